# Optimizing an MI355X kernel written in HIP

```python
import jax, jax.numpy as jnp
from jax import lax
import numpy as np

D_MODEL = 1024
BATCH = 8
SEQ = 2048
DEPTH = 2
DEC_BATCH = 128
DEC_SEQ = 8
PAST_LEN = 16384
PAGE_SIZE = 128

N_EVEN = (DEPTH + 1) // 2
N_ODD = DEPTH // 2
D_A = D_MODEL
CONV_W = 31
H_B = 8
DK_B = 128
DV_B = 128
D_B = H_B * DV_B
CHUNK_B = 64
D_C = 2 * D_MODEL
H_C = 8
DG_C = D_C // H_C
CHUNK_C = 128
EPS = 1e-6
HK_B = H_B * DK_B
D_IN_AB = 3 * D_A + 2 * HK_B + 2 * D_B
SPLIT_AB = [D_A, 2 * D_A, 3 * D_A, 3 * D_A + HK_B, 3 * D_A + 2 * HK_B, 3 * D_A + 2 * HK_B + D_B]

kernel_name = 'hybrid_conformerconv_hgrn2_gmlp_decode_step'


def _rmsnorm(x, g):
    xf = x.astype(jnp.float32)
    y = xf * lax.rsqrt(jnp.mean(xf * xf, axis=-1, keepdims=True) + EPS)
    return (y * g.astype(jnp.float32)).astype(x.dtype)


def _layernorm(x, g, b):
    xf = x.astype(jnp.float32)
    xc = xf - jnp.mean(xf, axis=-1, keepdims=True)
    y = xc * lax.rsqrt(jnp.mean(xc * xc, axis=-1, keepdims=True) + EPS)
    return (y * g.astype(jnp.float32) + b.astype(jnp.float32)).astype(x.dtype)


def _conformer_conv(a_val, a_glu, buf, conv_w, conv_b, ln_g, ln_b):
    a = a_val * jax.nn.sigmoid(a_glu)
    xp = jnp.concatenate([buf.astype(a.dtype), a], axis=1)
    y = lax.conv_general_dilated(xp, conv_w[:, None, :].astype(a.dtype), window_strides=(1,),
                                 padding='VALID', dimension_numbers=('NWC', 'WIO', 'NWC'),
                                 feature_group_count=D_A)
    y = jax.nn.silu(_layernorm(y + conv_b.astype(a.dtype), ln_g, ln_b))
    return y, xp[:, xp.shape[1] - (CONV_W - 1):]


def _hgrn2(q, f_pre, i_in, s0, lb):
    B, L = q.shape[0], q.shape[1]
    c = min(CHUNK_B, L)
    n = -(-L // c)
    pad = n * c - L
    f = lb + (1.0 - lb) * jax.nn.sigmoid(f_pre.astype(jnp.float32))
    logf = jnp.log(f)
    k = 1.0 - f
    qf = q.astype(jnp.float32)
    vf = i_in.astype(jnp.float32)
    padw = ((0, 0), (0, pad), (0, 0), (0, 0))
    qf, logf, k, vf = [jnp.pad(t, padw).reshape(B, n, c, H_B, t.shape[-1]) for t in (qf, logf, k, vf)]
    bcum = jnp.cumsum(logf, axis=2)
    b_mid = bcum[:, :, c // 2:c // 2 + 1]
    b_end = bcum[:, :, c - 1:c]
    scores = jnp.einsum('bnthd,bnshd->bnhts', qf * jnp.exp(bcum - b_mid), k * jnp.exp(b_mid - bcum))
    causal = jnp.tril(jnp.ones((c, c), dtype=bool))
    scores = jnp.where(causal, scores, 0.0)
    o_intra = jnp.einsum('bnhts,bnshv->bnthv', scores, vf)
    ds = jnp.einsum('bnshd,bnshv->bnhdv', k * jnp.exp(b_end - bcum), vf)
    decay = jnp.exp(b_end[:, :, 0])

    def step(s, inp):
        dec, d = inp
        return dec[..., None] * s + d, s

    s_fin, s_prev = lax.scan(step, s0.astype(jnp.float32),
                             (jnp.moveaxis(decay, 1, 0), jnp.moveaxis(ds, 1, 0)))
    s_prev = jnp.moveaxis(s_prev, 0, 1)
    o_inter = jnp.einsum('bnthd,bnhdv->bnthv', qf * jnp.exp(bcum), s_prev)
    o = (o_intra + o_inter).reshape(B, n * c, H_B, DV_B)[:, :L]
    return o, s_fin


def _even_layer(x, buf, s0, g_norm, w_in, conv_w, conv_b, ln_g, ln_b, lb, o_g, w_out):
    B, L, _ = x.shape
    z = _rmsnorm(x, g_norm) @ w_in
    a_val, a_glu, a_gate, q, f_pre, i_in, b_gate = jnp.split(z, SPLIT_AB, axis=-1)
    a_out, new_buf = _conformer_conv(a_val, a_glu, buf, conv_w, conv_b, ln_g, ln_b)
    a_out = a_out * jax.nn.silu(a_gate)
    o, s_new = _hgrn2(q.reshape(B, L, H_B, DK_B), f_pre.reshape(B, L, H_B, DK_B),
                      jax.nn.silu(i_in).reshape(B, L, H_B, DV_B), s0, lb)
    o = _rmsnorm(o, o_g).reshape(B, L, D_B).astype(x.dtype) * jax.nn.silu(b_gate)
    y = jnp.concatenate([a_out, o], axis=-1) @ w_out
    return x + y, new_buf, s_new


def _odd_layer(x, g_norm, w_in, ln_g, ln_b, w_s, b_s, w_out):
    B, L, _ = x.shape
    z = _rmsnorm(x, g_norm) @ w_in
    uv = jax.nn.gelu(z[..., :2 * D_C])
    gate = z[..., 2 * D_C:]
    u = uv[..., :D_C]
    v = _layernorm(uv[..., D_C:], ln_g, ln_b)
    n = -(-L // CHUNK_C)
    pad = n * CHUNK_C - L
    vp = jnp.pad(v, ((0, 0), (0, pad), (0, 0))).reshape(B, n, CHUNK_C, H_C, DG_C)
    ws = jnp.where(jnp.tril(jnp.ones((CHUNK_C, CHUNK_C), dtype=bool)), w_s, 0.0)
    mix = jnp.einsum('hts,bnshd->bnthd', ws.astype(vp.dtype), vp) + b_s.T[None, None, :, :, None]
    mix = mix.reshape(B, n * CHUNK_C, D_C)[:, :L]
    y = (u * mix * jax.nn.silu(gate)) @ w_out
    start = ((L - 1) // CHUNK_C) * CHUNK_C
    return x + y, v[:, start:]


def _trunk(x, bufs, states, norm_ab, w_in_ab, conv_w, conv_b, ln_a_g, ln_a_b, lb_logits, onorm_b,
           w_out_ab, norm_c, w_in_c, ln_c_g, ln_c_b, w_s, b_s, w_out_c, final_norm):
    lb_all = jnp.cumsum(jax.nn.softmax(lb_logits.astype(jnp.float32), axis=0), axis=0)
    new_bufs, new_states, new_v = [], [], []
    for l in range(DEPTH):
        j = l // 2
        if l % 2 == 0:
            x, nb, ns = _even_layer(x, bufs[j], states[j], norm_ab[j], w_in_ab[j], conv_w[j], conv_b[j],
                                    ln_a_g[j], ln_a_b[j], lb_all[j].reshape(H_B, DK_B), onorm_b[j],
                                    w_out_ab[j])
            new_bufs.append(nb)
            new_states.append(ns.astype(x.dtype))
        else:
            x, nv = _odd_layer(x, norm_c[j], w_in_c[j], ln_c_g[j], ln_c_b[j], w_s[j], b_s[j], w_out_c[j])
            new_v.append(nv)
    return _rmsnorm(x, final_norm), jnp.stack(new_bufs), jnp.stack(new_states), jnp.stack(new_v)


def setup_inputs(seed: int = 0) -> dict:
    key = jax.random.key(seed)
    ks = jax.random.split(key, 24)
    nrm = lambda k, s: jax.random.normal(k, s, jnp.float32)
    return {
        'x_prompt': nrm(ks[0], (BATCH, SEQ, D_MODEL)),
        'x_sample': nrm(ks[1], (DEC_BATCH, DEC_SEQ, D_MODEL)),
        'state_conv': 0.5 * nrm(ks[2], (N_EVEN, DEC_BATCH, CONV_W - 1, D_A)),
        'state_hgrn': 0.5 * nrm(ks[3], (N_EVEN, DEC_BATCH, H_B, DK_B, DV_B)),
        'norm_ab': 1.0 + 0.02 * nrm(ks[4], (N_EVEN, D_MODEL)),
        'w_in_ab': nrm(ks[5], (N_EVEN, D_MODEL, D_IN_AB)) * D_MODEL ** -0.5,
        'conv_w': nrm(ks[6], (N_EVEN, CONV_W, D_A)) * CONV_W ** -0.5,
        'conv_b': 0.02 * nrm(ks[7], (N_EVEN, D_A)),
        'ln_a_g': 1.0 + 0.02 * nrm(ks[8], (N_EVEN, D_A)),
        'ln_a_b': 0.02 * nrm(ks[9], (N_EVEN, D_A)),
        'lb_logits': 0.1 * nrm(ks[10], (N_EVEN + 1, HK_B)),
        'onorm_b': 1.0 + 0.02 * nrm(ks[11], (N_EVEN, H_B, DV_B)),
        'w_out_ab': nrm(ks[12], (N_EVEN, D_A + D_B, D_MODEL)) * (D_A + D_B) ** -0.5,
        'norm_c': 1.0 + 0.02 * nrm(ks[13], (N_ODD, D_MODEL)),
        'w_in_c': nrm(ks[14], (N_ODD, D_MODEL, 3 * D_C)) * D_MODEL ** -0.5,
        'ln_c_g': 1.0 + 0.02 * nrm(ks[15], (N_ODD, D_C)),
        'ln_c_b': 0.02 * nrm(ks[16], (N_ODD, D_C)),
        'w_s': nrm(ks[17], (N_ODD, H_C, CHUNK_C, CHUNK_C)) * CHUNK_C ** -0.5,
        'b_s': 1.0 + 0.1 * nrm(ks[18], (N_ODD, H_C, CHUNK_C)),
        'w_out_c': nrm(ks[19], (N_ODD, D_C, D_MODEL)) * D_C ** -0.5,
        'final_norm': 1.0 + 0.02 * nrm(ks[20], (D_MODEL,)),
    }


def reference(x_prompt, x_sample, state_conv, state_hgrn, norm_ab, w_in_ab, conv_w, conv_b, ln_a_g,
              ln_a_b, lb_logits, onorm_b, w_out_ab, norm_c, w_in_c, ln_c_g, ln_c_b, w_s, b_s, w_out_c,
              final_norm):
    weights = (norm_ab, w_in_ab, conv_w, conv_b, ln_a_g, ln_a_b, lb_logits, onorm_b, w_out_ab,
               norm_c, w_in_c, ln_c_g, ln_c_b, w_s, b_s, w_out_c, final_norm)
    bp = x_prompt.shape[0]
    bufs0 = jnp.zeros((N_EVEN, bp, CONV_W - 1, D_A), x_prompt.dtype)
    states0 = jnp.zeros((N_EVEN, bp, H_B, DK_B, DV_B), jnp.float32)
    y_prompt, conv_prompt, hgrn_prompt, gmlp_v_prompt = _trunk(x_prompt, bufs0, states0, *weights)
    y_sample, conv_sample, hgrn_sample, gmlp_v_sample = _trunk(x_sample, state_conv, state_hgrn, *weights)
    return (y_prompt, y_sample, conv_prompt, hgrn_prompt, gmlp_v_prompt, conv_sample, hgrn_sample, gmlp_v_sample)
```

```cpp
#include <hip/hip_runtime.h>
#include <hip/hip_cooperative_groups.h>
#include <cstdio>
#include <cstdint>
namespace cg = cooperative_groups;

#define LAS __attribute__((address_space(3)))
typedef unsigned short bf16_t;
typedef short bf16x8 __attribute__((ext_vector_type(8)));
typedef float f32x4 __attribute__((ext_vector_type(4)));
typedef float f32x2 __attribute__((ext_vector_type(2)));
typedef unsigned u32x4 __attribute__((ext_vector_type(4)));
typedef unsigned u32x2 __attribute__((ext_vector_type(2)));

constexpr int D = 1024, TP = 16384, TS = 1024, T = TP + TS;
constexpr int N1 = 7168, N3 = 6144, DC = 2048;
constexpr float EPS = 1e-6f;
constexpr int NWAVES = 8, NTHR = 512;
constexpr int LDS_BYTES = 147456;
constexpr size_t MiB = (size_t)1 << 20;
constexpr size_t WS_LB = 65536;
constexpr size_t WS_WT1 = 1 * MiB, WS_WT2 = 15 * MiB, WS_WT3 = 19 * MiB, WS_WT4 = 31 * MiB;
constexpr size_t WS_R1 = 35 * MiB;
constexpr size_t WS_X1 = WS_R1, WS_X1B = WS_R1 + 68 * MiB, WS_UG = WS_R1 + 102 * MiB;
constexpr size_t WS_SSP1 = WS_R1 + 170 * MiB, WS_VST = WS_R1 + 172 * MiB, WS_SSP2 = WS_R1 + 178 * MiB;
constexpr size_t WS_SEG = 239 * MiB;
constexpr size_t WS_END = 255 * MiB;
constexpr size_t O_YP = 0, O_YS = 16777216, O_CP = 17825792, O_HP = 18071552, O_GP = 19120128, O_CS = 21217280, O_HS = 25149440, O_GS = 41926656, O_END = 44023808;

struct Params { const float* in[21]; float* out; unsigned char* ws; };

__device__ __forceinline__ float bf2f(unsigned b) { return __uint_as_float(b << 16); }
__device__ __forceinline__ float bflo(unsigned w) { return __uint_as_float(w << 16); }
__device__ __forceinline__ float bfhi(unsigned w) { return __uint_as_float(w & 0xffff0000u); }
__device__ __forceinline__ unsigned f2bf(float f) { unsigned u = __float_as_uint(f); return (u + 0x7fffu + ((u >> 16) & 1u)) >> 16; }
__device__ __forceinline__ unsigned pk2(float lo, float hi) { return f2bf(lo) | (f2bf(hi) << 16); }
__device__ __forceinline__ float sigm(float x) { return 1.0f / (1.0f + __expf(-x)); }
__device__ __forceinline__ float silu(float x) { return x * sigm(x); }
__device__ __forceinline__ float gelu_t(float x) { return x * sigm(1.5957691216057308f * (x + 0.044715f * x * x * x)); }
__device__ __forceinline__ float wave_sum(float v) {
#pragma unroll
    for (int o = 1; o < 64; o <<= 1) v += __shfl_xor(v, o);
    return v;
}
__device__ __forceinline__ void st8(bf16_t* p, const float (&v)[8]) {
    u32x4 w; w.x = pk2(v[0], v[1]); w.y = pk2(v[2], v[3]); w.z = pk2(v[4], v[5]); w.w = pk2(v[6], v[7]); *(u32x4*)p = w;
}
__device__ __forceinline__ float block_sum(float v, LAS float* red) {
    v = wave_sum(v);
    __syncthreads();
    if ((threadIdx.x & 63) == 0) red[threadIdx.x >> 6] = v;
    __syncthreads();
    float s = 0.f;
#pragma unroll
    for (int i = 0; i < 8; ++i) s += red[i];
    return s;
}

template <int MAP> __device__ __forceinline__ int vmap(int vc) {
    const int vt = vc >> 8, c = vc & 255;
    if (MAP == 1) return vt < 8 ? (c < 128 ? 128 * vt + c : 1024 + 128 * vt + (c - 128)) : vc;
    if (MAP == 3) return vt < 16 ? (c < 128 ? 128 * vt + c : 4096 + 128 * vt + (c - 128)) : vc - 2048;
    return vc;
}

template <int MAP> __device__ __forceinline__ void transpose_item(const float* W, int K, int N, bf16_t* WT, const float* kscale, LAS float* scr, int item, int lane) {
    const int nblk = N / 32, kb = item / nblk, nb = item % nblk, k0 = 64 * kb, n0 = 32 * nb;
    const int on0 = vmap<MAP>(n0);
#pragma unroll 8
    for (int i = 0; i < 32; ++i) { const int kk = 2 * i + (lane >> 5); float w = W[(size_t)(k0 + kk) * N + on0 + (lane & 31)]; if (kscale) w *= kscale[k0 + kk]; scr[kk * 33 + (lane & 31)] = w; }
    asm volatile("s_waitcnt lgkmcnt(0)" ::: "memory");
    const int c = lane & 7;
#pragma unroll
    for (int j = 0; j < 4; ++j) { const int n = (lane >> 3) + 8 * j; const LAS float* s = scr + (8 * c) * 33 + n;
        u32x4 o; o.x = pk2(s[0 * 33], s[1 * 33]); o.y = pk2(s[2 * 33], s[3 * 33]); o.z = pk2(s[4 * 33], s[5 * 33]); o.w = pk2(s[6 * 33], s[7 * 33]);
        *(u32x4*)(WT + (size_t)(n0 + n) * K + k0 + 8 * c) = o; }
    asm volatile("s_waitcnt lgkmcnt(0)" ::: "memory");
}
__device__ __forceinline__ void rms_row_to_bf16(const float* xrow, const float* g, bf16_t* orow, int lane) {
    const f32x4* xr = (const f32x4*)xrow + lane; f32x4 v[4]; float s = 0.f;
#pragma unroll
    for (int j = 0; j < 4; ++j) { v[j] = xr[64 * j]; s += (v[j].x * v[j].x + v[j].y * v[j].y) + (v[j].z * v[j].z + v[j].w * v[j].w); }
    const float rs = rsqrtf(wave_sum(s) * (1.f / 1024.f) + EPS);
    u32x2* o8 = (u32x2*)orow + lane;
#pragma unroll
    for (int j = 0; j < 4; ++j) { const f32x4 gg = ((const f32x4*)g)[lane + 64 * j]; u32x2 w; w.x = pk2(v[j].x * rs * gg.x, v[j].y * rs * gg.y); w.y = pk2(v[j].z * rs * gg.z, v[j].w * rs * gg.w); o8[64 * j] = w; }
}
__device__ __forceinline__ void phase0(const Params& p, LAS unsigned char* lds, int vb, int G) {
    const int tid = threadIdx.x, lane = tid & 63, wave = tid >> 6;
    const int gw = vb * NWAVES + wave, NGW = G * NWAVES;
    float* LB = (float*)(p.ws + WS_LB);
    for (int i = vb * NTHR + tid; i < 1024; i += G * NTHR) { const float l0 = p.in[10][i], l1 = p.in[10][1024 + i]; LB[i] = 1.0f / (1.0f + __expf(l1 - l0)); }
    LAS float* scr = (LAS float*)(lds + wave * 16384);
    constexpr int I1 = (D / 64) * (N1 / 32), I2 = (2048 / 64) * (D / 32), I3 = (D / 64) * (N3 / 32), I4 = I2;
    for (int it = gw; it < I1 + I2 + I3 + I4; it += NGW) {
        int r = it;
        if (r < I1) { transpose_item<1>(p.in[5], D, N1, (bf16_t*)(p.ws + WS_WT1), nullptr, scr, r, lane); continue; } r -= I1;
        if (r < I2) { transpose_item<0>(p.in[12], 2048, D, (bf16_t*)(p.ws + WS_WT2), nullptr, scr, r, lane); continue; } r -= I2;
        if (r < I3) { transpose_item<3>(p.in[14], D, N3, (bf16_t*)(p.ws + WS_WT3), p.in[13], scr, r, lane); continue; } r -= I3;
        transpose_item<0>(p.in[19], 2048, D, (bf16_t*)(p.ws + WS_WT4), nullptr, scr, r, lane);
    }
    bf16_t* XN0 = (bf16_t*)p.out;
    for (int r = gw; r < T; r += NGW) { const float* xr = r < TP ? p.in[0] + (size_t)r * D : p.in[1] + (size_t)(r - TP) * D; rms_row_to_bf16(xr, p.in[4], XN0 + (size_t)r * D, lane); }
}

struct Epi1 {
    bf16_t* Z; const float* LB;
    __device__ __forceinline__ float rowscale(int) const { return 1.f; }
    template <int X1M, int X2M> __device__ __forceinline__ void tile8(int row, int pn, int c0, const float (&lo)[8], const float (&hi)[8], float) const {
        if (pn < 8) { float a[8];
#pragma unroll
            for (int i = 0; i < 8; ++i) a[i] = lo[i] * sigm(hi[i]);
            st8(Z + (size_t)row * 1024 + 128 * pn + c0, a);
        } else {
            const int g = (pn - 8) >> 2, col = ((pn - 8) & 3) * 256 + c0;
            bf16_t* base = Z + (size_t)(g + 1) * T * 1024 + (size_t)row * 1024 + col;
            float x[8], y[8];
            if (g == 1) {
#pragma unroll
                for (int i = 0; i < 8; ++i) { x[i] = lo[i]; y[i] = hi[i]; }
            } else if (g == 2) {
#pragma unroll
                for (int i = 0; i < 8; ++i) { const float l0 = LB[col + i], l1 = LB[col + 128 + i]; x[i] = __logf(l0 + (1.f - l0) * sigm(lo[i])); y[i] = __logf(l1 + (1.f - l1) * sigm(hi[i])); }
            } else {
#pragma unroll
                for (int i = 0; i < 8; ++i) { x[i] = silu(lo[i]); y[i] = silu(hi[i]); }
            }
            st8(base, x); st8(base + 128, y);
        }
    }
};
struct Epi2 {
    const float* xp; const float* xs; float* X1; bf16_t* X1B; float* SSP;
    __device__ __forceinline__ float rowscale(int) const { return 1.f; }
    template <int X1M, int X2M> __device__ __forceinline__ void tile8(int row, int pn, int c0, const float (&lo)[8], const float (&hi)[8], float) const {
        const int col = 256 * pn + c0;
        const float* xr = (row < TP ? xp + (size_t)row * D : xs + (size_t)(row - TP) * D) + col;
        const f32x4 a0 = *(const f32x4*)xr, a1 = *(const f32x4*)(xr + 4), b0 = *(const f32x4*)(xr + 128), b1 = *(const f32x4*)(xr + 132);
        float v[8], w[8];
        v[0] = a0.x + lo[0]; v[1] = a0.y + lo[1]; v[2] = a0.z + lo[2]; v[3] = a0.w + lo[3]; v[4] = a1.x + lo[4]; v[5] = a1.y + lo[5]; v[6] = a1.z + lo[6]; v[7] = a1.w + lo[7];
        w[0] = b0.x + hi[0]; w[1] = b0.y + hi[1]; w[2] = b0.z + hi[2]; w[3] = b0.w + hi[3]; w[4] = b1.x + hi[4]; w[5] = b1.y + hi[5]; w[6] = b1.z + hi[6]; w[7] = b1.w + hi[7];
        float* o = X1 + (size_t)row * D + col;
        *(f32x4*)o = (f32x4){v[0], v[1], v[2], v[3]}; *(f32x4*)(o + 4) = (f32x4){v[4], v[5], v[6], v[7]};
        *(f32x4*)(o + 128) = (f32x4){w[0], w[1], w[2], w[3]}; *(f32x4*)(o + 132) = (f32x4){w[4], w[5], w[6], w[7]};
        bf16_t* ob = X1B + (size_t)row * D + col; st8(ob, v); st8(ob + 128, w);
        float ss = 0.f;
#pragma unroll
        for (int i = 0; i < 8; ++i) ss += v[i] * v[i] + w[i] * w[i];
        ss += __shfl_xor(ss, X1M); ss += __shfl_xor(ss, X2M);
        if ((c0 & 31) == 0) SSP[(size_t)row * 16 + pn * 4 + (c0 >> 5)] = ss;
    }
};
struct Epi3 {
    const float* SSP1; bf16_t* UG; bf16_t* GV; f32x2* VST;
    __device__ __forceinline__ float rowscale(int row) const {
        const f32x4* s = (const f32x4*)(SSP1 + (size_t)row * 16); const f32x4 a = s[0], b = s[1], c = s[2], d = s[3];
        const float t = ((a.x + a.y) + (a.z + a.w)) + ((b.x + b.y) + (b.z + b.w)) + ((c.x + c.y) + (c.z + c.w)) + ((d.x + d.y) + (d.z + d.w));
        return rsqrtf(t * (1.f / 1024.f) + EPS);
    }
    template <int X1M, int X2M> __device__ __forceinline__ void tile8(int row, int pn, int c0, const float (&lo)[8], const float (&hi)[8], float rs) const {
        if (pn < 16) { float a[8];
#pragma unroll
            for (int i = 0; i < 8; ++i) a[i] = gelu_t(lo[i] * rs) * silu(hi[i] * rs);
            st8(UG + (size_t)row * DC + 128 * pn + c0, a);
        } else {
            const int col = 256 * (pn - 16) + c0; float x[8], y[8], s = 0.f, q = 0.f;
#pragma unroll
            for (int i = 0; i < 8; ++i) { x[i] = gelu_t(lo[i] * rs); y[i] = gelu_t(hi[i] * rs); s += x[i] + y[i]; q += x[i] * x[i] + y[i] * y[i]; }
            bf16_t* o = GV + (size_t)row * DC + col; st8(o, x); st8(o + 128, y);
            s += __shfl_xor(s, X1M); q += __shfl_xor(q, X1M); s += __shfl_xor(s, X2M); q += __shfl_xor(q, X2M);
            if ((c0 & 31) == 0) VST[(size_t)row * 32 + (pn - 16) * 4 + (c0 >> 5)] = (f32x2){s, q};
        }
    }
};
struct Epi4 {
    const float* X1; float* Y; float* SSP;
    __device__ __forceinline__ float rowscale(int) const { return 1.f; }
    template <int X1M, int X2M> __device__ __forceinline__ void tile8(int row, int pn, int c0, const float (&lo)[8], const float (&hi)[8], float) const {
        const int col = 256 * pn + c0;
        const float* xr = X1 + (size_t)row * D + col;
        const f32x4 a0 = *(const f32x4*)xr, a1 = *(const f32x4*)(xr + 4), b0 = *(const f32x4*)(xr + 128), b1 = *(const f32x4*)(xr + 132);
        float v[8], w[8];
        v[0] = a0.x + lo[0]; v[1] = a0.y + lo[1]; v[2] = a0.z + lo[2]; v[3] = a0.w + lo[3]; v[4] = a1.x + lo[4]; v[5] = a1.y + lo[5]; v[6] = a1.z + lo[6]; v[7] = a1.w + lo[7];
        w[0] = b0.x + hi[0]; w[1] = b0.y + hi[1]; w[2] = b0.z + hi[2]; w[3] = b0.w + hi[3]; w[4] = b1.x + hi[4]; w[5] = b1.y + hi[5]; w[6] = b1.z + hi[6]; w[7] = b1.w + hi[7];
        float* o = Y + (size_t)row * D + col;
        *(f32x4*)o = (f32x4){v[0], v[1], v[2], v[3]}; *(f32x4*)(o + 4) = (f32x4){v[4], v[5], v[6], v[7]};
        *(f32x4*)(o + 128) = (f32x4){w[0], w[1], w[2], w[3]}; *(f32x4*)(o + 132) = (f32x4){w[4], w[5], w[6], w[7]};
        float ss = 0.f;
#pragma unroll
        for (int i = 0; i < 8; ++i) ss += v[i] * v[i] + w[i] * w[i];
        ss += __shfl_xor(ss, X1M); ss += __shfl_xor(ss, X2M);
        if ((c0 & 31) == 0) SSP[(size_t)row * 16 + pn * 4 + (c0 >> 5)] = ss;
    }
};

template <class Epi> __device__ __forceinline__ void gemm_simple(LAS unsigned char* lds, const bf16_t* A, const bf16_t* Bt, int M, int N, int K, const Epi& E, int vb, int G) {
    LAS bf16_t* sA = (LAS bf16_t*)lds;
    LAS bf16_t* sB = (LAS bf16_t*)(lds + 4096);
    const int tid = threadIdx.x, r = tid >> 4, c0 = (tid & 15) * 8;
    const int nN = N / 256, nunits = (M / 32) * nN;
    for (int u = vb; u < nunits; u += G) {
        const int ms = u / nN, pn = u % nN, row0 = ms * 32, col0 = pn * 256;
        float lo[8], hi[8];
#pragma unroll
        for (int i = 0; i < 8; ++i) { lo[i] = 0.f; hi[i] = 0.f; }
        for (int k0 = 0; k0 < K; k0 += 32) {
            __syncthreads();
            if (tid < 128) { const int rr = tid >> 2, kc = (tid & 3) * 8; *(LAS u32x4*)(sA + rr * 40 + kc) = *(const u32x4*)(A + (size_t)(row0 + rr) * K + k0 + kc); }
            for (int q = tid; q < 1024; q += NTHR) { const int rr = q >> 2, kc = (q & 3) * 8; *(LAS u32x4*)(sB + rr * 40 + kc) = *(const u32x4*)(Bt + (size_t)(col0 + rr) * K + k0 + kc); }
            __syncthreads();
#pragma unroll 1
            for (int kc = 0; kc < 32; kc += 8) {
                const u32x4 av = *(const LAS u32x4*)(sA + r * 40 + kc);
                const float a0 = bflo(av.x), a1 = bfhi(av.x), a2 = bflo(av.y), a3 = bfhi(av.y), a4 = bflo(av.z), a5 = bfhi(av.z), a6 = bflo(av.w), a7 = bfhi(av.w);
#pragma unroll
                for (int i = 0; i < 8; ++i) {
                    const u32x4 b = *(const LAS u32x4*)(sB + (c0 + i) * 40 + kc);
                    lo[i] += a0 * bflo(b.x) + a1 * bfhi(b.x) + a2 * bflo(b.y) + a3 * bfhi(b.y) + a4 * bflo(b.z) + a5 * bfhi(b.z) + a6 * bflo(b.w) + a7 * bfhi(b.w);
                    const u32x4 c = *(const LAS u32x4*)(sB + (128 + c0 + i) * 40 + kc);
                    hi[i] += a0 * bflo(c.x) + a1 * bfhi(c.x) + a2 * bflo(c.y) + a3 * bfhi(c.y) + a4 * bflo(c.z) + a5 * bfhi(c.z) + a6 * bflo(c.w) + a7 * bfhi(c.w);
                }
            }
        }
        const int row = row0 + r; const float rsc = E.rowscale(row);
        E.template tile8<1, 2>(row, pn, c0, lo, hi, rsc);
    }
}

__device__ __forceinline__ void conv_simple(const Params& p, LAS unsigned char* lds, int vb, int G) {
    LAS float* red = (LAS float*)lds;
    const bf16_t* A = (const bf16_t*)(p.ws + WS_R1); const bf16_t* SGA = A + (size_t)T * 1024; bf16_t* H0 = (bf16_t*)p.out;
    const float *cw = p.in[6], *cb = p.in[7], *lg = p.in[8], *lbeta = p.in[9], *sc = p.in[2];
    const int tid = threadIdx.x, c = tid * 2;
    for (int r = vb; r < T; r += G) {
        int t, rowbase; const float* hist;
        if (r < TP) { t = r & 2047; rowbase = r - t; hist = nullptr; } else { const int b = (r - TP) >> 3; t = (r - TP) & 7; rowbase = r - t; hist = sc + (size_t)b * 30 * 1024; }
        float y0 = cb[c], y1 = cb[c + 1];
        for (int j = 0; j < 31; ++j) { const int i = t + j - 30; float a0 = 0.f, a1 = 0.f;
            if (i >= 0) { const unsigned w = *(const unsigned*)(A + (size_t)(rowbase + i) * 1024 + c); a0 = bflo(w); a1 = bfhi(w); }
            else if (hist) { a0 = hist[(30 + i) * 1024 + c]; a1 = hist[(30 + i) * 1024 + c + 1]; }
            y0 += cw[j * 1024 + c] * a0; y1 += cw[j * 1024 + c + 1] * a1; }
        const float mean = block_sum(y0 + y1, red) * (1.f / 1024.f);
        const float d0 = y0 - mean, d1 = y1 - mean;
        const float rstd = rsqrtf(block_sum(d0 * d0 + d1 * d1, red) * (1.f / 1024.f) + EPS);
        const float n0 = d0 * rstd * lg[c] + lbeta[c], n1 = d1 * rstd * lg[c + 1] + lbeta[c + 1];
        const unsigned gw = *(const unsigned*)(SGA + (size_t)r * 1024 + c);
        *(unsigned*)(H0 + (size_t)r * 2048 + c) = pk2(silu(n0) * bflo(gw), silu(n1) * bfhi(gw));
    }
    for (int idx = vb * NTHR + tid; idx < 8 * 30 * 1024; idx += G * NTHR) { const int b = idx / 30720, rem = idx % 30720, i = rem >> 10, cc = rem & 1023;
        p.out[O_CP + idx] = bf2f(A[(size_t)(b * 2048 + 2018 + i) * 1024 + cc]); }
    for (int idx = vb * NTHR + tid; idx < 128 * 30 * 1024; idx += G * NTHR) { const int b = idx / 30720, rem = idx % 30720, i = rem >> 10, cc = rem & 1023;
        p.out[O_CS + idx] = (i < 22) ? sc[(size_t)(b * 30 + 8 + i) * 1024 + cc] : bf2f(A[(size_t)(TP + b * 8 + i - 22) * 1024 + cc]); }
}

__device__ __forceinline__ void hgrn_simple(const Params& p, LAS unsigned char* lds, int vb, int G, int item_lo, int item_hi) {
    LAS float* sf = (LAS float*)lds; LAS float* sk = sf + 1024; LAS float* sq = sk + 1024; LAS float* si = sq + 1024; LAS float* so = si + 1024; LAS float* so2 = so + 4096;
    const int tid = threadIdx.x, v = tid & 127, dq = tid >> 7, lane = tid & 63, wave = tid >> 6;
    const bf16_t* Z = (const bf16_t*)(p.ws + WS_R1);
    const bf16_t *Q = Z + (size_t)2 * T * 1024, *LOGF = Z + (size_t)3 * T * 1024, *I = Z + (size_t)4 * T * 1024, *SGB = Z + (size_t)5 * T * 1024;
    const float* og = p.in[11]; bf16_t* H0 = (bf16_t*)p.out;
    for (int item = item_lo + vb; item < item_hi; item += G) {
        int h, L, rowbase; const float* s0; float* sout;
        if (item < 64) { const int b = item >> 3; h = item & 7; L = 2048; rowbase = b * 2048; s0 = nullptr; sout = p.out + O_HP + (size_t)item * 16384; }
        else { const int it = item - 64, b = it >> 3; h = it & 7; L = 8; rowbase = TP + b * 8; s0 = p.in[3] + (size_t)it * 16384; sout = p.out + O_HS + (size_t)it * 16384; }
        float S[32];
#pragma unroll
        for (int j = 0; j < 32; ++j) S[j] = s0 ? s0[(dq * 32 + j) * 128 + v] : 0.f;
        for (int t0 = 0; t0 < L; t0 += 8) {
            __syncthreads();
            for (int e = tid; e < 1024; e += NTHR) { const int tt = e >> 7, d = e & 127; const size_t off = (size_t)(rowbase + t0 + tt) * 1024 + h * 128 + d;
                const float f = __expf(bf2f(LOGF[off])); sf[e] = f; sk[e] = 1.f - f; sq[e] = bf2f(Q[off]); si[e] = bf2f(I[off]); }
            __syncthreads();
#pragma unroll 1
            for (int tt = 0; tt < 8; ++tt) { const float iv = si[tt * 128 + v]; float op = 0.f;
#pragma unroll
                for (int j = 0; j < 32; ++j) { const int d = dq * 32 + j; S[j] = sf[tt * 128 + d] * S[j] + sk[tt * 128 + d] * iv; op += S[j] * sq[tt * 128 + d]; }
                so[(tt * 4 + dq) * 128 + v] = op; }
            __syncthreads();
            for (int e = tid; e < 1024; e += NTHR) { const int tt = e >> 7, vv = e & 127; so2[e] = (so[(tt * 4 + 0) * 128 + vv] + so[(tt * 4 + 1) * 128 + vv]) + (so[(tt * 4 + 2) * 128 + vv] + so[(tt * 4 + 3) * 128 + vv]); }
            __syncthreads();
            { const int tt = wave; const size_t row = (size_t)(rowbase + t0 + tt);
              const float o0 = so2[tt * 128 + lane], o1 = so2[tt * 128 + 64 + lane];
              const float rs = rsqrtf(wave_sum(o0 * o0 + o1 * o1) * (1.f / 128.f) + EPS);
              const float r0 = o0 * rs * og[h * 128 + lane] * bf2f(SGB[row * 1024 + h * 128 + lane]);
              const float r1 = o1 * rs * og[h * 128 + 64 + lane] * bf2f(SGB[row * 1024 + h * 128 + 64 + lane]);
              H0[row * 2048 + 1024 + h * 128 + lane] = (bf16_t)f2bf(r0); H0[row * 2048 + 1024 + h * 128 + 64 + lane] = (bf16_t)f2bf(r1); }
        }
#pragma unroll
        for (int j = 0; j < 32; ++j) sout[(dq * 32 + j) * 128 + v] = S[j];
    }
}

__device__ __forceinline__ void gmlp_simple(const Params& p, LAS unsigned char* lds, int vb, int G) {
    LAS float* smean = (LAS float*)lds; LAS float* srstd = smean + 128;
    const f32x2* VST = (const f32x2*)(p.ws + WS_VST); const bf16_t* GV = (const bf16_t*)p.out; bf16_t* UG = (bf16_t*)(p.ws + WS_UG);
    const float *lg = p.in[15], *lb_ = p.in[16], *wsp = p.in[17], *bs = p.in[18];
    const int tid = threadIdx.x, ch = tid * 4, h = tid >> 6;
    const f32x4 g4 = *(const f32x4*)(lg + ch), b4 = *(const f32x4*)(lb_ + ch);
    for (int r = vb; r < T; r += G) {
        int t, cstart;
        if (r < TP) { t = r & 127; cstart = r - t; } else { t = (r - TP) & 7; cstart = r - t; }
        __syncthreads();
        if (tid <= t) { const size_t row = (size_t)(cstart + tid); float s = 0.f, q = 0.f;
            for (int j = 0; j < 32; ++j) { const f32x2 st = VST[row * 32 + j]; s += st.x; q += st.y; }
            const float mean = s * (1.f / 2048.f); const float var = q * (1.f / 2048.f) - mean * mean; smean[tid] = mean; srstd[tid] = rsqrtf(var + EPS); }
        __syncthreads();
        float a0 = 0.f, a1 = 0.f, a2 = 0.f, a3 = 0.f, v0 = 0.f, v1 = 0.f, v2 = 0.f, v3 = 0.f;
        for (int s = 0; s <= t; ++s) {
            const float w = wsp[(size_t)(h * 128 + t) * 128 + s], m = smean[s], rs = srstd[s];
            const u32x2 gvw = *(const u32x2*)(GV + (size_t)(cstart + s) * DC + ch);
            v0 = (bflo(gvw.x) - m) * rs * g4.x + b4.x; v1 = (bfhi(gvw.x) - m) * rs * g4.y + b4.y; v2 = (bflo(gvw.y) - m) * rs * g4.z + b4.z; v3 = (bfhi(gvw.y) - m) * rs * g4.w + b4.w;
            a0 += w * v0; a1 += w * v1; a2 += w * v2; a3 += w * v3;
        }
        const float bias = bs[h * 128 + t];
        const u32x2 ugw = *(const u32x2*)(UG + (size_t)r * DC + ch);
        u32x2 o; o.x = pk2(bflo(ugw.x) * (a0 + bias), bfhi(ugw.x) * (a1 + bias)); o.y = pk2(bflo(ugw.y) * (a2 + bias), bfhi(ugw.y) * (a3 + bias));
        *(u32x2*)(UG + (size_t)r * DC + ch) = o;
        if (r < TP) { const int tt = (r & 2047) - 1920; if (tt >= 0) *(f32x4*)(p.out + O_GP + ((size_t)(r >> 11) * 128 + tt) * DC + ch) = (f32x4){v0, v1, v2, v3}; }
        else *(f32x4*)(p.out + O_GS + (size_t)(r - TP) * DC + ch) = (f32x4){v0, v1, v2, v3};
    }
}

__device__ __forceinline__ void final_norm(const Params& p, int vb, int G) {
    const int tid = threadIdx.x, lane = tid & 63, wave = tid >> 6;
    const int gw = vb * NWAVES + wave, NGW = G * NWAVES;
    const float* SSP = (const float*)(p.ws + WS_SSP2); const float* g = p.in[20];
    for (int r = gw; r < T; r += NGW) {
        const f32x4* s = (const f32x4*)(SSP + (size_t)r * 16); const f32x4 a = s[0], b = s[1], c = s[2], d = s[3];
        const float tot = ((a.x + a.y) + (a.z + a.w)) + ((b.x + b.y) + (b.z + b.w)) + ((c.x + c.y) + (c.z + c.w)) + ((d.x + d.y) + (d.z + d.w));
        const float rs = rsqrtf(tot * (1.f / 1024.f) + EPS);
        f32x4* y = (f32x4*)(p.out + (size_t)r * D) + lane;
#pragma unroll
        for (int j = 0; j < 4; ++j) { const f32x4 gg = ((const f32x4*)g)[lane + 64 * j]; f32x4 v = y[64 * j]; v.x *= rs * gg.x; v.y *= rs * gg.y; v.z *= rs * gg.z; v.w *= rs * gg.w; y[64 * j] = v; }
    }
}

__global__ void __launch_bounds__(NTHR, 2) fwd_kernel(Params p) {
    extern __shared__ __attribute__((aligned(16))) unsigned char lds_raw[];
    LAS unsigned char* lds = (LAS unsigned char*)lds_raw;
    cg::grid_group grid = cg::this_grid();
    const int G = gridDim.x, vb = blockIdx.x;
    bf16_t* WT1 = (bf16_t*)(p.ws + WS_WT1); bf16_t* WT2 = (bf16_t*)(p.ws + WS_WT2); bf16_t* WT3 = (bf16_t*)(p.ws + WS_WT3); bf16_t* WT4 = (bf16_t*)(p.ws + WS_WT4);
    bf16_t* ZR = (bf16_t*)(p.ws + WS_R1);

    phase0(p, lds, vb, G);
    grid.sync();
    { Epi1 E{ZR, (const float*)(p.ws + WS_LB)}; gemm_simple(lds, (const bf16_t*)p.out, WT1, T, N1, D, E, vb, G); }
    grid.sync();
    hgrn_simple(p, lds, vb, G, 0, 64 + 1024);
    conv_simple(p, lds, vb, G);
    grid.sync();
    { Epi2 E{p.in[0], p.in[1], (float*)(p.ws + WS_X1), (bf16_t*)(p.ws + WS_X1B), (float*)(p.ws + WS_SSP1)}; gemm_simple(lds, (const bf16_t*)p.out, WT2, T, D, 2048, E, vb, G); }
    grid.sync();
    { Epi3 E{(const float*)(p.ws + WS_SSP1), (bf16_t*)(p.ws + WS_UG), (bf16_t*)p.out, (f32x2*)(p.ws + WS_VST)}; gemm_simple(lds, (const bf16_t*)(p.ws + WS_X1B), WT3, T, N3, D, E, vb, G); }
    grid.sync();
    gmlp_simple(p, lds, vb, G);
    grid.sync();
    { Epi4 E{(const float*)(p.ws + WS_X1), p.out, (float*)(p.ws + WS_SSP2)}; gemm_simple(lds, (const bf16_t*)(p.ws + WS_UG), WT4, T, D, 2048, E, vb, G); }
    grid.sync();
    final_norm(p, vb, G);
}

extern "C" void kernel_launch(void* const* d_in, const int* in_sizes, int n_in, void* d_out, int out_size, void* d_ws, size_t ws_size, hipStream_t stream) {
    static int grid = 0;
    if (grid == 0) {
        if (n_in != 21 || (size_t)out_size != O_END || ws_size < WS_END) { fprintf(stderr, "kernel_launch: unexpected shapes: n_in %d out %d ws %zu\n", n_in, out_size, ws_size); grid = -1; return; }
        int dev = 0, cus = 0, per_cu = 0;
        if (hipGetDevice(&dev) != hipSuccess || hipDeviceGetAttribute(&cus, hipDeviceAttributeMultiprocessorCount, dev) != hipSuccess) { grid = -1; return; }
        if (hipFuncSetAttribute((const void*)fwd_kernel, hipFuncAttributeMaxDynamicSharedMemorySize, LDS_BYTES) != hipSuccess) { fprintf(stderr, "kernel_launch: hipFuncSetAttribute failed\n"); grid = -1; return; }
        if (hipOccupancyMaxActiveBlocksPerMultiprocessor(&per_cu, (const void*)fwd_kernel, NTHR, LDS_BYTES) != hipSuccess || per_cu < 1) { fprintf(stderr, "kernel_launch: occupancy query says %d\n", per_cu); grid = -1; return; }
        grid = cus;
    }
    if (grid < 0) return;
    Params p{};
    for (int i = 0; i < 21; ++i) p.in[i] = (const float*)d_in[i];
    p.out = (float*)d_out; p.ws = (unsigned char*)d_ws;
    void* args[] = {&p};
    hipError_t e = hipLaunchCooperativeKernel((const void*)fwd_kernel, dim3(grid), dim3(NTHR), args, LDS_BYTES, stream);
    if (e != hipSuccess) fprintf(stderr, "kernel_launch: cooperative launch failed: %s (grid %d)\n", hipGetErrorString(e), grid);
}
```

```cpp
#include <hip/hip_runtime.h>
#include <hip/hip_cooperative_groups.h>
#include <cstdio>
#include <cstdint>
namespace cg = cooperative_groups;

#ifndef FAST_GEMM
#define FAST_GEMM 1
#endif

#define LAS __attribute__((address_space(3)))
typedef unsigned short bf16_t;
typedef short bf16x8 __attribute__((ext_vector_type(8)));
typedef float f32x4 __attribute__((ext_vector_type(4)));
typedef float f32x2 __attribute__((ext_vector_type(2)));
typedef unsigned u32x4 __attribute__((ext_vector_type(4)));
typedef unsigned u32x2 __attribute__((ext_vector_type(2)));

constexpr int D = 1024, TP = 16384, TS = 1024, T = TP + TS;
constexpr int N1 = 7168, N3 = 6144, DC = 2048;
constexpr float EPS = 1e-6f;
constexpr int NWAVES = 8, NTHR = 512;
constexpr int LDS_BYTES = 147456;
constexpr size_t MiB = (size_t)1 << 20;
constexpr size_t WS_LB = 65536;
constexpr size_t WS_WT1 = 1 * MiB, WS_WT2 = 15 * MiB, WS_WT3 = 19 * MiB, WS_WT4 = 31 * MiB;
constexpr size_t WS_R1 = 35 * MiB;
constexpr size_t WS_X1 = WS_R1, WS_X1B = WS_R1 + 68 * MiB, WS_UG = WS_R1 + 102 * MiB;
constexpr size_t WS_SSP1 = WS_R1 + 170 * MiB, WS_VST = WS_R1 + 172 * MiB, WS_SSP2 = WS_R1 + 178 * MiB;
constexpr size_t WS_SEG = 239 * MiB;
constexpr size_t WS_END = 255 * MiB;
constexpr size_t O_YP = 0, O_YS = 16777216, O_CP = 17825792, O_HP = 18071552, O_GP = 19120128, O_CS = 21217280, O_HS = 25149440, O_GS = 41926656, O_END = 44023808;

struct Params { const float* in[21]; float* out; unsigned char* ws; };

__device__ __forceinline__ float bf2f(unsigned b) { return __uint_as_float(b << 16); }
__device__ __forceinline__ float bflo(unsigned w) { return __uint_as_float(w << 16); }
__device__ __forceinline__ float bfhi(unsigned w) { return __uint_as_float(w & 0xffff0000u); }
__device__ __forceinline__ unsigned f2bf(float f) { unsigned u = __float_as_uint(f); return (u + 0x7fffu + ((u >> 16) & 1u)) >> 16; }
__device__ __forceinline__ unsigned pk2(float lo, float hi) { return f2bf(lo) | (f2bf(hi) << 16); }
__device__ __forceinline__ float sigm(float x) { return 1.0f / (1.0f + __expf(-x)); }
__device__ __forceinline__ float silu(float x) { return x * sigm(x); }
__device__ __forceinline__ float gelu_t(float x) { return x * sigm(1.5957691216057308f * (x + 0.044715f * x * x * x)); }
__device__ __forceinline__ float wave_sum(float v) {
#pragma unroll
    for (int o = 1; o < 64; o <<= 1) v += __shfl_xor(v, o);
    return v;
}
__device__ __forceinline__ void st8(bf16_t* p, const float (&v)[8]) {
    u32x4 w; w.x = pk2(v[0], v[1]); w.y = pk2(v[2], v[3]); w.z = pk2(v[4], v[5]); w.w = pk2(v[6], v[7]); *(u32x4*)p = w;
}
__device__ __forceinline__ float block_sum(float v, LAS float* red) {
    v = wave_sum(v);
    __syncthreads();
    if ((threadIdx.x & 63) == 0) red[threadIdx.x >> 6] = v;
    __syncthreads();
    float s = 0.f;
#pragma unroll
    for (int i = 0; i < 8; ++i) s += red[i];
    return s;
}

template <int MAP> __device__ __forceinline__ int vmap(int vc) {
    const int vt = vc >> 8, c = vc & 255;
    if (MAP == 1) return vt < 8 ? (c < 128 ? 128 * vt + c : 1024 + 128 * vt + (c - 128)) : vc;
    if (MAP == 3) return vt < 16 ? (c < 128 ? 128 * vt + c : 4096 + 128 * vt + (c - 128)) : vc - 2048;
    return vc;
}

template <int MAP> __device__ __forceinline__ void transpose_item(const float* W, int K, int N, bf16_t* WT, const float* kscale, LAS float* scr, int item, int lane) {
    const int nblk = N / 32, kb = item / nblk, nb = item % nblk, k0 = 64 * kb, n0 = 32 * nb;
    const int on0 = vmap<MAP>(n0);
#pragma unroll 8
    for (int i = 0; i < 32; ++i) { const int kk = 2 * i + (lane >> 5); float w = W[(size_t)(k0 + kk) * N + on0 + (lane & 31)]; if (kscale) w *= kscale[k0 + kk]; scr[kk * 33 + (lane & 31)] = w; }
    asm volatile("s_waitcnt lgkmcnt(0)" ::: "memory");
    const int c = lane & 7;
#pragma unroll
    for (int j = 0; j < 4; ++j) { const int n = (lane >> 3) + 8 * j; const LAS float* s = scr + (8 * c) * 33 + n;
        u32x4 o; o.x = pk2(s[0 * 33], s[1 * 33]); o.y = pk2(s[2 * 33], s[3 * 33]); o.z = pk2(s[4 * 33], s[5 * 33]); o.w = pk2(s[6 * 33], s[7 * 33]);
        *(u32x4*)(WT + (size_t)(n0 + n) * K + k0 + 8 * c) = o; }
    asm volatile("s_waitcnt lgkmcnt(0)" ::: "memory");
}
__device__ __forceinline__ void rms_row_to_bf16(const float* xrow, const float* g, bf16_t* orow, int lane) {
    const f32x4* xr = (const f32x4*)xrow + lane; f32x4 v[4]; float s = 0.f;
#pragma unroll
    for (int j = 0; j < 4; ++j) { v[j] = xr[64 * j]; s += (v[j].x * v[j].x + v[j].y * v[j].y) + (v[j].z * v[j].z + v[j].w * v[j].w); }
    const float rs = rsqrtf(wave_sum(s) * (1.f / 1024.f) + EPS);
    u32x2* o8 = (u32x2*)orow + lane;
#pragma unroll
    for (int j = 0; j < 4; ++j) { const f32x4 gg = ((const f32x4*)g)[lane + 64 * j]; u32x2 w; w.x = pk2(v[j].x * rs * gg.x, v[j].y * rs * gg.y); w.y = pk2(v[j].z * rs * gg.z, v[j].w * rs * gg.w); o8[64 * j] = w; }
}
__device__ __forceinline__ void phase0(const Params& p, LAS unsigned char* lds, int vb, int G) {
    const int tid = threadIdx.x, lane = tid & 63, wave = tid >> 6;
    const int gw = vb * NWAVES + wave, NGW = G * NWAVES;
    float* LB = (float*)(p.ws + WS_LB);
    for (int i = vb * NTHR + tid; i < 1024; i += G * NTHR) { const float l0 = p.in[10][i], l1 = p.in[10][1024 + i]; LB[i] = 1.0f / (1.0f + __expf(l1 - l0)); }
    LAS float* scr = (LAS float*)(lds + wave * 16384);
    constexpr int I1 = (D / 64) * (N1 / 32), I2 = (2048 / 64) * (D / 32), I3 = (D / 64) * (N3 / 32), I4 = I2;
    for (int it = gw; it < I1 + I2 + I3 + I4; it += NGW) {
        int r = it;
        if (r < I1) { transpose_item<1>(p.in[5], D, N1, (bf16_t*)(p.ws + WS_WT1), nullptr, scr, r, lane); continue; } r -= I1;
        if (r < I2) { transpose_item<0>(p.in[12], 2048, D, (bf16_t*)(p.ws + WS_WT2), nullptr, scr, r, lane); continue; } r -= I2;
        if (r < I3) { transpose_item<3>(p.in[14], D, N3, (bf16_t*)(p.ws + WS_WT3), p.in[13], scr, r, lane); continue; } r -= I3;
        transpose_item<0>(p.in[19], 2048, D, (bf16_t*)(p.ws + WS_WT4), nullptr, scr, r, lane);
    }
    bf16_t* XN0 = (bf16_t*)p.out;
    for (int r = gw; r < T; r += NGW) { const float* xr = r < TP ? p.in[0] + (size_t)r * D : p.in[1] + (size_t)(r - TP) * D; rms_row_to_bf16(xr, p.in[4], XN0 + (size_t)r * D, lane); }
}

struct Epi1 {
    bf16_t* Z; const float* LB;
    __device__ __forceinline__ float rowscale(int) const { return 1.f; }
    template <int X1M, int X2M> __device__ __forceinline__ void tile8(int row, int pn, int c0, const float (&lo)[8], const float (&hi)[8], float) const {
        if (pn < 8) { float a[8];
#pragma unroll
            for (int i = 0; i < 8; ++i) a[i] = lo[i] * sigm(hi[i]);
            st8(Z + (size_t)row * 1024 + 128 * pn + c0, a);
        } else {
            const int g = (pn - 8) >> 2, col = ((pn - 8) & 3) * 256 + c0;
            bf16_t* base = Z + (size_t)(g + 1) * T * 1024 + (size_t)row * 1024 + col;
            float x[8], y[8];
            if (g == 1) {
#pragma unroll
                for (int i = 0; i < 8; ++i) { x[i] = lo[i]; y[i] = hi[i]; }
            } else if (g == 2) {
#pragma unroll
                for (int i = 0; i < 8; ++i) { const float l0 = LB[col + i], l1 = LB[col + 128 + i]; x[i] = __logf(l0 + (1.f - l0) * sigm(lo[i])); y[i] = __logf(l1 + (1.f - l1) * sigm(hi[i])); }
            } else {
#pragma unroll
                for (int i = 0; i < 8; ++i) { x[i] = silu(lo[i]); y[i] = silu(hi[i]); }
            }
            st8(base, x); st8(base + 128, y);
        }
    }
};
struct Epi2 {
    const float* xp; const float* xs; float* X1; bf16_t* X1B; float* SSP;
    __device__ __forceinline__ float rowscale(int) const { return 1.f; }
    template <int X1M, int X2M> __device__ __forceinline__ void tile8(int row, int pn, int c0, const float (&lo)[8], const float (&hi)[8], float) const {
        const int col = 256 * pn + c0;
        const float* xr = (row < TP ? xp + (size_t)row * D : xs + (size_t)(row - TP) * D) + col;
        const f32x4 a0 = *(const f32x4*)xr, a1 = *(const f32x4*)(xr + 4), b0 = *(const f32x4*)(xr + 128), b1 = *(const f32x4*)(xr + 132);
        float v[8], w[8];
        v[0] = a0.x + lo[0]; v[1] = a0.y + lo[1]; v[2] = a0.z + lo[2]; v[3] = a0.w + lo[3]; v[4] = a1.x + lo[4]; v[5] = a1.y + lo[5]; v[6] = a1.z + lo[6]; v[7] = a1.w + lo[7];
        w[0] = b0.x + hi[0]; w[1] = b0.y + hi[1]; w[2] = b0.z + hi[2]; w[3] = b0.w + hi[3]; w[4] = b1.x + hi[4]; w[5] = b1.y + hi[5]; w[6] = b1.z + hi[6]; w[7] = b1.w + hi[7];
        float* o = X1 + (size_t)row * D + col;
        *(f32x4*)o = (f32x4){v[0], v[1], v[2], v[3]}; *(f32x4*)(o + 4) = (f32x4){v[4], v[5], v[6], v[7]};
        *(f32x4*)(o + 128) = (f32x4){w[0], w[1], w[2], w[3]}; *(f32x4*)(o + 132) = (f32x4){w[4], w[5], w[6], w[7]};
        bf16_t* ob = X1B + (size_t)row * D + col; st8(ob, v); st8(ob + 128, w);
        float ss = 0.f;
#pragma unroll
        for (int i = 0; i < 8; ++i) ss += v[i] * v[i] + w[i] * w[i];
        ss += __shfl_xor(ss, X1M); ss += __shfl_xor(ss, X2M);
        if ((c0 & 31) == 0) SSP[(size_t)row * 16 + pn * 4 + (c0 >> 5)] = ss;
    }
};
struct Epi3 {
    const float* SSP1; bf16_t* UG; bf16_t* GV; f32x2* VST;
    __device__ __forceinline__ float rowscale(int row) const {
        const f32x4* s = (const f32x4*)(SSP1 + (size_t)row * 16); const f32x4 a = s[0], b = s[1], c = s[2], d = s[3];
        const float t = ((a.x + a.y) + (a.z + a.w)) + ((b.x + b.y) + (b.z + b.w)) + ((c.x + c.y) + (c.z + c.w)) + ((d.x + d.y) + (d.z + d.w));
        return rsqrtf(t * (1.f / 1024.f) + EPS);
    }
    template <int X1M, int X2M> __device__ __forceinline__ void tile8(int row, int pn, int c0, const float (&lo)[8], const float (&hi)[8], float rs) const {
        if (pn < 16) { float a[8];
#pragma unroll
            for (int i = 0; i < 8; ++i) a[i] = gelu_t(lo[i] * rs) * silu(hi[i] * rs);
            st8(UG + (size_t)row * DC + 128 * pn + c0, a);
        } else {
            const int col = 256 * (pn - 16) + c0; float x[8], y[8], s = 0.f, q = 0.f;
#pragma unroll
            for (int i = 0; i < 8; ++i) { x[i] = gelu_t(lo[i] * rs); y[i] = gelu_t(hi[i] * rs); s += x[i] + y[i]; q += x[i] * x[i] + y[i] * y[i]; }
            bf16_t* o = GV + (size_t)row * DC + col; st8(o, x); st8(o + 128, y);
            s += __shfl_xor(s, X1M); q += __shfl_xor(q, X1M); s += __shfl_xor(s, X2M); q += __shfl_xor(q, X2M);
            if ((c0 & 31) == 0) VST[(size_t)row * 32 + (pn - 16) * 4 + (c0 >> 5)] = (f32x2){s, q};
        }
    }
};
struct Epi4 {
    const float* X1; float* Y; float* SSP;
    __device__ __forceinline__ float rowscale(int) const { return 1.f; }
    template <int X1M, int X2M> __device__ __forceinline__ void tile8(int row, int pn, int c0, const float (&lo)[8], const float (&hi)[8], float) const {
        const int col = 256 * pn + c0;
        const float* xr = X1 + (size_t)row * D + col;
        const f32x4 a0 = *(const f32x4*)xr, a1 = *(const f32x4*)(xr + 4), b0 = *(const f32x4*)(xr + 128), b1 = *(const f32x4*)(xr + 132);
        float v[8], w[8];
        v[0] = a0.x + lo[0]; v[1] = a0.y + lo[1]; v[2] = a0.z + lo[2]; v[3] = a0.w + lo[3]; v[4] = a1.x + lo[4]; v[5] = a1.y + lo[5]; v[6] = a1.z + lo[6]; v[7] = a1.w + lo[7];
        w[0] = b0.x + hi[0]; w[1] = b0.y + hi[1]; w[2] = b0.z + hi[2]; w[3] = b0.w + hi[3]; w[4] = b1.x + hi[4]; w[5] = b1.y + hi[5]; w[6] = b1.z + hi[6]; w[7] = b1.w + hi[7];
        float* o = Y + (size_t)row * D + col;
        *(f32x4*)o = (f32x4){v[0], v[1], v[2], v[3]}; *(f32x4*)(o + 4) = (f32x4){v[4], v[5], v[6], v[7]};
        *(f32x4*)(o + 128) = (f32x4){w[0], w[1], w[2], w[3]}; *(f32x4*)(o + 132) = (f32x4){w[4], w[5], w[6], w[7]};
        float ss = 0.f;
#pragma unroll
        for (int i = 0; i < 8; ++i) ss += v[i] * v[i] + w[i] * w[i];
        ss += __shfl_xor(ss, X1M); ss += __shfl_xor(ss, X2M);
        if ((c0 & 31) == 0) SSP[(size_t)row * 16 + pn * 4 + (c0 >> 5)] = ss;
    }
};

template <class Epi> __device__ __forceinline__ void gemm_simple(LAS unsigned char* lds, const bf16_t* A, const bf16_t* Bt, int M, int N, int K, const Epi& E, int vb, int G) {
    LAS bf16_t* sA = (LAS bf16_t*)lds;
    LAS bf16_t* sB = (LAS bf16_t*)(lds + 4096);
    const int tid = threadIdx.x, r = tid >> 4, c0 = (tid & 15) * 8;
    const int nN = N / 256, nunits = (M / 32) * nN;
    for (int u = vb; u < nunits; u += G) {
        const int ms = u / nN, pn = u % nN, row0 = ms * 32, col0 = pn * 256;
        float lo[8], hi[8];
#pragma unroll
        for (int i = 0; i < 8; ++i) { lo[i] = 0.f; hi[i] = 0.f; }
        for (int k0 = 0; k0 < K; k0 += 32) {
            __syncthreads();
            if (tid < 128) { const int rr = tid >> 2, kc = (tid & 3) * 8; *(LAS u32x4*)(sA + rr * 40 + kc) = *(const u32x4*)(A + (size_t)(row0 + rr) * K + k0 + kc); }
            for (int q = tid; q < 1024; q += NTHR) { const int rr = q >> 2, kc = (q & 3) * 8; *(LAS u32x4*)(sB + rr * 40 + kc) = *(const u32x4*)(Bt + (size_t)(col0 + rr) * K + k0 + kc); }
            __syncthreads();
#pragma unroll 1
            for (int kc = 0; kc < 32; kc += 8) {
                const u32x4 av = *(const LAS u32x4*)(sA + r * 40 + kc);
                const float a0 = bflo(av.x), a1 = bfhi(av.x), a2 = bflo(av.y), a3 = bfhi(av.y), a4 = bflo(av.z), a5 = bfhi(av.z), a6 = bflo(av.w), a7 = bfhi(av.w);
#pragma unroll
                for (int i = 0; i < 8; ++i) {
                    const u32x4 b = *(const LAS u32x4*)(sB + (c0 + i) * 40 + kc);
                    lo[i] += a0 * bflo(b.x) + a1 * bfhi(b.x) + a2 * bflo(b.y) + a3 * bfhi(b.y) + a4 * bflo(b.z) + a5 * bfhi(b.z) + a6 * bflo(b.w) + a7 * bfhi(b.w);
                    const u32x4 c = *(const LAS u32x4*)(sB + (128 + c0 + i) * 40 + kc);
                    hi[i] += a0 * bflo(c.x) + a1 * bfhi(c.x) + a2 * bflo(c.y) + a3 * bfhi(c.y) + a4 * bflo(c.z) + a5 * bfhi(c.z) + a6 * bflo(c.w) + a7 * bfhi(c.w);
                }
            }
        }
        const int row = row0 + r; const float rsc = E.rowscale(row);
        E.template tile8<1, 2>(row, pn, c0, lo, hi, rsc);
    }
}

namespace pg8 {
#define PG8_LAS __attribute__((address_space(3)))
constexpr int BM = 256, BK = 64, HALF = 128, HTB = HALF * BK * 2  , STAGE_BYTES = 8 * HTB, NXCD = 8, WGM = 8;

__host__ __device__ __forceinline__ int lds_byte(int r, int c) { const int st = (r >> 4) * 2 + (c >> 5), rr = r & 15, cc = c & 31, ob = rr * 64 + cc * 2; return st * 1024 + (ob ^ (((ob >> 9) & 1) << 5)); }
__host__ __device__ __forceinline__ void stage_rc(int b, int& R, int& C) { const int st = b / 1024, sb = b % 1024, swz = sb ^ (((sb >> 9) & 1) << 5); R = (st >> 1) * 16 + swz / 64; C = (st & 1) * 32 + (swz % 64) / 2; }
__host__ __device__ __forceinline__ int perm32(int rho) { const int n = rho >> 4, i = rho & 15; return 8 * (i >> 2) + 4 * n + (i & 3); }

struct Unit { int pm, pn; };
struct Gemm { const bf16_t* A; const bf16_t* Bt; int M, N, K; };

struct StaticOrder {
    int nM, nN, nwg, G, c;
    __host__ __device__ void init(int M, int N, int G_, int c_) { nM = M / BM; nN = N / BM; nwg = nM * nN; G = G_; c = c_; }
    __host__ __device__ bool next(int i, Unit& u) const {
        const long L = (long)i * G + c; if (L >= nwg) return false;
        int wgid = (int)L; { const int q = nwg / NXCD, r = nwg % NXCD, xcd = wgid % NXCD, off = wgid / NXCD; wgid = (xcd < r ? xcd * (q + 1) : r * (q + 1) + (xcd - r) * q) + off; }
        const int nig = WGM * nN, gid = wgid / nig, fm = gid * WGM, gsz = (nM - fm) < WGM ? (nM - fm) : WGM;
        u.pm = fm + ((wgid % nig) % gsz); u.pn = (wgid % nig) / gsz; return true;
    }
    __device__ __forceinline__ void a_ready(const Unit&) const {}
    __device__ __forceinline__ void done(const Unit&) const {}
};
template <class Epi, class Sched, bool ALIGN_EPI = false, bool SP2 = false>
__device__ __forceinline__ void gemm_phase(PG8_LAS unsigned char* lds, const Gemm g, const Sched& S, const Epi& E) {
    const int tid = threadIdx.x, wid = __builtin_amdgcn_readfirstlane(tid >> 6), lane = tid & 63, wr = wid >> 2, wc = wid & 3, fr = lane & 15, fq = lane >> 4;
    const int K = g.K, nt = K / BK;
    unsigned voffA[2], voffB[2];
#pragma unroll
    for (int i = 0; i < 2; ++i) { int R, C; stage_rc(tid * 16 + i * 8192, R, C); const int Rb = Epi::PERM ? ((R & ~31) + perm32(R & 31)) : R;
        voffA[i] = (unsigned)(R * K + C) * 2u; voffB[i] = (unsigned)(Rb * K + C) * 2u; }
    const size_t kstep = (size_t)(BK * 2);
    const size_t hstep = (size_t)HALF * K * 2;
    const size_t tstep = 2 * hstep;
    const unsigned ldsw = (unsigned)wid * 1024u;
    const int aoff = lds_byte(wr * 64 + fr, fq * 8), boff = lds_byte(wc * 32 + fr, fq * 8);
#define PG8_SA(b, h) (((b) * 2 + (h)) * HTB)
#define PG8_SB(b, h) ((4 + (b) * 2 + (h)) * HTB)
#define PG8_STAGE(bufoff, gbase, voff) do { _Pragma("unroll") for (int _i = 0; _i < 2; ++_i) \
        __builtin_amdgcn_global_load_lds((const unsigned*)((const char*)(gbase) + (voff)[_i]), (PG8_LAS unsigned*)(lds + (bufoff) + ldsw + _i * 8192), 16, 0, 0); } while (0)
#define PG8_LDA(dst, b, h) do { _Pragma("unroll") for (int m = 0; m < 4; ++m) _Pragma("unroll") for (int k = 0; k < 2; ++k) dst[m][k] = *(const PG8_LAS bf16x8*)(lds + PG8_SA(b, h) + aoff + m * 2048 + k * 1024); } while (0)
#define PG8_LDB(dst, b, h) do { _Pragma("unroll") for (int n = 0; n < 2; ++n) _Pragma("unroll") for (int k = 0; k < 2; ++k) dst[n][k] = *(const PG8_LAS bf16x8*)(lds + PG8_SB(b, h) + boff + n * 2048 + k * 1024); } while (0)
#define PG8_MMA(ai, bj, At, Bt) do { __builtin_amdgcn_s_setprio(1); _Pragma("unroll") for (int m = 0; m < 4; ++m) _Pragma("unroll") for (int n = 0; n < 2; ++n) _Pragma("unroll") for (int k = 0; k < 2; ++k) \
        acc[ai][bj][m][n] = __builtin_amdgcn_mfma_f32_16x16x32_bf16(Bt[n][k], At[m][k], acc[ai][bj][m][n], 0, 0, 0); __builtin_amdgcn_s_setprio(0); } while (0)
#define PG8_WAIT_V(n) asm volatile("s_waitcnt vmcnt(" #n ")" ::: "memory")
#define PG8_WAIT_L(n) asm volatile("s_waitcnt lgkmcnt(" #n ")" ::: "memory")
#define PG8_BAR __builtin_amdgcn_s_barrier()
#define PG8_SCHED __builtin_amdgcn_sched_barrier(0)
    Unit cur, nxt; int ui = 0;
    if (!S.next(0, cur)) return;
    f32x4 acc[2][2][4][2];
#pragma unroll
    for (int a = 0; a < 2; ++a)
#pragma unroll
        for (int b = 0; b < 2; ++b)
#pragma unroll
            for (int m = 0; m < 4; ++m)
#pragma unroll
                for (int n = 0; n < 2; ++n) acc[a][b][m][n] = (f32x4){0.f, 0.f, 0.f, 0.f};
    bf16x8 At[4][2], B0[2][2], B1[2][2];
    const char* cA = (const char*)g.A + (size_t)cur.pm * tstep; const char* cB = (const char*)g.Bt + (size_t)cur.pn * tstep;
    S.a_ready(cur);
    if constexpr (SP2) {
        PG8_STAGE(PG8_SB(0, 0), cB, voffB); PG8_STAGE(PG8_SB(0, 1), cB + hstep, voffB); PG8_STAGE(PG8_SA(0, 0), cA, voffA); PG8_STAGE(PG8_SA(0, 1), cA + hstep, voffA);
        if (wr == 1) PG8_BAR;
        PG8_WAIT_V(2); PG8_BAR;
        PG8_STAGE(PG8_SB(1, 0), cB + kstep, voffB); PG8_STAGE(PG8_SA(1, 0), cA + kstep, voffA); PG8_STAGE(PG8_SB(1, 1), cB + hstep + kstep, voffB);
        PG8_WAIT_V(6); PG8_BAR;
    } else {
        PG8_STAGE(PG8_SB(0, 0), cB, voffB); PG8_STAGE(PG8_SA(0, 0), cA, voffA); PG8_STAGE(PG8_SB(0, 1), cB + hstep, voffB); PG8_STAGE(PG8_SA(0, 1), cA + hstep, voffA);
        if (wr == 1) PG8_BAR;
        PG8_WAIT_V(4); PG8_BAR;
        PG8_STAGE(PG8_SB(1, 0), cB + kstep, voffB); PG8_STAGE(PG8_SA(1, 0), cA + kstep, voffA); PG8_STAGE(PG8_SB(1, 1), cB + hstep + kstep, voffB);
        PG8_WAIT_V(6); PG8_BAR;
    }
    for (;;) {
        const bool has_next = S.next(ui + 1, nxt);
        const char* nA = has_next ? (const char*)g.A + (size_t)nxt.pm * tstep : cA; const char* nB = has_next ? (const char*)g.Bt + (size_t)nxt.pn * tstep : cB;
        for (int t = 0; t < nt; t += 2) {
            const bool last = (t == nt - 2);
            const char* a1 = cA + (size_t)(t + 1) * kstep;
            const char* a2 = last ? nA : cA + (size_t)(t + 2) * kstep; const char* b2 = last ? nB : cB + (size_t)(t + 2) * kstep;
            const char* a3 = a2 + kstep; const char* b3 = b2 + kstep;
            if (last && has_next) S.a_ready(nxt);
            if constexpr (SP2) {
            PG8_LDB(B0, 0, 0); PG8_LDB(B1, 0, 1); PG8_SCHED; PG8_LDA(At, 0, 0); PG8_STAGE(PG8_SA(1, 1), a1 + hstep, voffA);
            PG8_WAIT_V(8); PG8_WAIT_L(0); PG8_BAR; PG8_MMA(0, 0, At, B0); PG8_MMA(0, 1, At, B1); PG8_BAR; PG8_SCHED;
            PG8_LDA(At, 0, 1); PG8_STAGE(PG8_SB(0, 0), b2, voffB); PG8_STAGE(PG8_SB(0, 1), b2 + hstep, voffB); PG8_STAGE(PG8_SA(0, 0), a2, voffA);
            PG8_WAIT_V(8); PG8_WAIT_L(0); PG8_BAR; PG8_MMA(1, 0, At, B0); PG8_MMA(1, 1, At, B1); PG8_BAR; PG8_SCHED;
            PG8_LDB(B0, 1, 0); PG8_LDB(B1, 1, 1); PG8_SCHED; PG8_LDA(At, 1, 0); PG8_STAGE(PG8_SA(0, 1), a2 + hstep, voffA);
            PG8_WAIT_V(8); PG8_WAIT_L(0); PG8_BAR; PG8_MMA(0, 0, At, B0); PG8_MMA(0, 1, At, B1); PG8_BAR; PG8_SCHED;
            PG8_LDA(At, 1, 1); PG8_STAGE(PG8_SB(1, 0), b3, voffB); PG8_STAGE(PG8_SB(1, 1), b3 + hstep, voffB); PG8_STAGE(PG8_SA(1, 0), a3, voffA);
            PG8_WAIT_V(8); PG8_WAIT_L(0); PG8_BAR; PG8_MMA(1, 0, At, B0); PG8_MMA(1, 1, At, B1); PG8_BAR; PG8_SCHED;
            } else {
            PG8_LDB(B0, 0, 0); PG8_SCHED; PG8_LDA(At, 0, 0); PG8_STAGE(PG8_SA(1, 1), a1 + hstep, voffA);
            PG8_WAIT_L(8); PG8_BAR; PG8_WAIT_L(0); PG8_MMA(0, 0, At, B0); PG8_BAR; PG8_SCHED;
            PG8_LDB(B1, 0, 1); PG8_STAGE(PG8_SB(0, 0), b2, voffB);
            PG8_BAR; PG8_WAIT_L(0); PG8_MMA(0, 1, At, B1); PG8_BAR;
            PG8_LDA(At, 0, 1); PG8_STAGE(PG8_SA(0, 0), a2, voffA);
            PG8_BAR; PG8_WAIT_L(0); PG8_MMA(1, 0, At, B0); PG8_BAR; PG8_SCHED;
            PG8_STAGE(PG8_SB(0, 1), b2 + hstep, voffB);
            PG8_WAIT_V(6); PG8_BAR; PG8_MMA(1, 1, At, B1); PG8_BAR;
            PG8_LDB(B0, 1, 0); PG8_SCHED; PG8_LDA(At, 1, 0); PG8_STAGE(PG8_SA(0, 1), a2 + hstep, voffA);
            PG8_WAIT_L(8); PG8_BAR; PG8_WAIT_L(0); PG8_MMA(0, 0, At, B0); PG8_BAR; PG8_SCHED;
            PG8_LDB(B1, 1, 1); PG8_STAGE(PG8_SB(1, 0), b3, voffB);
            PG8_BAR; PG8_WAIT_L(0); PG8_MMA(0, 1, At, B1); PG8_BAR;
            PG8_LDA(At, 1, 1); PG8_STAGE(PG8_SA(1, 0), a3, voffA);
            PG8_BAR; PG8_WAIT_L(0); PG8_MMA(1, 0, At, B0); PG8_BAR; PG8_SCHED;
            PG8_STAGE(PG8_SB(1, 1), b3 + hstep, voffB);
            PG8_WAIT_V(6); PG8_BAR; PG8_MMA(1, 1, At, B1); PG8_BAR;
            }
        }
        if constexpr (ALIGN_EPI) { if (wr == 0) PG8_BAR; }
        if constexpr (!Epi::AFTER_DRAIN) { E(acc, cur, wr, wc, fr, fq); S.done(cur); }
        if (!has_next) break;
#pragma unroll
        for (int a = 0; a < 2; ++a)
#pragma unroll
            for (int b = 0; b < 2; ++b)
#pragma unroll
                for (int m = 0; m < 4; ++m)
#pragma unroll
                    for (int n = 0; n < 2; ++n) acc[a][b][m][n] = (f32x4){0.f, 0.f, 0.f, 0.f};
        cur = nxt; cA = nA; cB = nB; ++ui;
        if constexpr (ALIGN_EPI) { if (wr == 1) PG8_BAR; }
    }
    PG8_WAIT_V(0);
    if constexpr (!ALIGN_EPI) { if (wr == 0) PG8_BAR; }
    PG8_BAR;
    if constexpr (Epi::AFTER_DRAIN) { E.fused(acc, cur, wr, wc, fr, fq, lds, wid, lane); S.done(cur); }
#undef PG8_SA
#undef PG8_SB
#undef PG8_STAGE
#undef PG8_LDA
#undef PG8_LDB
#undef PG8_MMA
#undef PG8_WAIT_V
#undef PG8_WAIT_L
#undef PG8_BAR
#undef PG8_SCHED
}
}

template <class E> struct EpiAd {
    static constexpr bool PERM = true, AFTER_DRAIN = false; E e;
    __device__ __forceinline__ void operator()(const f32x4 (&acc)[2][2][4][2], const pg8::Unit& u, int wr, int wc, int fr, int fq) const {
#pragma unroll
        for (int ai = 0; ai < 2; ++ai)
#pragma unroll
            for (int m = 0; m < 4; ++m) {
                const int row = u.pm * 256 + ai * 128 + wr * 64 + m * 16 + fr;
                const float rsc = e.rowscale(row);
                float lo[8], hi[8];
#pragma unroll
                for (int j = 0; j < 4; ++j) { lo[j] = acc[ai][0][m][0][j]; lo[4 + j] = acc[ai][0][m][1][j]; hi[j] = acc[ai][1][m][0][j]; hi[4 + j] = acc[ai][1][m][1][j]; }
                e.template tile8<16, 32>(row, u.pn, wc * 32 + 8 * fq, lo, hi, rsc);
            }
    }
};
template <class E> __device__ __forceinline__ void gemm_fast(LAS unsigned char* lds, const bf16_t* A, const bf16_t* Bt, int M, int N, int K, const E& e, int vb, int G) {
    pg8::Gemm g{A, Bt, M, N, K}; pg8::StaticOrder S; S.init(M, N, G, vb);
    EpiAd<E> Ea{e};
    pg8::gemm_phase<EpiAd<E>, pg8::StaticOrder, true, true>(lds, g, S, Ea);
}
#if FAST_GEMM
#define GEMM gemm_fast
#else
#define GEMM gemm_simple
#endif

__device__ __forceinline__ void conv_simple(const Params& p, LAS unsigned char* lds, int vb, int G) {
    LAS float* red = (LAS float*)lds;
    const bf16_t* A = (const bf16_t*)(p.ws + WS_R1); const bf16_t* SGA = A + (size_t)T * 1024; bf16_t* H0 = (bf16_t*)p.out;
    const float *cw = p.in[6], *cb = p.in[7], *lg = p.in[8], *lbeta = p.in[9], *sc = p.in[2];
    const int tid = threadIdx.x, c = tid * 2;
    for (int r = vb; r < T; r += G) {
        int t, rowbase; const float* hist;
        if (r < TP) { t = r & 2047; rowbase = r - t; hist = nullptr; } else { const int b = (r - TP) >> 3; t = (r - TP) & 7; rowbase = r - t; hist = sc + (size_t)b * 30 * 1024; }
        float y0 = cb[c], y1 = cb[c + 1];
        for (int j = 0; j < 31; ++j) { const int i = t + j - 30; float a0 = 0.f, a1 = 0.f;
            if (i >= 0) { const unsigned w = *(const unsigned*)(A + (size_t)(rowbase + i) * 1024 + c); a0 = bflo(w); a1 = bfhi(w); }
            else if (hist) { a0 = hist[(30 + i) * 1024 + c]; a1 = hist[(30 + i) * 1024 + c + 1]; }
            y0 += cw[j * 1024 + c] * a0; y1 += cw[j * 1024 + c + 1] * a1; }
        const float mean = block_sum(y0 + y1, red) * (1.f / 1024.f);
        const float d0 = y0 - mean, d1 = y1 - mean;
        const float rstd = rsqrtf(block_sum(d0 * d0 + d1 * d1, red) * (1.f / 1024.f) + EPS);
        const float n0 = d0 * rstd * lg[c] + lbeta[c], n1 = d1 * rstd * lg[c + 1] + lbeta[c + 1];
        const unsigned gw = *(const unsigned*)(SGA + (size_t)r * 1024 + c);
        *(unsigned*)(H0 + (size_t)r * 2048 + c) = pk2(silu(n0) * bflo(gw), silu(n1) * bfhi(gw));
    }
    for (int idx = vb * NTHR + tid; idx < 8 * 30 * 1024; idx += G * NTHR) { const int b = idx / 30720, rem = idx % 30720, i = rem >> 10, cc = rem & 1023;
        p.out[O_CP + idx] = bf2f(A[(size_t)(b * 2048 + 2018 + i) * 1024 + cc]); }
    for (int idx = vb * NTHR + tid; idx < 128 * 30 * 1024; idx += G * NTHR) { const int b = idx / 30720, rem = idx % 30720, i = rem >> 10, cc = rem & 1023;
        p.out[O_CS + idx] = (i < 22) ? sc[(size_t)(b * 30 + 8 + i) * 1024 + cc] : bf2f(A[(size_t)(TP + b * 8 + i - 22) * 1024 + cc]); }
}

__device__ __forceinline__ void hgrn_simple(const Params& p, LAS unsigned char* lds, int vb, int G, int item_lo, int item_hi) {
    LAS float* sf = (LAS float*)lds; LAS float* sk = sf + 1024; LAS float* sq = sk + 1024; LAS float* si = sq + 1024; LAS float* so = si + 1024; LAS float* so2 = so + 4096;
    const int tid = threadIdx.x, v = tid & 127, dq = tid >> 7, lane = tid & 63, wave = tid >> 6;
    const bf16_t* Z = (const bf16_t*)(p.ws + WS_R1);
    const bf16_t *Q = Z + (size_t)2 * T * 1024, *LOGF = Z + (size_t)3 * T * 1024, *I = Z + (size_t)4 * T * 1024, *SGB = Z + (size_t)5 * T * 1024;
    const float* og = p.in[11]; bf16_t* H0 = (bf16_t*)p.out;
    for (int item = item_lo + vb; item < item_hi; item += G) {
        int h, L, rowbase; const float* s0; float* sout;
        if (item < 64) { const int b = item >> 3; h = item & 7; L = 2048; rowbase = b * 2048; s0 = nullptr; sout = p.out + O_HP + (size_t)item * 16384; }
        else { const int it = item - 64, b = it >> 3; h = it & 7; L = 8; rowbase = TP + b * 8; s0 = p.in[3] + (size_t)it * 16384; sout = p.out + O_HS + (size_t)it * 16384; }
        float S[32];
#pragma unroll
        for (int j = 0; j < 32; ++j) S[j] = s0 ? s0[(dq * 32 + j) * 128 + v] : 0.f;
        for (int t0 = 0; t0 < L; t0 += 8) {
            __syncthreads();
            for (int e = tid; e < 1024; e += NTHR) { const int tt = e >> 7, d = e & 127; const size_t off = (size_t)(rowbase + t0 + tt) * 1024 + h * 128 + d;
                const float f = __expf(bf2f(LOGF[off])); sf[e] = f; sk[e] = 1.f - f; sq[e] = bf2f(Q[off]); si[e] = bf2f(I[off]); }
            __syncthreads();
#pragma unroll 1
            for (int tt = 0; tt < 8; ++tt) { const float iv = si[tt * 128 + v]; float op = 0.f;
#pragma unroll
                for (int j = 0; j < 32; ++j) { const int d = dq * 32 + j; S[j] = sf[tt * 128 + d] * S[j] + sk[tt * 128 + d] * iv; op += S[j] * sq[tt * 128 + d]; }
                so[(tt * 4 + dq) * 128 + v] = op; }
            __syncthreads();
            for (int e = tid; e < 1024; e += NTHR) { const int tt = e >> 7, vv = e & 127; so2[e] = (so[(tt * 4 + 0) * 128 + vv] + so[(tt * 4 + 1) * 128 + vv]) + (so[(tt * 4 + 2) * 128 + vv] + so[(tt * 4 + 3) * 128 + vv]); }
            __syncthreads();
            { const int tt = wave; const size_t row = (size_t)(rowbase + t0 + tt);
              const float o0 = so2[tt * 128 + lane], o1 = so2[tt * 128 + 64 + lane];
              const float rs = rsqrtf(wave_sum(o0 * o0 + o1 * o1) * (1.f / 128.f) + EPS);
              const float r0 = o0 * rs * og[h * 128 + lane] * bf2f(SGB[row * 1024 + h * 128 + lane]);
              const float r1 = o1 * rs * og[h * 128 + 64 + lane] * bf2f(SGB[row * 1024 + h * 128 + 64 + lane]);
              H0[row * 2048 + 1024 + h * 128 + lane] = (bf16_t)f2bf(r0); H0[row * 2048 + 1024 + h * 128 + 64 + lane] = (bf16_t)f2bf(r1); }
        }
#pragma unroll
        for (int j = 0; j < 32; ++j) sout[(dq * 32 + j) * 128 + v] = S[j];
    }
}

__device__ __forceinline__ void gmlp_simple(const Params& p, LAS unsigned char* lds, int vb, int G) {
    LAS float* smean = (LAS float*)lds; LAS float* srstd = smean + 128;
    const f32x2* VST = (const f32x2*)(p.ws + WS_VST); const bf16_t* GV = (const bf16_t*)p.out; bf16_t* UG = (bf16_t*)(p.ws + WS_UG);
    const float *lg = p.in[15], *lb_ = p.in[16], *wsp = p.in[17], *bs = p.in[18];
    const int tid = threadIdx.x, ch = tid * 4, h = tid >> 6;
    const f32x4 g4 = *(const f32x4*)(lg + ch), b4 = *(const f32x4*)(lb_ + ch);
    for (int r = vb; r < T; r += G) {
        int t, cstart;
        if (r < TP) { t = r & 127; cstart = r - t; } else { t = (r - TP) & 7; cstart = r - t; }
        __syncthreads();
        if (tid <= t) { const size_t row = (size_t)(cstart + tid); float s = 0.f, q = 0.f;
            for (int j = 0; j < 32; ++j) { const f32x2 st = VST[row * 32 + j]; s += st.x; q += st.y; }
            const float mean = s * (1.f / 2048.f); const float var = q * (1.f / 2048.f) - mean * mean; smean[tid] = mean; srstd[tid] = rsqrtf(var + EPS); }
        __syncthreads();
        float a0 = 0.f, a1 = 0.f, a2 = 0.f, a3 = 0.f, v0 = 0.f, v1 = 0.f, v2 = 0.f, v3 = 0.f;
        for (int s = 0; s <= t; ++s) {
            const float w = wsp[(size_t)(h * 128 + t) * 128 + s], m = smean[s], rs = srstd[s];
            const u32x2 gvw = *(const u32x2*)(GV + (size_t)(cstart + s) * DC + ch);
            v0 = (bflo(gvw.x) - m) * rs * g4.x + b4.x; v1 = (bfhi(gvw.x) - m) * rs * g4.y + b4.y; v2 = (bflo(gvw.y) - m) * rs * g4.z + b4.z; v3 = (bfhi(gvw.y) - m) * rs * g4.w + b4.w;
            a0 += w * v0; a1 += w * v1; a2 += w * v2; a3 += w * v3;
        }
        const float bias = bs[h * 128 + t];
        const u32x2 ugw = *(const u32x2*)(UG + (size_t)r * DC + ch);
        u32x2 o; o.x = pk2(bflo(ugw.x) * (a0 + bias), bfhi(ugw.x) * (a1 + bias)); o.y = pk2(bflo(ugw.y) * (a2 + bias), bfhi(ugw.y) * (a3 + bias));
        *(u32x2*)(UG + (size_t)r * DC + ch) = o;
        if (r < TP) { const int tt = (r & 2047) - 1920; if (tt >= 0) *(f32x4*)(p.out + O_GP + ((size_t)(r >> 11) * 128 + tt) * DC + ch) = (f32x4){v0, v1, v2, v3}; }
        else *(f32x4*)(p.out + O_GS + (size_t)(r - TP) * DC + ch) = (f32x4){v0, v1, v2, v3};
    }
}

__device__ __forceinline__ void final_norm(const Params& p, int vb, int G) {
    const int tid = threadIdx.x, lane = tid & 63, wave = tid >> 6;
    const int gw = vb * NWAVES + wave, NGW = G * NWAVES;
    const float* SSP = (const float*)(p.ws + WS_SSP2); const float* g = p.in[20];
    for (int r = gw; r < T; r += NGW) {
        const f32x4* s = (const f32x4*)(SSP + (size_t)r * 16); const f32x4 a = s[0], b = s[1], c = s[2], d = s[3];
        const float tot = ((a.x + a.y) + (a.z + a.w)) + ((b.x + b.y) + (b.z + b.w)) + ((c.x + c.y) + (c.z + c.w)) + ((d.x + d.y) + (d.z + d.w));
        const float rs = rsqrtf(tot * (1.f / 1024.f) + EPS);
        f32x4* y = (f32x4*)(p.out + (size_t)r * D) + lane;
#pragma unroll
        for (int j = 0; j < 4; ++j) { const f32x4 gg = ((const f32x4*)g)[lane + 64 * j]; f32x4 v = y[64 * j]; v.x *= rs * gg.x; v.y *= rs * gg.y; v.z *= rs * gg.z; v.w *= rs * gg.w; y[64 * j] = v; }
    }
}

__global__ void __launch_bounds__(NTHR, 2) fwd_kernel(Params p) {
    extern __shared__ __attribute__((aligned(16))) unsigned char lds_raw[];
    LAS unsigned char* lds = (LAS unsigned char*)lds_raw;
    cg::grid_group grid = cg::this_grid();
    const int G = gridDim.x, vb = blockIdx.x;
    bf16_t* WT1 = (bf16_t*)(p.ws + WS_WT1); bf16_t* WT2 = (bf16_t*)(p.ws + WS_WT2); bf16_t* WT3 = (bf16_t*)(p.ws + WS_WT3); bf16_t* WT4 = (bf16_t*)(p.ws + WS_WT4);
    bf16_t* ZR = (bf16_t*)(p.ws + WS_R1);

    phase0(p, lds, vb, G);
    grid.sync();
    { Epi1 E{ZR, (const float*)(p.ws + WS_LB)}; GEMM(lds, (const bf16_t*)p.out, WT1, T, N1, D, E, vb, G); }
    grid.sync();
    hgrn_simple(p, lds, vb, G, 0, 64 + 1024);
    conv_simple(p, lds, vb, G);
    grid.sync();
    { Epi2 E{p.in[0], p.in[1], (float*)(p.ws + WS_X1), (bf16_t*)(p.ws + WS_X1B), (float*)(p.ws + WS_SSP1)}; GEMM(lds, (const bf16_t*)p.out, WT2, T, D, 2048, E, vb, G); }
    grid.sync();
    { Epi3 E{(const float*)(p.ws + WS_SSP1), (bf16_t*)(p.ws + WS_UG), (bf16_t*)p.out, (f32x2*)(p.ws + WS_VST)}; GEMM(lds, (const bf16_t*)(p.ws + WS_X1B), WT3, T, N3, D, E, vb, G); }
    grid.sync();
    gmlp_simple(p, lds, vb, G);
    grid.sync();
    { Epi4 E{(const float*)(p.ws + WS_X1), p.out, (float*)(p.ws + WS_SSP2)}; GEMM(lds, (const bf16_t*)(p.ws + WS_UG), WT4, T, D, 2048, E, vb, G); }
    grid.sync();
    final_norm(p, vb, G);
}

extern "C" void kernel_launch(void* const* d_in, const int* in_sizes, int n_in, void* d_out, int out_size, void* d_ws, size_t ws_size, hipStream_t stream) {
    static int grid = 0;
    if (grid == 0) {
        if (n_in != 21 || (size_t)out_size != O_END || ws_size < WS_END) { fprintf(stderr, "kernel_launch: unexpected shapes: n_in %d out %d ws %zu\n", n_in, out_size, ws_size); grid = -1; return; }
        int dev = 0, cus = 0, per_cu = 0;
        if (hipGetDevice(&dev) != hipSuccess || hipDeviceGetAttribute(&cus, hipDeviceAttributeMultiprocessorCount, dev) != hipSuccess) { grid = -1; return; }
        if (hipFuncSetAttribute((const void*)fwd_kernel, hipFuncAttributeMaxDynamicSharedMemorySize, LDS_BYTES) != hipSuccess) { fprintf(stderr, "kernel_launch: hipFuncSetAttribute failed\n"); grid = -1; return; }
        if (hipOccupancyMaxActiveBlocksPerMultiprocessor(&per_cu, (const void*)fwd_kernel, NTHR, LDS_BYTES) != hipSuccess || per_cu < 1) { fprintf(stderr, "kernel_launch: occupancy query says %d\n", per_cu); grid = -1; return; }
        grid = cus;
    }
    if (grid < 0) return;
    Params p{};
    for (int i = 0; i < 21; ++i) p.in[i] = (const float*)d_in[i];
    p.out = (float*)d_out; p.ws = (unsigned char*)d_ws;
    void* args[] = {&p};
    hipError_t e = hipLaunchCooperativeKernel((const void*)fwd_kernel, dim3(grid), dim3(NTHR), args, LDS_BYTES, stream);
    if (e != hipSuccess) fprintf(stderr, "kernel_launch: cooperative launch failed: %s (grid %d)\n", hipGetErrorString(e), grid);
}
```

```cpp
#include <hip/hip_runtime.h>
#include <hip/hip_cooperative_groups.h>
#include <cstdio>
#include <cstdint>
namespace cg = cooperative_groups;

#ifndef FAST_GEMM
#define FAST_GEMM 1
#endif

#define LAS __attribute__((address_space(3)))
typedef unsigned short bf16_t;
typedef short bf16x8 __attribute__((ext_vector_type(8)));
typedef float f32x4 __attribute__((ext_vector_type(4)));
typedef float f32x2 __attribute__((ext_vector_type(2)));
typedef unsigned u32x4 __attribute__((ext_vector_type(4)));
typedef unsigned u32x2 __attribute__((ext_vector_type(2)));

constexpr int D = 1024, TP = 16384, TS = 1024, T = TP + TS;
constexpr int N1 = 7168, N3 = 6144, DC = 2048;
constexpr float EPS = 1e-6f;
constexpr int NWAVES = 8, NTHR = 512;
constexpr int LDS_BYTES = 147456;
constexpr size_t MiB = (size_t)1 << 20;
constexpr size_t WS_LB = 65536;
constexpr size_t WS_WT1 = 1 * MiB, WS_WT2 = 15 * MiB, WS_WT3 = 19 * MiB, WS_WT4 = 31 * MiB;
constexpr size_t WS_R1 = 35 * MiB;
constexpr size_t WS_X1 = WS_R1, WS_X1B = WS_R1 + 68 * MiB, WS_UG = WS_R1 + 102 * MiB;
constexpr size_t WS_SSP1 = WS_R1 + 170 * MiB, WS_VST = WS_R1 + 172 * MiB, WS_SSP2 = WS_R1 + 178 * MiB;
constexpr size_t WS_SEG = 239 * MiB;
constexpr size_t WS_END = 255 * MiB;
constexpr size_t O_YP = 0, O_YS = 16777216, O_CP = 17825792, O_HP = 18071552, O_GP = 19120128, O_CS = 21217280, O_HS = 25149440, O_GS = 41926656, O_END = 44023808;

struct Params { const float* in[21]; float* out; unsigned char* ws; };

__device__ __forceinline__ float bf2f(unsigned b) { return __uint_as_float(b << 16); }
__device__ __forceinline__ float bflo(unsigned w) { return __uint_as_float(w << 16); }
__device__ __forceinline__ float bfhi(unsigned w) { return __uint_as_float(w & 0xffff0000u); }
__device__ __forceinline__ unsigned f2bf(float f) { unsigned u = __float_as_uint(f); return (u + 0x7fffu + ((u >> 16) & 1u)) >> 16; }
__device__ __forceinline__ unsigned pk2(float lo, float hi) { return f2bf(lo) | (f2bf(hi) << 16); }
__device__ __forceinline__ float sigm(float x) { return 1.0f / (1.0f + __expf(-x)); }
__device__ __forceinline__ float silu(float x) { return x * sigm(x); }
__device__ __forceinline__ float gelu_t(float x) { return x * sigm(1.5957691216057308f * (x + 0.044715f * x * x * x)); }
__device__ __forceinline__ float wave_sum(float v) {
#pragma unroll
    for (int o = 1; o < 64; o <<= 1) v += __shfl_xor(v, o);
    return v;
}
__device__ __forceinline__ void st8(bf16_t* p, const float (&v)[8]) {
    u32x4 w; w.x = pk2(v[0], v[1]); w.y = pk2(v[2], v[3]); w.z = pk2(v[4], v[5]); w.w = pk2(v[6], v[7]); *(u32x4*)p = w;
}
__device__ __forceinline__ float block_sum(float v, LAS float* red) {
    v = wave_sum(v);
    __syncthreads();
    if ((threadIdx.x & 63) == 0) red[threadIdx.x >> 6] = v;
    __syncthreads();
    float s = 0.f;
#pragma unroll
    for (int i = 0; i < 8; ++i) s += red[i];
    return s;
}

template <int MAP> __device__ __forceinline__ int vmap(int vc) {
    const int vt = vc >> 8, c = vc & 255;
    if (MAP == 1) return vt < 8 ? (c < 128 ? 128 * vt + c : 1024 + 128 * vt + (c - 128)) : vc;
    if (MAP == 3) return vt < 16 ? (c < 128 ? 128 * vt + c : 4096 + 128 * vt + (c - 128)) : vc - 2048;
    return vc;
}

template <int MAP> __device__ __forceinline__ void transpose_item(const float* W, int K, int N, bf16_t* WT, const float* kscale, LAS float* scr, int item, int lane) {
    const int nblk = N / 32, kb = item / nblk, nb = item % nblk, k0 = 64 * kb, n0 = 32 * nb;
    const int on0 = vmap<MAP>(n0);
#pragma unroll 8
    for (int i = 0; i < 32; ++i) { const int kk = 2 * i + (lane >> 5); float w = W[(size_t)(k0 + kk) * N + on0 + (lane & 31)]; if (kscale) w *= kscale[k0 + kk]; scr[kk * 33 + (lane & 31)] = w; }
    asm volatile("s_waitcnt lgkmcnt(0)" ::: "memory");
    const int c = lane & 7;
#pragma unroll
    for (int j = 0; j < 4; ++j) { const int n = (lane >> 3) + 8 * j; const LAS float* s = scr + (8 * c) * 33 + n;
        u32x4 o; o.x = pk2(s[0 * 33], s[1 * 33]); o.y = pk2(s[2 * 33], s[3 * 33]); o.z = pk2(s[4 * 33], s[5 * 33]); o.w = pk2(s[6 * 33], s[7 * 33]);
        *(u32x4*)(WT + (size_t)(n0 + n) * K + k0 + 8 * c) = o; }
    asm volatile("s_waitcnt lgkmcnt(0)" ::: "memory");
}
__device__ __forceinline__ void rms_row_to_bf16(const float* xrow, const float* g, bf16_t* orow, int lane) {
    const f32x4* xr = (const f32x4*)xrow + lane; f32x4 v[4]; float s = 0.f;
#pragma unroll
    for (int j = 0; j < 4; ++j) { v[j] = xr[64 * j]; s += (v[j].x * v[j].x + v[j].y * v[j].y) + (v[j].z * v[j].z + v[j].w * v[j].w); }
    const float rs = rsqrtf(wave_sum(s) * (1.f / 1024.f) + EPS);
    u32x2* o8 = (u32x2*)orow + lane;
#pragma unroll
    for (int j = 0; j < 4; ++j) { const f32x4 gg = ((const f32x4*)g)[lane + 64 * j]; u32x2 w; w.x = pk2(v[j].x * rs * gg.x, v[j].y * rs * gg.y); w.y = pk2(v[j].z * rs * gg.z, v[j].w * rs * gg.w); o8[64 * j] = w; }
}
__device__ __forceinline__ void phase0(const Params& p, LAS unsigned char* lds, int vb, int G) {
    const int tid = threadIdx.x, lane = tid & 63, wave = tid >> 6;
    const int gw = vb * NWAVES + wave, NGW = G * NWAVES;
    float* LB = (float*)(p.ws + WS_LB);
    for (int i = vb * NTHR + tid; i < 1024; i += G * NTHR) { const float l0 = p.in[10][i], l1 = p.in[10][1024 + i]; LB[i] = 1.0f / (1.0f + __expf(l1 - l0)); }
    LAS float* scr = (LAS float*)(lds + wave * 16384);
    constexpr int I1 = (D / 64) * (N1 / 32), I2 = (2048 / 64) * (D / 32), I3 = (D / 64) * (N3 / 32), I4 = I2;
    for (int it = gw; it < I1 + I2 + I3 + I4; it += NGW) {
        int r = it;
        if (r < I1) { transpose_item<1>(p.in[5], D, N1, (bf16_t*)(p.ws + WS_WT1), nullptr, scr, r, lane); continue; } r -= I1;
        if (r < I2) { transpose_item<0>(p.in[12], 2048, D, (bf16_t*)(p.ws + WS_WT2), nullptr, scr, r, lane); continue; } r -= I2;
        if (r < I3) { transpose_item<3>(p.in[14], D, N3, (bf16_t*)(p.ws + WS_WT3), p.in[13], scr, r, lane); continue; } r -= I3;
        transpose_item<0>(p.in[19], 2048, D, (bf16_t*)(p.ws + WS_WT4), nullptr, scr, r, lane);
    }
    bf16_t* XN0 = (bf16_t*)p.out;
    for (int r = gw; r < T; r += NGW) { const float* xr = r < TP ? p.in[0] + (size_t)r * D : p.in[1] + (size_t)(r - TP) * D; rms_row_to_bf16(xr, p.in[4], XN0 + (size_t)r * D, lane); }
}

struct Epi1 {
    bf16_t* Z; const float* LB;
    __device__ __forceinline__ float rowscale(int) const { return 1.f; }
    template <int X1M, int X2M> __device__ __forceinline__ void tile8(int row, int pn, int c0, const float (&lo)[8], const float (&hi)[8], float) const {
        if (pn < 8) { float a[8];
#pragma unroll
            for (int i = 0; i < 8; ++i) a[i] = lo[i] * sigm(hi[i]);
            st8(Z + (size_t)row * 1024 + 128 * pn + c0, a);
        } else {
            const int g = (pn - 8) >> 2, col = ((pn - 8) & 3) * 256 + c0;
            bf16_t* base = Z + (size_t)(g + 1) * T * 1024 + (size_t)row * 1024 + col;
            float x[8], y[8];
            if (g == 1) {
#pragma unroll
                for (int i = 0; i < 8; ++i) { x[i] = lo[i]; y[i] = hi[i]; }
            } else if (g == 2) {
#pragma unroll
                for (int i = 0; i < 8; ++i) { const float l0 = LB[col + i], l1 = LB[col + 128 + i]; x[i] = __logf(l0 + (1.f - l0) * sigm(lo[i])); y[i] = __logf(l1 + (1.f - l1) * sigm(hi[i])); }
            } else {
#pragma unroll
                for (int i = 0; i < 8; ++i) { x[i] = silu(lo[i]); y[i] = silu(hi[i]); }
            }
            st8(base, x); st8(base + 128, y);
        }
    }
};
struct Epi2 {
    const float* xp; const float* xs; float* X1; bf16_t* X1B; float* SSP;
    __device__ __forceinline__ float rowscale(int) const { return 1.f; }
    template <int X1M, int X2M> __device__ __forceinline__ void tile8(int row, int pn, int c0, const float (&lo)[8], const float (&hi)[8], float) const {
        const int col = 256 * pn + c0;
        const float* xr = (row < TP ? xp + (size_t)row * D : xs + (size_t)(row - TP) * D) + col;
        const f32x4 a0 = *(const f32x4*)xr, a1 = *(const f32x4*)(xr + 4), b0 = *(const f32x4*)(xr + 128), b1 = *(const f32x4*)(xr + 132);
        float v[8], w[8];
        v[0] = a0.x + lo[0]; v[1] = a0.y + lo[1]; v[2] = a0.z + lo[2]; v[3] = a0.w + lo[3]; v[4] = a1.x + lo[4]; v[5] = a1.y + lo[5]; v[6] = a1.z + lo[6]; v[7] = a1.w + lo[7];
        w[0] = b0.x + hi[0]; w[1] = b0.y + hi[1]; w[2] = b0.z + hi[2]; w[3] = b0.w + hi[3]; w[4] = b1.x + hi[4]; w[5] = b1.y + hi[5]; w[6] = b1.z + hi[6]; w[7] = b1.w + hi[7];
        float* o = X1 + (size_t)row * D + col;
        *(f32x4*)o = (f32x4){v[0], v[1], v[2], v[3]}; *(f32x4*)(o + 4) = (f32x4){v[4], v[5], v[6], v[7]};
        *(f32x4*)(o + 128) = (f32x4){w[0], w[1], w[2], w[3]}; *(f32x4*)(o + 132) = (f32x4){w[4], w[5], w[6], w[7]};
        bf16_t* ob = X1B + (size_t)row * D + col; st8(ob, v); st8(ob + 128, w);
        float ss = 0.f;
#pragma unroll
        for (int i = 0; i < 8; ++i) ss += v[i] * v[i] + w[i] * w[i];
        ss += __shfl_xor(ss, X1M); ss += __shfl_xor(ss, X2M);
        if ((c0 & 31) == 0) SSP[(size_t)row * 16 + pn * 4 + (c0 >> 5)] = ss;
    }
};
struct Epi3 {
    const float* SSP1; bf16_t* UG; bf16_t* GV; f32x2* VST;
    __device__ __forceinline__ float rowscale(int row) const {
        const f32x4* s = (const f32x4*)(SSP1 + (size_t)row * 16); const f32x4 a = s[0], b = s[1], c = s[2], d = s[3];
        const float t = ((a.x + a.y) + (a.z + a.w)) + ((b.x + b.y) + (b.z + b.w)) + ((c.x + c.y) + (c.z + c.w)) + ((d.x + d.y) + (d.z + d.w));
        return rsqrtf(t * (1.f / 1024.f) + EPS);
    }
    template <int X1M, int X2M> __device__ __forceinline__ void tile8(int row, int pn, int c0, const float (&lo)[8], const float (&hi)[8], float rs) const {
        if (pn < 16) { float a[8];
#pragma unroll
            for (int i = 0; i < 8; ++i) a[i] = gelu_t(lo[i] * rs) * silu(hi[i] * rs);
            st8(UG + (size_t)row * DC + 128 * pn + c0, a);
        } else {
            const int col = 256 * (pn - 16) + c0; float x[8], y[8], s = 0.f, q = 0.f;
#pragma unroll
            for (int i = 0; i < 8; ++i) { x[i] = gelu_t(lo[i] * rs); y[i] = gelu_t(hi[i] * rs); s += x[i] + y[i]; q += x[i] * x[i] + y[i] * y[i]; }
            bf16_t* o = GV + (size_t)row * DC + col; st8(o, x); st8(o + 128, y);
            s += __shfl_xor(s, X1M); q += __shfl_xor(q, X1M); s += __shfl_xor(s, X2M); q += __shfl_xor(q, X2M);
            if ((c0 & 31) == 0) VST[(size_t)row * 32 + (pn - 16) * 4 + (c0 >> 5)] = (f32x2){s, q};
        }
    }
};
struct Epi4 {
    const float* X1; float* Y; float* SSP;
    __device__ __forceinline__ float rowscale(int) const { return 1.f; }
    template <int X1M, int X2M> __device__ __forceinline__ void tile8(int row, int pn, int c0, const float (&lo)[8], const float (&hi)[8], float) const {
        const int col = 256 * pn + c0;
        const float* xr = X1 + (size_t)row * D + col;
        const f32x4 a0 = *(const f32x4*)xr, a1 = *(const f32x4*)(xr + 4), b0 = *(const f32x4*)(xr + 128), b1 = *(const f32x4*)(xr + 132);
        float v[8], w[8];
        v[0] = a0.x + lo[0]; v[1] = a0.y + lo[1]; v[2] = a0.z + lo[2]; v[3] = a0.w + lo[3]; v[4] = a1.x + lo[4]; v[5] = a1.y + lo[5]; v[6] = a1.z + lo[6]; v[7] = a1.w + lo[7];
        w[0] = b0.x + hi[0]; w[1] = b0.y + hi[1]; w[2] = b0.z + hi[2]; w[3] = b0.w + hi[3]; w[4] = b1.x + hi[4]; w[5] = b1.y + hi[5]; w[6] = b1.z + hi[6]; w[7] = b1.w + hi[7];
        float* o = Y + (size_t)row * D + col;
        *(f32x4*)o = (f32x4){v[0], v[1], v[2], v[3]}; *(f32x4*)(o + 4) = (f32x4){v[4], v[5], v[6], v[7]};
        *(f32x4*)(o + 128) = (f32x4){w[0], w[1], w[2], w[3]}; *(f32x4*)(o + 132) = (f32x4){w[4], w[5], w[6], w[7]};
        float ss = 0.f;
#pragma unroll
        for (int i = 0; i < 8; ++i) ss += v[i] * v[i] + w[i] * w[i];
        ss += __shfl_xor(ss, X1M); ss += __shfl_xor(ss, X2M);
        if ((c0 & 31) == 0) SSP[(size_t)row * 16 + pn * 4 + (c0 >> 5)] = ss;
    }
};

template <class Epi> __device__ __forceinline__ void gemm_simple(LAS unsigned char* lds, const bf16_t* A, const bf16_t* Bt, int M, int N, int K, const Epi& E, int vb, int G) {
    LAS bf16_t* sA = (LAS bf16_t*)lds;
    LAS bf16_t* sB = (LAS bf16_t*)(lds + 4096);
    const int tid = threadIdx.x, r = tid >> 4, c0 = (tid & 15) * 8;
    const int nN = N / 256, nunits = (M / 32) * nN;
    for (int u = vb; u < nunits; u += G) {
        const int ms = u / nN, pn = u % nN, row0 = ms * 32, col0 = pn * 256;
        float lo[8], hi[8];
#pragma unroll
        for (int i = 0; i < 8; ++i) { lo[i] = 0.f; hi[i] = 0.f; }
        for (int k0 = 0; k0 < K; k0 += 32) {
            __syncthreads();
            if (tid < 128) { const int rr = tid >> 2, kc = (tid & 3) * 8; *(LAS u32x4*)(sA + rr * 40 + kc) = *(const u32x4*)(A + (size_t)(row0 + rr) * K + k0 + kc); }
            for (int q = tid; q < 1024; q += NTHR) { const int rr = q >> 2, kc = (q & 3) * 8; *(LAS u32x4*)(sB + rr * 40 + kc) = *(const u32x4*)(Bt + (size_t)(col0 + rr) * K + k0 + kc); }
            __syncthreads();
#pragma unroll 1
            for (int kc = 0; kc < 32; kc += 8) {
                const u32x4 av = *(const LAS u32x4*)(sA + r * 40 + kc);
                const float a0 = bflo(av.x), a1 = bfhi(av.x), a2 = bflo(av.y), a3 = bfhi(av.y), a4 = bflo(av.z), a5 = bfhi(av.z), a6 = bflo(av.w), a7 = bfhi(av.w);
#pragma unroll
                for (int i = 0; i < 8; ++i) {
                    const u32x4 b = *(const LAS u32x4*)(sB + (c0 + i) * 40 + kc);
                    lo[i] += a0 * bflo(b.x) + a1 * bfhi(b.x) + a2 * bflo(b.y) + a3 * bfhi(b.y) + a4 * bflo(b.z) + a5 * bfhi(b.z) + a6 * bflo(b.w) + a7 * bfhi(b.w);
                    const u32x4 c = *(const LAS u32x4*)(sB + (128 + c0 + i) * 40 + kc);
                    hi[i] += a0 * bflo(c.x) + a1 * bfhi(c.x) + a2 * bflo(c.y) + a3 * bfhi(c.y) + a4 * bflo(c.z) + a5 * bfhi(c.z) + a6 * bflo(c.w) + a7 * bfhi(c.w);
                }
            }
        }
        const int row = row0 + r; const float rsc = E.rowscale(row);
        E.template tile8<1, 2>(row, pn, c0, lo, hi, rsc);
    }
}

namespace pg8 {
#define PG8_LAS __attribute__((address_space(3)))
constexpr int BM = 256, BK = 64, HALF = 128, HTB = HALF * BK * 2  , STAGE_BYTES = 8 * HTB, NXCD = 8, WGM = 8;

__host__ __device__ __forceinline__ int lds_byte(int r, int c) { const int st = (r >> 4) * 2 + (c >> 5), rr = r & 15, cc = c & 31, ob = rr * 64 + cc * 2; return st * 1024 + (ob ^ (((ob >> 9) & 1) << 5)); }
__host__ __device__ __forceinline__ void stage_rc(int b, int& R, int& C) { const int st = b / 1024, sb = b % 1024, swz = sb ^ (((sb >> 9) & 1) << 5); R = (st >> 1) * 16 + swz / 64; C = (st & 1) * 32 + (swz % 64) / 2; }
__host__ __device__ __forceinline__ int perm32(int rho) { const int n = rho >> 4, i = rho & 15; return 8 * (i >> 2) + 4 * n + (i & 3); }

struct Unit { int pm, pn; };
struct Gemm { const bf16_t* A; const bf16_t* Bt; int M, N, K; };

struct StaticOrder {
    int nM, nN, nwg, G, c;
    __host__ __device__ void init(int M, int N, int G_, int c_) { nM = M / BM; nN = N / BM; nwg = nM * nN; G = G_; c = c_; }
    __host__ __device__ bool next(int i, Unit& u) const {
        const long L = (long)i * G + c; if (L >= nwg) return false;
        int wgid = (int)L; { const int q = nwg / NXCD, r = nwg % NXCD, xcd = wgid % NXCD, off = wgid / NXCD; wgid = (xcd < r ? xcd * (q + 1) : r * (q + 1) + (xcd - r) * q) + off; }
        const int nig = WGM * nN, gid = wgid / nig, fm = gid * WGM, gsz = (nM - fm) < WGM ? (nM - fm) : WGM;
        u.pm = fm + ((wgid % nig) % gsz); u.pn = (wgid % nig) / gsz; return true;
    }
    __device__ __forceinline__ void a_ready(const Unit&) const {}
    __device__ __forceinline__ void done(const Unit&) const {}
};
template <class Epi, class Sched, bool ALIGN_EPI = false, bool SP2 = false>
__device__ __forceinline__ void gemm_phase(PG8_LAS unsigned char* lds, const Gemm g, const Sched& S, const Epi& E) {
    const int tid = threadIdx.x, wid = __builtin_amdgcn_readfirstlane(tid >> 6), lane = tid & 63, wr = wid >> 2, wc = wid & 3, fr = lane & 15, fq = lane >> 4;
    const int K = g.K, nt = K / BK;
    unsigned voffA[2], voffB[2];
#pragma unroll
    for (int i = 0; i < 2; ++i) { int R, C; stage_rc(tid * 16 + i * 8192, R, C); const int Rb = Epi::PERM ? ((R & ~31) + perm32(R & 31)) : R;
        voffA[i] = (unsigned)(R * K + C) * 2u; voffB[i] = (unsigned)(Rb * K + C) * 2u; }
    const size_t kstep = (size_t)(BK * 2);
    const size_t hstep = (size_t)HALF * K * 2;
    const size_t tstep = 2 * hstep;
    const unsigned ldsw = (unsigned)wid * 1024u;
    const int aoff = lds_byte(wr * 64 + fr, fq * 8), boff = lds_byte(wc * 32 + fr, fq * 8);
#define PG8_SA(b, h) (((b) * 2 + (h)) * HTB)
#define PG8_SB(b, h) ((4 + (b) * 2 + (h)) * HTB)
#define PG8_STAGE(bufoff, gbase, voff) do { _Pragma("unroll") for (int _i = 0; _i < 2; ++_i) \
        __builtin_amdgcn_global_load_lds((const unsigned*)((const char*)(gbase) + (voff)[_i]), (PG8_LAS unsigned*)(lds + (bufoff) + ldsw + _i * 8192), 16, 0, 0); } while (0)
#define PG8_LDA(dst, b, h) do { _Pragma("unroll") for (int m = 0; m < 4; ++m) _Pragma("unroll") for (int k = 0; k < 2; ++k) dst[m][k] = *(const PG8_LAS bf16x8*)(lds + PG8_SA(b, h) + aoff + m * 2048 + k * 1024); } while (0)
#define PG8_LDB(dst, b, h) do { _Pragma("unroll") for (int n = 0; n < 2; ++n) _Pragma("unroll") for (int k = 0; k < 2; ++k) dst[n][k] = *(const PG8_LAS bf16x8*)(lds + PG8_SB(b, h) + boff + n * 2048 + k * 1024); } while (0)
#define PG8_MMA(ai, bj, At, Bt) do { __builtin_amdgcn_s_setprio(1); _Pragma("unroll") for (int m = 0; m < 4; ++m) _Pragma("unroll") for (int n = 0; n < 2; ++n) _Pragma("unroll") for (int k = 0; k < 2; ++k) \
        acc[ai][bj][m][n] = __builtin_amdgcn_mfma_f32_16x16x32_bf16(Bt[n][k], At[m][k], acc[ai][bj][m][n], 0, 0, 0); __builtin_amdgcn_s_setprio(0); } while (0)
#define PG8_WAIT_V(n) asm volatile("s_waitcnt vmcnt(" #n ")" ::: "memory")
#define PG8_WAIT_L(n) asm volatile("s_waitcnt lgkmcnt(" #n ")" ::: "memory")
#define PG8_BAR __builtin_amdgcn_s_barrier()
#define PG8_SCHED __builtin_amdgcn_sched_barrier(0)
    Unit cur, nxt; int ui = 0;
    if (!S.next(0, cur)) return;
    f32x4 acc[2][2][4][2];
#pragma unroll
    for (int a = 0; a < 2; ++a)
#pragma unroll
        for (int b = 0; b < 2; ++b)
#pragma unroll
            for (int m = 0; m < 4; ++m)
#pragma unroll
                for (int n = 0; n < 2; ++n) acc[a][b][m][n] = (f32x4){0.f, 0.f, 0.f, 0.f};
    bf16x8 At[4][2], B0[2][2], B1[2][2];
    const char* cA = (const char*)g.A + (size_t)cur.pm * tstep; const char* cB = (const char*)g.Bt + (size_t)cur.pn * tstep;
    S.a_ready(cur);
    if constexpr (SP2) {
        PG8_STAGE(PG8_SB(0, 0), cB, voffB); PG8_STAGE(PG8_SB(0, 1), cB + hstep, voffB); PG8_STAGE(PG8_SA(0, 0), cA, voffA); PG8_STAGE(PG8_SA(0, 1), cA + hstep, voffA);
        if (wr == 1) PG8_BAR;
        PG8_WAIT_V(2); PG8_BAR;
        PG8_STAGE(PG8_SB(1, 0), cB + kstep, voffB); PG8_STAGE(PG8_SA(1, 0), cA + kstep, voffA); PG8_STAGE(PG8_SB(1, 1), cB + hstep + kstep, voffB);
        PG8_WAIT_V(6); PG8_BAR;
    } else {
        PG8_STAGE(PG8_SB(0, 0), cB, voffB); PG8_STAGE(PG8_SA(0, 0), cA, voffA); PG8_STAGE(PG8_SB(0, 1), cB + hstep, voffB); PG8_STAGE(PG8_SA(0, 1), cA + hstep, voffA);
        if (wr == 1) PG8_BAR;
        PG8_WAIT_V(4); PG8_BAR;
        PG8_STAGE(PG8_SB(1, 0), cB + kstep, voffB); PG8_STAGE(PG8_SA(1, 0), cA + kstep, voffA); PG8_STAGE(PG8_SB(1, 1), cB + hstep + kstep, voffB);
        PG8_WAIT_V(6); PG8_BAR;
    }
    for (;;) {
        const bool has_next = S.next(ui + 1, nxt);
        const char* nA = has_next ? (const char*)g.A + (size_t)nxt.pm * tstep : cA; const char* nB = has_next ? (const char*)g.Bt + (size_t)nxt.pn * tstep : cB;
        for (int t = 0; t < nt; t += 2) {
            const bool last = (t == nt - 2);
            const char* a1 = cA + (size_t)(t + 1) * kstep;
            const char* a2 = last ? nA : cA + (size_t)(t + 2) * kstep; const char* b2 = last ? nB : cB + (size_t)(t + 2) * kstep;
            const char* a3 = a2 + kstep; const char* b3 = b2 + kstep;
            if (last && has_next) S.a_ready(nxt);
            if constexpr (SP2) {
            PG8_LDB(B0, 0, 0); PG8_LDB(B1, 0, 1); PG8_SCHED; PG8_LDA(At, 0, 0); PG8_STAGE(PG8_SA(1, 1), a1 + hstep, voffA);
            PG8_WAIT_V(8); PG8_WAIT_L(0); PG8_BAR; PG8_MMA(0, 0, At, B0); PG8_MMA(0, 1, At, B1); PG8_BAR; PG8_SCHED;
            PG8_LDA(At, 0, 1); PG8_STAGE(PG8_SB(0, 0), b2, voffB); PG8_STAGE(PG8_SB(0, 1), b2 + hstep, voffB); PG8_STAGE(PG8_SA(0, 0), a2, voffA);
            PG8_WAIT_V(8); PG8_WAIT_L(0); PG8_BAR; PG8_MMA(1, 0, At, B0); PG8_MMA(1, 1, At, B1); PG8_BAR; PG8_SCHED;
            PG8_LDB(B0, 1, 0); PG8_LDB(B1, 1, 1); PG8_SCHED; PG8_LDA(At, 1, 0); PG8_STAGE(PG8_SA(0, 1), a2 + hstep, voffA);
            PG8_WAIT_V(8); PG8_WAIT_L(0); PG8_BAR; PG8_MMA(0, 0, At, B0); PG8_MMA(0, 1, At, B1); PG8_BAR; PG8_SCHED;
            PG8_LDA(At, 1, 1); PG8_STAGE(PG8_SB(1, 0), b3, voffB); PG8_STAGE(PG8_SB(1, 1), b3 + hstep, voffB); PG8_STAGE(PG8_SA(1, 0), a3, voffA);
            PG8_WAIT_V(8); PG8_WAIT_L(0); PG8_BAR; PG8_MMA(1, 0, At, B0); PG8_MMA(1, 1, At, B1); PG8_BAR; PG8_SCHED;
            } else {
            PG8_LDB(B0, 0, 0); PG8_SCHED; PG8_LDA(At, 0, 0); PG8_STAGE(PG8_SA(1, 1), a1 + hstep, voffA);
            PG8_WAIT_L(8); PG8_BAR; PG8_WAIT_L(0); PG8_MMA(0, 0, At, B0); PG8_BAR; PG8_SCHED;
            PG8_LDB(B1, 0, 1); PG8_STAGE(PG8_SB(0, 0), b2, voffB);
            PG8_BAR; PG8_WAIT_L(0); PG8_MMA(0, 1, At, B1); PG8_BAR;
            PG8_LDA(At, 0, 1); PG8_STAGE(PG8_SA(0, 0), a2, voffA);
            PG8_BAR; PG8_WAIT_L(0); PG8_MMA(1, 0, At, B0); PG8_BAR; PG8_SCHED;
            PG8_STAGE(PG8_SB(0, 1), b2 + hstep, voffB);
            PG8_WAIT_V(6); PG8_BAR; PG8_MMA(1, 1, At, B1); PG8_BAR;
            PG8_LDB(B0, 1, 0); PG8_SCHED; PG8_LDA(At, 1, 0); PG8_STAGE(PG8_SA(0, 1), a2 + hstep, voffA);
            PG8_WAIT_L(8); PG8_BAR; PG8_WAIT_L(0); PG8_MMA(0, 0, At, B0); PG8_BAR; PG8_SCHED;
            PG8_LDB(B1, 1, 1); PG8_STAGE(PG8_SB(1, 0), b3, voffB);
            PG8_BAR; PG8_WAIT_L(0); PG8_MMA(0, 1, At, B1); PG8_BAR;
            PG8_LDA(At, 1, 1); PG8_STAGE(PG8_SA(1, 0), a3, voffA);
            PG8_BAR; PG8_WAIT_L(0); PG8_MMA(1, 0, At, B0); PG8_BAR; PG8_SCHED;
            PG8_STAGE(PG8_SB(1, 1), b3 + hstep, voffB);
            PG8_WAIT_V(6); PG8_BAR; PG8_MMA(1, 1, At, B1); PG8_BAR;
            }
        }
        if constexpr (ALIGN_EPI) { if (wr == 0) PG8_BAR; }
        if constexpr (!Epi::AFTER_DRAIN) { E(acc, cur, wr, wc, fr, fq); S.done(cur); }
        if (!has_next) break;
#pragma unroll
        for (int a = 0; a < 2; ++a)
#pragma unroll
            for (int b = 0; b < 2; ++b)
#pragma unroll
                for (int m = 0; m < 4; ++m)
#pragma unroll
                    for (int n = 0; n < 2; ++n) acc[a][b][m][n] = (f32x4){0.f, 0.f, 0.f, 0.f};
        cur = nxt; cA = nA; cB = nB; ++ui;
        if constexpr (ALIGN_EPI) { if (wr == 1) PG8_BAR; }
    }
    PG8_WAIT_V(0);
    if constexpr (!ALIGN_EPI) { if (wr == 0) PG8_BAR; }
    PG8_BAR;
    if constexpr (Epi::AFTER_DRAIN) { E.fused(acc, cur, wr, wc, fr, fq, lds, wid, lane); S.done(cur); }
#undef PG8_SA
#undef PG8_SB
#undef PG8_STAGE
#undef PG8_LDA
#undef PG8_LDB
#undef PG8_MMA
#undef PG8_WAIT_V
#undef PG8_WAIT_L
#undef PG8_BAR
#undef PG8_SCHED
}
}

template <class E> struct EpiAd {
    static constexpr bool PERM = true, AFTER_DRAIN = false; E e;
    __device__ __forceinline__ void operator()(const f32x4 (&acc)[2][2][4][2], const pg8::Unit& u, int wr, int wc, int fr, int fq) const {
#pragma unroll
        for (int ai = 0; ai < 2; ++ai)
#pragma unroll
            for (int m = 0; m < 4; ++m) {
                const int row = u.pm * 256 + ai * 128 + wr * 64 + m * 16 + fr;
                const float rsc = e.rowscale(row);
                float lo[8], hi[8];
#pragma unroll
                for (int j = 0; j < 4; ++j) { lo[j] = acc[ai][0][m][0][j]; lo[4 + j] = acc[ai][0][m][1][j]; hi[j] = acc[ai][1][m][0][j]; hi[4 + j] = acc[ai][1][m][1][j]; }
                e.template tile8<16, 32>(row, u.pn, wc * 32 + 8 * fq, lo, hi, rsc);
            }
    }
};
template <class E> __device__ __forceinline__ void gemm_fast(LAS unsigned char* lds, const bf16_t* A, const bf16_t* Bt, int M, int N, int K, const E& e, int vb, int G) {
    pg8::Gemm g{A, Bt, M, N, K}; pg8::StaticOrder S; S.init(M, N, G, vb);
    EpiAd<E> Ea{e};
    pg8::gemm_phase<EpiAd<E>, pg8::StaticOrder, true, true>(lds, g, S, Ea);
}
#if FAST_GEMM
#define GEMM gemm_fast
#else
#define GEMM gemm_simple
#endif

__device__ __forceinline__ void conv_simple(const Params& p, LAS unsigned char* lds, int vb, int G) {
    LAS float* red = (LAS float*)lds;
    const bf16_t* A = (const bf16_t*)(p.ws + WS_R1); const bf16_t* SGA = A + (size_t)T * 1024; bf16_t* H0 = (bf16_t*)p.out;
    const float *cw = p.in[6], *cb = p.in[7], *lg = p.in[8], *lbeta = p.in[9], *sc = p.in[2];
    const int tid = threadIdx.x, c = tid * 2;
    for (int r = vb; r < T; r += G) {
        int t, rowbase; const float* hist;
        if (r < TP) { t = r & 2047; rowbase = r - t; hist = nullptr; } else { const int b = (r - TP) >> 3; t = (r - TP) & 7; rowbase = r - t; hist = sc + (size_t)b * 30 * 1024; }
        float y0 = cb[c], y1 = cb[c + 1];
        for (int j = 0; j < 31; ++j) { const int i = t + j - 30; float a0 = 0.f, a1 = 0.f;
            if (i >= 0) { const unsigned w = *(const unsigned*)(A + (size_t)(rowbase + i) * 1024 + c); a0 = bflo(w); a1 = bfhi(w); }
            else if (hist) { a0 = hist[(30 + i) * 1024 + c]; a1 = hist[(30 + i) * 1024 + c + 1]; }
            y0 += cw[j * 1024 + c] * a0; y1 += cw[j * 1024 + c + 1] * a1; }
        const float mean = block_sum(y0 + y1, red) * (1.f / 1024.f);
        const float d0 = y0 - mean, d1 = y1 - mean;
        const float rstd = rsqrtf(block_sum(d0 * d0 + d1 * d1, red) * (1.f / 1024.f) + EPS);
        const float n0 = d0 * rstd * lg[c] + lbeta[c], n1 = d1 * rstd * lg[c + 1] + lbeta[c + 1];
        const unsigned gw = *(const unsigned*)(SGA + (size_t)r * 1024 + c);
        *(unsigned*)(H0 + (size_t)r * 2048 + c) = pk2(silu(n0) * bflo(gw), silu(n1) * bfhi(gw));
    }
    for (int idx = vb * NTHR + tid; idx < 8 * 30 * 1024; idx += G * NTHR) { const int b = idx / 30720, rem = idx % 30720, i = rem >> 10, cc = rem & 1023;
        p.out[O_CP + idx] = bf2f(A[(size_t)(b * 2048 + 2018 + i) * 1024 + cc]); }
    for (int idx = vb * NTHR + tid; idx < 128 * 30 * 1024; idx += G * NTHR) { const int b = idx / 30720, rem = idx % 30720, i = rem >> 10, cc = rem & 1023;
        p.out[O_CS + idx] = (i < 22) ? sc[(size_t)(b * 30 + 8 + i) * 1024 + cc] : bf2f(A[(size_t)(TP + b * 8 + i - 22) * 1024 + cc]); }
}


typedef float f32x16 __attribute__((ext_vector_type(16)));
__device__ __forceinline__ bf16x8 ldfrag(const LAS unsigned char* img, int pitchB, int row0, int k0, int lane) {
    return *(const LAS bf16x8*)(img + (row0 + (lane & 31)) * pitchB + (k0 + 8 * (lane >> 5)) * 2);
}
#define MFMA32(a, b, c) __builtin_amdgcn_mfma_f32_32x32x16_bf16((a), (b), (c), 0, 0, 0)
__device__ __forceinline__ int accrow(int r, int lane) { return (r & 3) + 8 * (r >> 2) + 4 * (lane >> 5); }

__device__ __forceinline__ void conv_fast(const Params& p, LAS unsigned char* lds, int vb, int G) {
    LAS float* red = (LAS float*)lds;
    const bf16_t* A = (const bf16_t*)(p.ws + WS_R1); const bf16_t* SGA = A + (size_t)T * 1024; bf16_t* H0 = (bf16_t*)p.out;
    const float *cw = p.in[6], *cb = p.in[7], *lg = p.in[8], *lbeta = p.in[9], *sc = p.in[2];
    const int tid = threadIdx.x, lane = tid & 63, wave = tid >> 6, c = tid * 2;
    LAS float* cwl = (LAS float*)(lds + 1024);
    __syncthreads();
    for (int q = tid; q < 31 * 256; q += NTHR) *(LAS f32x4*)(cwl + q * 4) = *(const f32x4*)(cw + q * 4);
    __syncthreads();
    const float cb0 = cb[c], cb1 = cb[c + 1], g0 = lg[c], g1 = lg[c + 1], be0 = lbeta[c], be1 = lbeta[c + 1];
    for (int item = vb; item < 384; item += G) {
        int L, rowfirst; float w0[38], w1[38];
        if (item < 256) { const int b = item >> 5, t0 = (item & 31) * 64; L = 64; rowfirst = b * 2048 + t0;
#pragma unroll
            for (int i = 0; i < 30; ++i) { unsigned u = 0u; if (t0 > 0) u = *(const unsigned*)(A + (size_t)(rowfirst - 30 + i) * 1024 + c); w0[i] = bflo(u); w1[i] = bfhi(u); }
        } else { const int sb = item - 256; L = 8; rowfirst = TP + sb * 8; const float* hist = sc + (size_t)sb * 30 * 1024;
#pragma unroll
            for (int i = 0; i < 30; ++i) { const f32x2 hv = *(const f32x2*)(hist + i * 1024 + c); w0[i] = hv.x; w1[i] = hv.y; }
        }
        for (int g = 0; g < L; g += 8) {
#pragma unroll
            for (int k = 0; k < 8; ++k) { const unsigned u = *(const unsigned*)(A + (size_t)(rowfirst + g + k) * 1024 + c); w0[30 + k] = bflo(u); w1[30 + k] = bfhi(u); }
            float y0[8], y1[8], st[16];
#pragma unroll
            for (int k = 0; k < 8; ++k) { y0[k] = cb0; y1[k] = cb1; }
#pragma unroll
            for (int j = 0; j < 31; ++j) { const f32x2 w = *(const LAS f32x2*)(cwl + j * 1024 + c);
#pragma unroll
                for (int k = 0; k < 8; ++k) { y0[k] += w.x * w0[k + j]; y1[k] += w.y * w1[k + j]; } }
#pragma unroll
            for (int k = 0; k < 8; ++k) { st[k] = y0[k] + y1[k]; st[8 + k] = y0[k] * y0[k] + y1[k] * y1[k]; }
#pragma unroll
            for (int k = 0; k < 16; ++k) st[k] = wave_sum(st[k]);
            if (lane == 0) {
#pragma unroll
                for (int k = 0; k < 16; ++k) red[wave * 16 + k] = st[k]; }
            __syncthreads();
            if (tid < 16) { float s = 0.f;
#pragma unroll
                for (int w = 0; w < 8; ++w) s += red[w * 16 + tid];
                red[128 + tid] = s; }
            __syncthreads();
#pragma unroll
            for (int k = 0; k < 8; ++k) { const float mean = red[128 + k] * (1.f / 1024.f); const float var = red[136 + k] * (1.f / 1024.f) - mean * mean; const float rstd = rsqrtf(var + EPS);
                const float n0 = (y0[k] - mean) * rstd * g0 + be0, n1 = (y1[k] - mean) * rstd * g1 + be1;
                const size_t row = (size_t)(rowfirst + g + k);
                const unsigned gw = *(const unsigned*)(SGA + row * 1024 + c);
                *(unsigned*)(H0 + row * 2048 + c) = pk2(silu(n0) * bflo(gw), silu(n1) * bfhi(gw)); }
#pragma unroll
            for (int i = 0; i < 30; ++i) { w0[i] = w0[i + 8]; w1[i] = w1[i + 8]; }
        }
    }
    for (int idx = vb * NTHR + tid; idx < 8 * 30 * 1024; idx += G * NTHR) { const int b = idx / 30720, rem = idx % 30720, i = rem >> 10, cc = rem & 1023;
        p.out[O_CP + idx] = bf2f(A[(size_t)(b * 2048 + 2018 + i) * 1024 + cc]); }
    for (int idx = vb * NTHR + tid; idx < 128 * 30 * 1024; idx += G * NTHR) { const int b = idx / 30720, rem = idx % 30720, i = rem >> 10, cc = rem & 1023;
        p.out[O_CS + idx] = (i < 22) ? sc[(size_t)(b * 30 + 8 + i) * 1024 + cc] : bf2f(A[(size_t)(TP + b * 8 + i - 22) * 1024 + cc]); }
}

__device__ __forceinline__ void hgrn_simple(const Params& p, LAS unsigned char* lds, int vb, int G, int item_lo, int item_hi) {
    LAS float* sf = (LAS float*)lds; LAS float* sk = sf + 1024; LAS float* sq = sk + 1024; LAS float* si = sq + 1024; LAS float* so = si + 1024; LAS float* so2 = so + 4096;
    const int tid = threadIdx.x, v = tid & 127, dq = tid >> 7, lane = tid & 63, wave = tid >> 6;
    const bf16_t* Z = (const bf16_t*)(p.ws + WS_R1);
    const bf16_t *Q = Z + (size_t)2 * T * 1024, *LOGF = Z + (size_t)3 * T * 1024, *I = Z + (size_t)4 * T * 1024, *SGB = Z + (size_t)5 * T * 1024;
    const float* og = p.in[11]; bf16_t* H0 = (bf16_t*)p.out;
    for (int item = item_lo + vb; item < item_hi; item += G) {
        int h, L, rowbase; const float* s0; float* sout;
        if (item < 64) { const int b = item >> 3; h = item & 7; L = 2048; rowbase = b * 2048; s0 = nullptr; sout = p.out + O_HP + (size_t)item * 16384; }
        else { const int it = item - 64, b = it >> 3; h = it & 7; L = 8; rowbase = TP + b * 8; s0 = p.in[3] + (size_t)it * 16384; sout = p.out + O_HS + (size_t)it * 16384; }
        float S[32];
#pragma unroll
        for (int j = 0; j < 32; ++j) S[j] = s0 ? s0[(dq * 32 + j) * 128 + v] : 0.f;
        for (int t0 = 0; t0 < L; t0 += 8) {
            __syncthreads();
            for (int e = tid; e < 1024; e += NTHR) { const int tt = e >> 7, d = e & 127; const size_t off = (size_t)(rowbase + t0 + tt) * 1024 + h * 128 + d;
                const float f = __expf(bf2f(LOGF[off])); sf[e] = f; sk[e] = 1.f - f; sq[e] = bf2f(Q[off]); si[e] = bf2f(I[off]); }
            __syncthreads();
#pragma unroll 1
            for (int tt = 0; tt < 8; ++tt) { const float iv = si[tt * 128 + v]; float op = 0.f;
#pragma unroll
                for (int j = 0; j < 32; ++j) { const int d = dq * 32 + j; S[j] = sf[tt * 128 + d] * S[j] + sk[tt * 128 + d] * iv; op += S[j] * sq[tt * 128 + d]; }
                so[(tt * 4 + dq) * 128 + v] = op; }
            __syncthreads();
            for (int e = tid; e < 1024; e += NTHR) { const int tt = e >> 7, vv = e & 127; so2[e] = (so[(tt * 4 + 0) * 128 + vv] + so[(tt * 4 + 1) * 128 + vv]) + (so[(tt * 4 + 2) * 128 + vv] + so[(tt * 4 + 3) * 128 + vv]); }
            __syncthreads();
            { const int tt = wave; const size_t row = (size_t)(rowbase + t0 + tt);
              const float o0 = so2[tt * 128 + lane], o1 = so2[tt * 128 + 64 + lane];
              const float rs = rsqrtf(wave_sum(o0 * o0 + o1 * o1) * (1.f / 128.f) + EPS);
              const float r0 = o0 * rs * og[h * 128 + lane] * bf2f(SGB[row * 1024 + h * 128 + lane]);
              const float r1 = o1 * rs * og[h * 128 + 64 + lane] * bf2f(SGB[row * 1024 + h * 128 + 64 + lane]);
              H0[row * 2048 + 1024 + h * 128 + lane] = (bf16_t)f2bf(r0); H0[row * 2048 + 1024 + h * 128 + 64 + lane] = (bf16_t)f2bf(r1); }
        }
#pragma unroll
        for (int j = 0; j < 32; ++j) sout[(dq * 32 + j) * 128 + v] = S[j];
    }
}

__device__ __forceinline__ void gmlp_simple(const Params& p, LAS unsigned char* lds, int vb, int G, int row_lo) {
    LAS float* smean = (LAS float*)lds; LAS float* srstd = smean + 128;
    const f32x2* VST = (const f32x2*)(p.ws + WS_VST); const bf16_t* GV = (const bf16_t*)p.out; bf16_t* UG = (bf16_t*)(p.ws + WS_UG);
    const float *lg = p.in[15], *lb_ = p.in[16], *wsp = p.in[17], *bs = p.in[18];
    const int tid = threadIdx.x, ch = tid * 4, h = tid >> 6;
    const f32x4 g4 = *(const f32x4*)(lg + ch), b4 = *(const f32x4*)(lb_ + ch);
    for (int r = row_lo + vb; r < T; r += G) {
        int t, cstart;
        if (r < TP) { t = r & 127; cstart = r - t; } else { t = (r - TP) & 7; cstart = r - t; }
        __syncthreads();
        if (tid <= t) { const size_t row = (size_t)(cstart + tid); float s = 0.f, q = 0.f;
            for (int j = 0; j < 32; ++j) { const f32x2 st = VST[row * 32 + j]; s += st.x; q += st.y; }
            const float mean = s * (1.f / 2048.f); const float var = q * (1.f / 2048.f) - mean * mean; smean[tid] = mean; srstd[tid] = rsqrtf(var + EPS); }
        __syncthreads();
        float a0 = 0.f, a1 = 0.f, a2 = 0.f, a3 = 0.f, v0 = 0.f, v1 = 0.f, v2 = 0.f, v3 = 0.f;
        for (int s = 0; s <= t; ++s) {
            const float w = wsp[(size_t)(h * 128 + t) * 128 + s], m = smean[s], rs = srstd[s];
            const u32x2 gvw = *(const u32x2*)(GV + (size_t)(cstart + s) * DC + ch);
            v0 = (bflo(gvw.x) - m) * rs * g4.x + b4.x; v1 = (bfhi(gvw.x) - m) * rs * g4.y + b4.y; v2 = (bflo(gvw.y) - m) * rs * g4.z + b4.z; v3 = (bfhi(gvw.y) - m) * rs * g4.w + b4.w;
            a0 += w * v0; a1 += w * v1; a2 += w * v2; a3 += w * v3;
        }
        const float bias = bs[h * 128 + t];
        const u32x2 ugw = *(const u32x2*)(UG + (size_t)r * DC + ch);
        u32x2 o; o.x = pk2(bflo(ugw.x) * (a0 + bias), bfhi(ugw.x) * (a1 + bias)); o.y = pk2(bflo(ugw.y) * (a2 + bias), bfhi(ugw.y) * (a3 + bias));
        *(u32x2*)(UG + (size_t)r * DC + ch) = o;
        if (r < TP) { const int tt = (r & 2047) - 1920; if (tt >= 0) *(f32x4*)(p.out + O_GP + ((size_t)(r >> 11) * 128 + tt) * DC + ch) = (f32x4){v0, v1, v2, v3}; }
        else *(f32x4*)(p.out + O_GS + (size_t)(r - TP) * DC + ch) = (f32x4){v0, v1, v2, v3};
    }
}


constexpr int GM_W = 0, GM_VT = 34816, GM_MR = 34816 + 69632, GM_PITCH = 272;
__device__ __forceinline__ void gmlp_fast(const Params& p, LAS unsigned char* lds, int vb, int G) {
    LAS float* smean = (LAS float*)(lds + GM_MR); LAS float* srstd = smean + 128;
    const f32x2* VST = (const f32x2*)(p.ws + WS_VST); const bf16_t* GV = (const bf16_t*)p.out; bf16_t* UG = (bf16_t*)(p.ws + WS_UG);
    const float *lg = p.in[15], *lb_ = p.in[16], *wsp = p.in[17], *bs = p.in[18];
    const int tid = threadIdx.x, lane = tid & 63, wid = __builtin_amdgcn_readfirstlane(tid >> 6);
    for (int sitem = vb; sitem < 256; sitem += G) {
        const int chunk = sitem >> 1, hh = (sitem & 1) * 4; const size_t cstart = (size_t)chunk * 128;
        const bool lastchunk = (chunk & 15) == 15; const int bseq = chunk >> 4;
        __syncthreads();
        if (tid < 128) { const size_t row = cstart + tid; float s = 0.f, q = 0.f;
            for (int j = 0; j < 32; ++j) { const f32x2 st = VST[row * 32 + j]; s += st.x; q += st.y; }
            const float mean = s * (1.f / 2048.f); const float var = q * (1.f / 2048.f) - mean * mean; smean[tid] = mean; srstd[tid] = rsqrtf(var + EPS); }
        for (int h = hh; h < hh + 4; ++h) {
            __syncthreads();
            for (int q = tid; q < 4096; q += NTHR) { const int t = q >> 5, s0 = (q & 31) * 4; const f32x4 w = *(const f32x4*)(wsp + (size_t)(h * 128 + t) * 128 + s0);
                u32x2 o; o.x = pk2(s0 <= t ? w.x : 0.f, s0 + 1 <= t ? w.y : 0.f); o.y = pk2(s0 + 2 <= t ? w.z : 0.f, s0 + 3 <= t ? w.w : 0.f);
                *(LAS u32x2*)(lds + GM_W + t * GM_PITCH + s0 * 2) = o; }
            for (int q = tid; q < 2048; q += NTHR) { const int cc = q & 255, sg = q >> 8; const int col = h * 256 + cc; const float gg = lg[col], bb = lb_[col];
                float vn[16];
#pragma unroll
                for (int j = 0; j < 16; ++j) { const int srow = sg * 16 + j; vn[j] = (bf2f(GV[(cstart + srow) * DC + col]) - smean[srow]) * srstd[srow] * gg + bb; }
                u32x4 o0, o1; o0.x = pk2(vn[0], vn[1]); o0.y = pk2(vn[2], vn[3]); o0.z = pk2(vn[4], vn[5]); o0.w = pk2(vn[6], vn[7]); o1.x = pk2(vn[8], vn[9]); o1.y = pk2(vn[10], vn[11]); o1.z = pk2(vn[12], vn[13]); o1.w = pk2(vn[14], vn[15]);
                *(LAS u32x4*)(lds + GM_VT + cc * GM_PITCH + sg * 32) = o0; *(LAS u32x4*)(lds + GM_VT + cc * GM_PITCH + sg * 32 + 16) = o1;
                if (lastchunk) {
#pragma unroll
                    for (int j = 0; j < 16; ++j) p.out[O_GP + ((size_t)bseq * 128 + sg * 16 + j) * DC + col] = vn[j]; }
            }
            __syncthreads();
            f32x16 acc[4];
#pragma unroll
            for (int mt = 0; mt < 4; ++mt)
#pragma unroll
                for (int r = 0; r < 16; ++r) acc[mt][r] = 0.f;
#pragma unroll
            for (int ks = 0; ks < 8; ++ks) { const bf16x8 b = ldfrag(lds + GM_VT, GM_PITCH, 32 * wid, 16 * ks, lane);
#pragma unroll
                for (int mt = 0; mt < 4; ++mt) if (ks < 2 * (mt + 1)) { const bf16x8 a = ldfrag(lds + GM_W, GM_PITCH, 32 * mt, 16 * ks, lane); acc[mt] = MFMA32(a, b, acc[mt]); } }
            const int col = h * 256 + 32 * wid + (lane & 31);
#pragma unroll
            for (int mt = 0; mt < 4; ++mt)
#pragma unroll
                for (int r = 0; r < 16; ++r) { const int t = 32 * mt + accrow(r, lane); bf16_t* u = UG + (cstart + t) * DC + col;
                    *u = (bf16_t)f2bf(bf2f(*u) * (acc[mt][r] + bs[h * 128 + t])); }
        }
    }
}

__device__ __forceinline__ void final_norm(const Params& p, int vb, int G) {
    const int tid = threadIdx.x, lane = tid & 63, wave = tid >> 6;
    const int gw = vb * NWAVES + wave, NGW = G * NWAVES;
    const float* SSP = (const float*)(p.ws + WS_SSP2); const float* g = p.in[20];
    for (int r = gw; r < T; r += NGW) {
        const f32x4* s = (const f32x4*)(SSP + (size_t)r * 16); const f32x4 a = s[0], b = s[1], c = s[2], d = s[3];
        const float tot = ((a.x + a.y) + (a.z + a.w)) + ((b.x + b.y) + (b.z + b.w)) + ((c.x + c.y) + (c.z + c.w)) + ((d.x + d.y) + (d.z + d.w));
        const float rs = rsqrtf(tot * (1.f / 1024.f) + EPS);
        f32x4* y = (f32x4*)(p.out + (size_t)r * D) + lane;
#pragma unroll
        for (int j = 0; j < 4; ++j) { const f32x4 gg = ((const f32x4*)g)[lane + 64 * j]; f32x4 v = y[64 * j]; v.x *= rs * gg.x; v.y *= rs * gg.y; v.z *= rs * gg.z; v.w *= rs * gg.w; y[64 * j] = v; }
    }
}

__global__ void __launch_bounds__(NTHR, 2) fwd_kernel(Params p) {
    extern __shared__ __attribute__((aligned(16))) unsigned char lds_raw[];
    LAS unsigned char* lds = (LAS unsigned char*)lds_raw;
    cg::grid_group grid = cg::this_grid();
    const int G = gridDim.x, vb = blockIdx.x;
    bf16_t* WT1 = (bf16_t*)(p.ws + WS_WT1); bf16_t* WT2 = (bf16_t*)(p.ws + WS_WT2); bf16_t* WT3 = (bf16_t*)(p.ws + WS_WT3); bf16_t* WT4 = (bf16_t*)(p.ws + WS_WT4);
    bf16_t* ZR = (bf16_t*)(p.ws + WS_R1);

    phase0(p, lds, vb, G);
    grid.sync();
    { Epi1 E{ZR, (const float*)(p.ws + WS_LB)}; GEMM(lds, (const bf16_t*)p.out, WT1, T, N1, D, E, vb, G); }
    grid.sync();
    hgrn_simple(p, lds, vb, G, 0, 64 + 1024);
    conv_fast(p, lds, vb, G);
    grid.sync();
    { Epi2 E{p.in[0], p.in[1], (float*)(p.ws + WS_X1), (bf16_t*)(p.ws + WS_X1B), (float*)(p.ws + WS_SSP1)}; GEMM(lds, (const bf16_t*)p.out, WT2, T, D, 2048, E, vb, G); }
    grid.sync();
    { Epi3 E{(const float*)(p.ws + WS_SSP1), (bf16_t*)(p.ws + WS_UG), (bf16_t*)p.out, (f32x2*)(p.ws + WS_VST)}; GEMM(lds, (const bf16_t*)(p.ws + WS_X1B), WT3, T, N3, D, E, vb, G); }
    grid.sync();
    gmlp_fast(p, lds, vb, G);
    gmlp_simple(p, lds, vb, G, TP);
    grid.sync();
    { Epi4 E{(const float*)(p.ws + WS_X1), p.out, (float*)(p.ws + WS_SSP2)}; GEMM(lds, (const bf16_t*)(p.ws + WS_UG), WT4, T, D, 2048, E, vb, G); }
    grid.sync();
    final_norm(p, vb, G);
}

extern "C" void kernel_launch(void* const* d_in, const int* in_sizes, int n_in, void* d_out, int out_size, void* d_ws, size_t ws_size, hipStream_t stream) {
    static int grid = 0;
    if (grid == 0) {
        if (n_in != 21 || (size_t)out_size != O_END || ws_size < WS_END) { fprintf(stderr, "kernel_launch: unexpected shapes: n_in %d out %d ws %zu\n", n_in, out_size, ws_size); grid = -1; return; }
        int dev = 0, cus = 0, per_cu = 0;
        if (hipGetDevice(&dev) != hipSuccess || hipDeviceGetAttribute(&cus, hipDeviceAttributeMultiprocessorCount, dev) != hipSuccess) { grid = -1; return; }
        if (hipFuncSetAttribute((const void*)fwd_kernel, hipFuncAttributeMaxDynamicSharedMemorySize, LDS_BYTES) != hipSuccess) { fprintf(stderr, "kernel_launch: hipFuncSetAttribute failed\n"); grid = -1; return; }
        if (hipOccupancyMaxActiveBlocksPerMultiprocessor(&per_cu, (const void*)fwd_kernel, NTHR, LDS_BYTES) != hipSuccess || per_cu < 1) { fprintf(stderr, "kernel_launch: occupancy query says %d\n", per_cu); grid = -1; return; }
        grid = cus;
    }
    if (grid < 0) return;
    Params p{};
    for (int i = 0; i < 21; ++i) p.in[i] = (const float*)d_in[i];
    p.out = (float*)d_out; p.ws = (unsigned char*)d_ws;
    void* args[] = {&p};
    hipError_t e = hipLaunchCooperativeKernel((const void*)fwd_kernel, dim3(grid), dim3(NTHR), args, LDS_BYTES, stream);
    if (e != hipSuccess) fprintf(stderr, "kernel_launch: cooperative launch failed: %s (grid %d)\n", hipGetErrorString(e), grid);
}
```

```cpp
#include <hip/hip_runtime.h>
#include <hip/hip_cooperative_groups.h>
#include <cstdio>
#include <cstdint>
namespace cg = cooperative_groups;

#ifndef FAST_GEMM
#define FAST_GEMM 1
#endif

#define LAS __attribute__((address_space(3)))
typedef unsigned short bf16_t;
typedef short bf16x8 __attribute__((ext_vector_type(8)));
typedef float f32x4 __attribute__((ext_vector_type(4)));
typedef float f32x2 __attribute__((ext_vector_type(2)));
typedef unsigned u32x4 __attribute__((ext_vector_type(4)));
typedef unsigned u32x2 __attribute__((ext_vector_type(2)));

constexpr int D = 1024, TP = 16384, TS = 1024, T = TP + TS;
constexpr int N1 = 7168, N3 = 6144, DC = 2048;
constexpr float EPS = 1e-6f;
constexpr int NWAVES = 8, NTHR = 512;
constexpr int LDS_BYTES = 147456;
constexpr size_t MiB = (size_t)1 << 20;
constexpr size_t WS_LB = 65536;
constexpr size_t WS_WT1 = 1 * MiB, WS_WT2 = 15 * MiB, WS_WT3 = 19 * MiB, WS_WT4 = 31 * MiB;
constexpr size_t WS_R1 = 35 * MiB;
constexpr size_t WS_X1 = WS_R1, WS_X1B = WS_R1 + 68 * MiB, WS_UG = WS_R1 + 102 * MiB;
constexpr size_t WS_SSP1 = WS_R1 + 170 * MiB, WS_VST = WS_R1 + 172 * MiB, WS_SSP2 = WS_R1 + 178 * MiB;
constexpr size_t WS_SEG = 239 * MiB;
constexpr size_t WS_END = 255 * MiB;
constexpr size_t O_YP = 0, O_YS = 16777216, O_CP = 17825792, O_HP = 18071552, O_GP = 19120128, O_CS = 21217280, O_HS = 25149440, O_GS = 41926656, O_END = 44023808;

struct Params { const float* in[21]; float* out; unsigned char* ws; };

__device__ __forceinline__ int opaque(int x) { asm volatile("" : "+v"(x)); return x; }
__device__ __forceinline__ float bf2f(unsigned b) { return __uint_as_float(b << 16); }
__device__ __forceinline__ float bflo(unsigned w) { return __uint_as_float(w << 16); }
__device__ __forceinline__ float bfhi(unsigned w) { return __uint_as_float(w & 0xffff0000u); }
__device__ __forceinline__ unsigned f2bf(float f) { unsigned u = __float_as_uint(f); return (u + 0x7fffu + ((u >> 16) & 1u)) >> 16; }
__device__ __forceinline__ unsigned pk2(float lo, float hi) { return f2bf(lo) | (f2bf(hi) << 16); }
__device__ __forceinline__ float sigm(float x) { return 1.0f / (1.0f + __expf(-x)); }
__device__ __forceinline__ float silu(float x) { return x * sigm(x); }
__device__ __forceinline__ float gelu_t(float x) { return x * sigm(1.5957691216057308f * (x + 0.044715f * x * x * x)); }
__device__ __forceinline__ float wave_sum(float v) {
#pragma unroll
    for (int o = 1; o < 64; o <<= 1) v += __shfl_xor(v, o);
    return v;
}
__device__ __forceinline__ void st8(bf16_t* p, const float (&v)[8]) {
    u32x4 w; w.x = pk2(v[0], v[1]); w.y = pk2(v[2], v[3]); w.z = pk2(v[4], v[5]); w.w = pk2(v[6], v[7]); *(u32x4*)p = w;
}
__device__ __forceinline__ float block_sum(float v, LAS float* red) {
    v = wave_sum(v);
    __syncthreads();
    if ((threadIdx.x & 63) == 0) red[threadIdx.x >> 6] = v;
    __syncthreads();
    float s = 0.f;
#pragma unroll
    for (int i = 0; i < 8; ++i) s += red[i];
    return s;
}

template <int MAP> __device__ __forceinline__ int vmap(int vc) {
    const int vt = vc >> 8, c = vc & 255;
    if (MAP == 1) return vt < 8 ? (c < 128 ? 128 * vt + c : 1024 + 128 * vt + (c - 128)) : vc;
    if (MAP == 3) return vt < 16 ? (c < 128 ? 128 * vt + c : 4096 + 128 * vt + (c - 128)) : vc - 2048;
    return vc;
}

template <int MAP> __device__ __forceinline__ void transpose_item(const float* W, int K, int N, bf16_t* WT, const float* kscale, LAS float* scr, int item, int lane) {
    const int nblk = N / 32, kb = item / nblk, nb = item % nblk, k0 = 64 * kb, n0 = 32 * nb;
    const int on0 = vmap<MAP>(n0);
#pragma unroll 8
    for (int i = 0; i < 32; ++i) { const int kk = 2 * i + (lane >> 5); float w = W[(size_t)(k0 + kk) * N + on0 + (lane & 31)]; if (kscale) w *= kscale[k0 + kk]; scr[kk * 33 + (lane & 31)] = w; }
    asm volatile("s_waitcnt lgkmcnt(0)" ::: "memory");
    const int c = lane & 7;
#pragma unroll
    for (int j = 0; j < 4; ++j) { const int n = (lane >> 3) + 8 * j; const LAS float* s = scr + (8 * c) * 33 + n;
        u32x4 o; o.x = pk2(s[0 * 33], s[1 * 33]); o.y = pk2(s[2 * 33], s[3 * 33]); o.z = pk2(s[4 * 33], s[5 * 33]); o.w = pk2(s[6 * 33], s[7 * 33]);
        *(u32x4*)(WT + (size_t)(n0 + n) * K + k0 + 8 * c) = o; }
    asm volatile("s_waitcnt lgkmcnt(0)" ::: "memory");
}
__device__ __forceinline__ void rms_row_to_bf16(const float* xrow, const float* g, bf16_t* orow, int lane) {
    const f32x4* xr = (const f32x4*)xrow + lane; f32x4 v[4]; float s = 0.f;
#pragma unroll
    for (int j = 0; j < 4; ++j) { v[j] = xr[64 * j]; s += (v[j].x * v[j].x + v[j].y * v[j].y) + (v[j].z * v[j].z + v[j].w * v[j].w); }
    const float rs = rsqrtf(wave_sum(s) * (1.f / 1024.f) + EPS);
    u32x2* o8 = (u32x2*)orow + lane;
#pragma unroll
    for (int j = 0; j < 4; ++j) { const f32x4 gg = ((const f32x4*)g)[lane + 64 * j]; u32x2 w; w.x = pk2(v[j].x * rs * gg.x, v[j].y * rs * gg.y); w.y = pk2(v[j].z * rs * gg.z, v[j].w * rs * gg.w); o8[64 * j] = w; }
}
__device__ __forceinline__ void phase0(const Params& p, LAS unsigned char* lds, int vb, int G) {
    const int tid = opaque((int)threadIdx.x), lane = tid & 63, wave = tid >> 6;
    const int gw = vb * NWAVES + wave, NGW = G * NWAVES;
    float* LB = (float*)(p.ws + WS_LB);
    for (int i = vb * NTHR + tid; i < 1024; i += G * NTHR) { const float l0 = p.in[10][i], l1 = p.in[10][1024 + i]; LB[i] = 1.0f / (1.0f + __expf(l1 - l0)); }
    LAS float* scr = (LAS float*)(lds + wave * 16384);
    constexpr int I1 = (D / 64) * (N1 / 32), I2 = (2048 / 64) * (D / 32), I3 = (D / 64) * (N3 / 32), I4 = I2;
    for (int it = gw; it < I1 + I2 + I3 + I4; it += NGW) {
        int r = it;
        if (r < I1) { transpose_item<1>(p.in[5], D, N1, (bf16_t*)(p.ws + WS_WT1), nullptr, scr, r, lane); continue; } r -= I1;
        if (r < I2) { transpose_item<0>(p.in[12], 2048, D, (bf16_t*)(p.ws + WS_WT2), nullptr, scr, r, lane); continue; } r -= I2;
        if (r < I3) { transpose_item<3>(p.in[14], D, N3, (bf16_t*)(p.ws + WS_WT3), p.in[13], scr, r, lane); continue; } r -= I3;
        transpose_item<0>(p.in[19], 2048, D, (bf16_t*)(p.ws + WS_WT4), nullptr, scr, r, lane);
    }
    bf16_t* XN0 = (bf16_t*)p.out;
    for (int r = gw; r < T; r += NGW) { const float* xr = r < TP ? p.in[0] + (size_t)r * D : p.in[1] + (size_t)(r - TP) * D; rms_row_to_bf16(xr, p.in[4], XN0 + (size_t)r * D, lane); }
}

struct Epi1 {
    bf16_t* Z; const float* LB;
    __device__ __forceinline__ float rowscale(int) const { return 1.f; }
    template <int X1M, int X2M> __device__ __forceinline__ void tile8(int row, int pn, int c0, const float (&lo)[8], const float (&hi)[8], float) const {
        if (pn < 8) { float a[8];
#pragma unroll
            for (int i = 0; i < 8; ++i) a[i] = lo[i] * sigm(hi[i]);
            st8(Z + (size_t)row * 1024 + 128 * pn + c0, a);
        } else {
            const int g = (pn - 8) >> 2, col = ((pn - 8) & 3) * 256 + c0;
            bf16_t* base = Z + (size_t)(g + 1) * T * 1024 + (size_t)row * 1024 + col;
            float x[8], y[8];
            if (g == 1) {
#pragma unroll
                for (int i = 0; i < 8; ++i) { x[i] = lo[i]; y[i] = hi[i]; }
            } else if (g == 2) {
#pragma unroll
                for (int i = 0; i < 8; ++i) { const float l0 = LB[col + i], l1 = LB[col + 128 + i]; x[i] = __logf(l0 + (1.f - l0) * sigm(lo[i])); y[i] = __logf(l1 + (1.f - l1) * sigm(hi[i])); }
            } else {
#pragma unroll
                for (int i = 0; i < 8; ++i) { x[i] = silu(lo[i]); y[i] = silu(hi[i]); }
            }
            st8(base, x); st8(base + 128, y);
        }
    }
};
struct Epi2 {
    const float* xp; const float* xs; float* X1; bf16_t* X1B; float* SSP;
    __device__ __forceinline__ float rowscale(int) const { return 1.f; }
    template <int X1M, int X2M> __device__ __forceinline__ void tile8(int row, int pn, int c0, const float (&lo)[8], const float (&hi)[8], float) const {
        const int col = 256 * pn + c0;
        const float* xr = (row < TP ? xp + (size_t)row * D : xs + (size_t)(row - TP) * D) + col;
        const f32x4 a0 = *(const f32x4*)xr, a1 = *(const f32x4*)(xr + 4), b0 = *(const f32x4*)(xr + 128), b1 = *(const f32x4*)(xr + 132);
        float v[8], w[8];
        v[0] = a0.x + lo[0]; v[1] = a0.y + lo[1]; v[2] = a0.z + lo[2]; v[3] = a0.w + lo[3]; v[4] = a1.x + lo[4]; v[5] = a1.y + lo[5]; v[6] = a1.z + lo[6]; v[7] = a1.w + lo[7];
        w[0] = b0.x + hi[0]; w[1] = b0.y + hi[1]; w[2] = b0.z + hi[2]; w[3] = b0.w + hi[3]; w[4] = b1.x + hi[4]; w[5] = b1.y + hi[5]; w[6] = b1.z + hi[6]; w[7] = b1.w + hi[7];
        float* o = X1 + (size_t)row * D + col;
        *(f32x4*)o = (f32x4){v[0], v[1], v[2], v[3]}; *(f32x4*)(o + 4) = (f32x4){v[4], v[5], v[6], v[7]};
        *(f32x4*)(o + 128) = (f32x4){w[0], w[1], w[2], w[3]}; *(f32x4*)(o + 132) = (f32x4){w[4], w[5], w[6], w[7]};
        bf16_t* ob = X1B + (size_t)row * D + col; st8(ob, v); st8(ob + 128, w);
        float ss = 0.f;
#pragma unroll
        for (int i = 0; i < 8; ++i) ss += v[i] * v[i] + w[i] * w[i];
        ss += __shfl_xor(ss, X1M); ss += __shfl_xor(ss, X2M);
        if ((c0 & 31) == 0) SSP[(size_t)row * 16 + pn * 4 + (c0 >> 5)] = ss;
    }
};
struct Epi3 {
    const float* SSP1; bf16_t* UG; bf16_t* GV; f32x2* VST;
    __device__ __forceinline__ float rowscale(int row) const {
        const f32x4* s = (const f32x4*)(SSP1 + (size_t)row * 16); const f32x4 a = s[0], b = s[1], c = s[2], d = s[3];
        const float t = ((a.x + a.y) + (a.z + a.w)) + ((b.x + b.y) + (b.z + b.w)) + ((c.x + c.y) + (c.z + c.w)) + ((d.x + d.y) + (d.z + d.w));
        return rsqrtf(t * (1.f / 1024.f) + EPS);
    }
    template <int X1M, int X2M> __device__ __forceinline__ void tile8(int row, int pn, int c0, const float (&lo)[8], const float (&hi)[8], float rs) const {
        if (pn < 16) { float a[8];
#pragma unroll
            for (int i = 0; i < 8; ++i) a[i] = gelu_t(lo[i] * rs) * silu(hi[i] * rs);
            st8(UG + (size_t)row * DC + 128 * pn + c0, a);
        } else {
            const int col = 256 * (pn - 16) + c0; float x[8], y[8], s = 0.f, q = 0.f;
#pragma unroll
            for (int i = 0; i < 8; ++i) { x[i] = gelu_t(lo[i] * rs); y[i] = gelu_t(hi[i] * rs); s += x[i] + y[i]; q += x[i] * x[i] + y[i] * y[i]; }
            bf16_t* o = GV + (size_t)row * DC + col; st8(o, x); st8(o + 128, y);
            s += __shfl_xor(s, X1M); q += __shfl_xor(q, X1M); s += __shfl_xor(s, X2M); q += __shfl_xor(q, X2M);
            if ((c0 & 31) == 0) VST[(size_t)row * 32 + (pn - 16) * 4 + (c0 >> 5)] = (f32x2){s, q};
        }
    }
};
struct Epi4 {
    const float* X1; float* Y; float* SSP;
    __device__ __forceinline__ float rowscale(int) const { return 1.f; }
    template <int X1M, int X2M> __device__ __forceinline__ void tile8(int row, int pn, int c0, const float (&lo)[8], const float (&hi)[8], float) const {
        const int col = 256 * pn + c0;
        const float* xr = X1 + (size_t)row * D + col;
        const f32x4 a0 = *(const f32x4*)xr, a1 = *(const f32x4*)(xr + 4), b0 = *(const f32x4*)(xr + 128), b1 = *(const f32x4*)(xr + 132);
        float v[8], w[8];
        v[0] = a0.x + lo[0]; v[1] = a0.y + lo[1]; v[2] = a0.z + lo[2]; v[3] = a0.w + lo[3]; v[4] = a1.x + lo[4]; v[5] = a1.y + lo[5]; v[6] = a1.z + lo[6]; v[7] = a1.w + lo[7];
        w[0] = b0.x + hi[0]; w[1] = b0.y + hi[1]; w[2] = b0.z + hi[2]; w[3] = b0.w + hi[3]; w[4] = b1.x + hi[4]; w[5] = b1.y + hi[5]; w[6] = b1.z + hi[6]; w[7] = b1.w + hi[7];
        float* o = Y + (size_t)row * D + col;
        *(f32x4*)o = (f32x4){v[0], v[1], v[2], v[3]}; *(f32x4*)(o + 4) = (f32x4){v[4], v[5], v[6], v[7]};
        *(f32x4*)(o + 128) = (f32x4){w[0], w[1], w[2], w[3]}; *(f32x4*)(o + 132) = (f32x4){w[4], w[5], w[6], w[7]};
        float ss = 0.f;
#pragma unroll
        for (int i = 0; i < 8; ++i) ss += v[i] * v[i] + w[i] * w[i];
        ss += __shfl_xor(ss, X1M); ss += __shfl_xor(ss, X2M);
        if ((c0 & 31) == 0) SSP[(size_t)row * 16 + pn * 4 + (c0 >> 5)] = ss;
    }
};

template <class Epi> __device__ __forceinline__ void gemm_simple(LAS unsigned char* lds, const bf16_t* A, const bf16_t* Bt, int M, int N, int K, const Epi& E, int vb, int G) {
    LAS bf16_t* sA = (LAS bf16_t*)lds;
    LAS bf16_t* sB = (LAS bf16_t*)(lds + 4096);
    const int tid = opaque((int)threadIdx.x), r = tid >> 4, c0 = (tid & 15) * 8;
    const int nN = N / 256, nunits = (M / 32) * nN;
    for (int u = vb; u < nunits; u += G) {
        const int ms = u / nN, pn = u % nN, row0 = ms * 32, col0 = pn * 256;
        float lo[8], hi[8];
#pragma unroll
        for (int i = 0; i < 8; ++i) { lo[i] = 0.f; hi[i] = 0.f; }
        for (int k0 = 0; k0 < K; k0 += 32) {
            __syncthreads();
            if (tid < 128) { const int rr = tid >> 2, kc = (tid & 3) * 8; *(LAS u32x4*)(sA + rr * 40 + kc) = *(const u32x4*)(A + (size_t)(row0 + rr) * K + k0 + kc); }
            for (int q = tid; q < 1024; q += NTHR) { const int rr = q >> 2, kc = (q & 3) * 8; *(LAS u32x4*)(sB + rr * 40 + kc) = *(const u32x4*)(Bt + (size_t)(col0 + rr) * K + k0 + kc); }
            __syncthreads();
#pragma unroll 1
            for (int kc = 0; kc < 32; kc += 8) {
                const u32x4 av = *(const LAS u32x4*)(sA + r * 40 + kc);
                const float a0 = bflo(av.x), a1 = bfhi(av.x), a2 = bflo(av.y), a3 = bfhi(av.y), a4 = bflo(av.z), a5 = bfhi(av.z), a6 = bflo(av.w), a7 = bfhi(av.w);
#pragma unroll
                for (int i = 0; i < 8; ++i) {
                    const u32x4 b = *(const LAS u32x4*)(sB + (c0 + i) * 40 + kc);
                    lo[i] += a0 * bflo(b.x) + a1 * bfhi(b.x) + a2 * bflo(b.y) + a3 * bfhi(b.y) + a4 * bflo(b.z) + a5 * bfhi(b.z) + a6 * bflo(b.w) + a7 * bfhi(b.w);
                    const u32x4 c = *(const LAS u32x4*)(sB + (128 + c0 + i) * 40 + kc);
                    hi[i] += a0 * bflo(c.x) + a1 * bfhi(c.x) + a2 * bflo(c.y) + a3 * bfhi(c.y) + a4 * bflo(c.z) + a5 * bfhi(c.z) + a6 * bflo(c.w) + a7 * bfhi(c.w);
                }
            }
        }
        const int row = row0 + r; const float rsc = E.rowscale(row);
        E.template tile8<1, 2>(row, pn, c0, lo, hi, rsc);
    }
}

namespace pg8 {
#define PG8_LAS __attribute__((address_space(3)))
constexpr int BM = 256, BK = 64, HALF = 128, HTB = HALF * BK * 2  , STAGE_BYTES = 8 * HTB, NXCD = 8, WGM = 8;

__host__ __device__ __forceinline__ int lds_byte(int r, int c) { const int st = (r >> 4) * 2 + (c >> 5), rr = r & 15, cc = c & 31, ob = rr * 64 + cc * 2; return st * 1024 + (ob ^ (((ob >> 9) & 1) << 5)); }
__host__ __device__ __forceinline__ void stage_rc(int b, int& R, int& C) { const int st = b / 1024, sb = b % 1024, swz = sb ^ (((sb >> 9) & 1) << 5); R = (st >> 1) * 16 + swz / 64; C = (st & 1) * 32 + (swz % 64) / 2; }
__host__ __device__ __forceinline__ int perm32(int rho) { const int n = rho >> 4, i = rho & 15; return 8 * (i >> 2) + 4 * n + (i & 3); }

struct Unit { int pm, pn; };
struct Gemm { const bf16_t* A; const bf16_t* Bt; int M, N, K; };

struct StaticOrder {
    int nM, nN, nwg, G, c;
    __host__ __device__ void init(int M, int N, int G_, int c_) { nM = M / BM; nN = N / BM; nwg = nM * nN; G = G_; c = c_; }
    __host__ __device__ bool next(int i, Unit& u) const {
        const long L = (long)i * G + c; if (L >= nwg) return false;
        int wgid = (int)L; { const int q = nwg / NXCD, r = nwg % NXCD, xcd = wgid % NXCD, off = wgid / NXCD; wgid = (xcd < r ? xcd * (q + 1) : r * (q + 1) + (xcd - r) * q) + off; }
        const int nig = WGM * nN, gid = wgid / nig, fm = gid * WGM, gsz = (nM - fm) < WGM ? (nM - fm) : WGM;
        u.pm = fm + ((wgid % nig) % gsz); u.pn = (wgid % nig) / gsz; return true;
    }
    __device__ __forceinline__ void a_ready(const Unit&) const {}
    __device__ __forceinline__ void done(const Unit&) const {}
};
template <class Epi, class Sched, bool ALIGN_EPI = false, bool SP2 = false>
__device__ __forceinline__ void gemm_phase(PG8_LAS unsigned char* lds, const Gemm g, const Sched& S, const Epi& E) {
    const int tid = opaque((int)threadIdx.x), wid = __builtin_amdgcn_readfirstlane(tid >> 6), lane = tid & 63, wr = wid >> 2, wc = wid & 3, fr = lane & 15, fq = lane >> 4;
    const int K = g.K, nt = K / BK;
    unsigned voffA[2], voffB[2];
#pragma unroll
    for (int i = 0; i < 2; ++i) { int R, C; stage_rc(tid * 16 + i * 8192, R, C); const int Rb = Epi::PERM ? ((R & ~31) + perm32(R & 31)) : R;
        voffA[i] = (unsigned)(R * K + C) * 2u; voffB[i] = (unsigned)(Rb * K + C) * 2u; }
    const size_t kstep = (size_t)(BK * 2);
    const size_t hstep = (size_t)HALF * K * 2;
    const size_t tstep = 2 * hstep;
    const unsigned ldsw = (unsigned)wid * 1024u;
    const int aoff = lds_byte(wr * 64 + fr, fq * 8), boff = lds_byte(wc * 32 + fr, fq * 8);
#define PG8_SA(b, h) (((b) * 2 + (h)) * HTB)
#define PG8_SB(b, h) ((4 + (b) * 2 + (h)) * HTB)
#define PG8_STAGE(bufoff, gbase, voff) do { _Pragma("unroll") for (int _i = 0; _i < 2; ++_i) \
        __builtin_amdgcn_global_load_lds((const unsigned*)((const char*)(gbase) + (voff)[_i]), (PG8_LAS unsigned*)(lds + (bufoff) + ldsw + _i * 8192), 16, 0, 0); } while (0)
#define PG8_LDA(dst, b, h) do { _Pragma("unroll") for (int m = 0; m < 4; ++m) _Pragma("unroll") for (int k = 0; k < 2; ++k) dst[m][k] = *(const PG8_LAS bf16x8*)(lds + PG8_SA(b, h) + aoff + m * 2048 + k * 1024); } while (0)
#define PG8_LDB(dst, b, h) do { _Pragma("unroll") for (int n = 0; n < 2; ++n) _Pragma("unroll") for (int k = 0; k < 2; ++k) dst[n][k] = *(const PG8_LAS bf16x8*)(lds + PG8_SB(b, h) + boff + n * 2048 + k * 1024); } while (0)
#define PG8_MMA(ai, bj, At, Bt) do { __builtin_amdgcn_s_setprio(1); _Pragma("unroll") for (int m = 0; m < 4; ++m) _Pragma("unroll") for (int n = 0; n < 2; ++n) _Pragma("unroll") for (int k = 0; k < 2; ++k) \
        acc[ai][bj][m][n] = __builtin_amdgcn_mfma_f32_16x16x32_bf16(Bt[n][k], At[m][k], acc[ai][bj][m][n], 0, 0, 0); __builtin_amdgcn_s_setprio(0); } while (0)
#define PG8_WAIT_V(n) asm volatile("s_waitcnt vmcnt(" #n ")" ::: "memory")
#define PG8_WAIT_L(n) asm volatile("s_waitcnt lgkmcnt(" #n ")" ::: "memory")
#define PG8_BAR __builtin_amdgcn_s_barrier()
#define PG8_SCHED __builtin_amdgcn_sched_barrier(0)
    Unit cur, nxt; int ui = 0;
    if (!S.next(0, cur)) return;
    f32x4 acc[2][2][4][2];
#pragma unroll
    for (int a = 0; a < 2; ++a)
#pragma unroll
        for (int b = 0; b < 2; ++b)
#pragma unroll
            for (int m = 0; m < 4; ++m)
#pragma unroll
                for (int n = 0; n < 2; ++n) acc[a][b][m][n] = (f32x4){0.f, 0.f, 0.f, 0.f};
    bf16x8 At[4][2], B0[2][2], B1[2][2];
    const char* cA = (const char*)g.A + (size_t)cur.pm * tstep; const char* cB = (const char*)g.Bt + (size_t)cur.pn * tstep;
    S.a_ready(cur);
    if constexpr (SP2) {
        PG8_STAGE(PG8_SB(0, 0), cB, voffB); PG8_STAGE(PG8_SB(0, 1), cB + hstep, voffB); PG8_STAGE(PG8_SA(0, 0), cA, voffA); PG8_STAGE(PG8_SA(0, 1), cA + hstep, voffA);
        if (wr == 1) PG8_BAR;
        PG8_WAIT_V(2); PG8_BAR;
        PG8_STAGE(PG8_SB(1, 0), cB + kstep, voffB); PG8_STAGE(PG8_SA(1, 0), cA + kstep, voffA); PG8_STAGE(PG8_SB(1, 1), cB + hstep + kstep, voffB);
        PG8_WAIT_V(6); PG8_BAR;
    } else {
        PG8_STAGE(PG8_SB(0, 0), cB, voffB); PG8_STAGE(PG8_SA(0, 0), cA, voffA); PG8_STAGE(PG8_SB(0, 1), cB + hstep, voffB); PG8_STAGE(PG8_SA(0, 1), cA + hstep, voffA);
        if (wr == 1) PG8_BAR;
        PG8_WAIT_V(4); PG8_BAR;
        PG8_STAGE(PG8_SB(1, 0), cB + kstep, voffB); PG8_STAGE(PG8_SA(1, 0), cA + kstep, voffA); PG8_STAGE(PG8_SB(1, 1), cB + hstep + kstep, voffB);
        PG8_WAIT_V(6); PG8_BAR;
    }
    for (;;) {
        const bool has_next = S.next(ui + 1, nxt);
        const char* nA = has_next ? (const char*)g.A + (size_t)nxt.pm * tstep : cA; const char* nB = has_next ? (const char*)g.Bt + (size_t)nxt.pn * tstep : cB;
        for (int t = 0; t < nt; t += 2) {
            const bool last = (t == nt - 2);
            const char* a1 = cA + (size_t)(t + 1) * kstep;
            const char* a2 = last ? nA : cA + (size_t)(t + 2) * kstep; const char* b2 = last ? nB : cB + (size_t)(t + 2) * kstep;
            const char* a3 = a2 + kstep; const char* b3 = b2 + kstep;
            if (last && has_next) S.a_ready(nxt);
            if constexpr (SP2) {
            PG8_LDB(B0, 0, 0); PG8_LDB(B1, 0, 1); PG8_SCHED; PG8_LDA(At, 0, 0); PG8_STAGE(PG8_SA(1, 1), a1 + hstep, voffA);
            PG8_WAIT_V(8); PG8_WAIT_L(0); PG8_BAR; PG8_MMA(0, 0, At, B0); PG8_MMA(0, 1, At, B1); PG8_BAR; PG8_SCHED;
            PG8_LDA(At, 0, 1); PG8_STAGE(PG8_SB(0, 0), b2, voffB); PG8_STAGE(PG8_SB(0, 1), b2 + hstep, voffB); PG8_STAGE(PG8_SA(0, 0), a2, voffA);
            PG8_WAIT_V(8); PG8_WAIT_L(0); PG8_BAR; PG8_MMA(1, 0, At, B0); PG8_MMA(1, 1, At, B1); PG8_BAR; PG8_SCHED;
            PG8_LDB(B0, 1, 0); PG8_LDB(B1, 1, 1); PG8_SCHED; PG8_LDA(At, 1, 0); PG8_STAGE(PG8_SA(0, 1), a2 + hstep, voffA);
            PG8_WAIT_V(8); PG8_WAIT_L(0); PG8_BAR; PG8_MMA(0, 0, At, B0); PG8_MMA(0, 1, At, B1); PG8_BAR; PG8_SCHED;
            PG8_LDA(At, 1, 1); PG8_STAGE(PG8_SB(1, 0), b3, voffB); PG8_STAGE(PG8_SB(1, 1), b3 + hstep, voffB); PG8_STAGE(PG8_SA(1, 0), a3, voffA);
            PG8_WAIT_V(8); PG8_WAIT_L(0); PG8_BAR; PG8_MMA(1, 0, At, B0); PG8_MMA(1, 1, At, B1); PG8_BAR; PG8_SCHED;
            } else {
            PG8_LDB(B0, 0, 0); PG8_SCHED; PG8_LDA(At, 0, 0); PG8_STAGE(PG8_SA(1, 1), a1 + hstep, voffA);
            PG8_WAIT_L(8); PG8_BAR; PG8_WAIT_L(0); PG8_MMA(0, 0, At, B0); PG8_BAR; PG8_SCHED;
            PG8_LDB(B1, 0, 1); PG8_STAGE(PG8_SB(0, 0), b2, voffB);
            PG8_BAR; PG8_WAIT_L(0); PG8_MMA(0, 1, At, B1); PG8_BAR;
            PG8_LDA(At, 0, 1); PG8_STAGE(PG8_SA(0, 0), a2, voffA);
            PG8_BAR; PG8_WAIT_L(0); PG8_MMA(1, 0, At, B0); PG8_BAR; PG8_SCHED;
            PG8_STAGE(PG8_SB(0, 1), b2 + hstep, voffB);
            PG8_WAIT_V(6); PG8_BAR; PG8_MMA(1, 1, At, B1); PG8_BAR;
            PG8_LDB(B0, 1, 0); PG8_SCHED; PG8_LDA(At, 1, 0); PG8_STAGE(PG8_SA(0, 1), a2 + hstep, voffA);
            PG8_WAIT_L(8); PG8_BAR; PG8_WAIT_L(0); PG8_MMA(0, 0, At, B0); PG8_BAR; PG8_SCHED;
            PG8_LDB(B1, 1, 1); PG8_STAGE(PG8_SB(1, 0), b3, voffB);
            PG8_BAR; PG8_WAIT_L(0); PG8_MMA(0, 1, At, B1); PG8_BAR;
            PG8_LDA(At, 1, 1); PG8_STAGE(PG8_SA(1, 0), a3, voffA);
            PG8_BAR; PG8_WAIT_L(0); PG8_MMA(1, 0, At, B0); PG8_BAR; PG8_SCHED;
            PG8_STAGE(PG8_SB(1, 1), b3 + hstep, voffB);
            PG8_WAIT_V(6); PG8_BAR; PG8_MMA(1, 1, At, B1); PG8_BAR;
            }
        }
        if constexpr (ALIGN_EPI) { if (wr == 0) PG8_BAR; }
        if constexpr (!Epi::AFTER_DRAIN) { E(acc, cur, wr, wc, fr, fq); S.done(cur); }
        if (!has_next) break;
#pragma unroll
        for (int a = 0; a < 2; ++a)
#pragma unroll
            for (int b = 0; b < 2; ++b)
#pragma unroll
                for (int m = 0; m < 4; ++m)
#pragma unroll
                    for (int n = 0; n < 2; ++n) acc[a][b][m][n] = (f32x4){0.f, 0.f, 0.f, 0.f};
        cur = nxt; cA = nA; cB = nB; ++ui;
        if constexpr (ALIGN_EPI) { if (wr == 1) PG8_BAR; }
    }
    PG8_WAIT_V(0);
    if constexpr (!ALIGN_EPI) { if (wr == 0) PG8_BAR; }
    PG8_BAR;
    if constexpr (Epi::AFTER_DRAIN) { E.fused(acc, cur, wr, wc, fr, fq, lds, wid, lane); S.done(cur); }
#undef PG8_SA
#undef PG8_SB
#undef PG8_STAGE
#undef PG8_LDA
#undef PG8_LDB
#undef PG8_MMA
#undef PG8_WAIT_V
#undef PG8_WAIT_L
#undef PG8_BAR
#undef PG8_SCHED
}
}

template <class E> struct EpiAd {
    static constexpr bool PERM = true, AFTER_DRAIN = false; E e;
    __device__ __forceinline__ void operator()(const f32x4 (&acc)[2][2][4][2], const pg8::Unit& u, int wr, int wc, int fr, int fq) const {
#pragma unroll
        for (int ai = 0; ai < 2; ++ai)
#pragma unroll
            for (int m = 0; m < 4; ++m) {
                const int row = u.pm * 256 + ai * 128 + wr * 64 + m * 16 + fr;
                const float rsc = e.rowscale(row);
                float lo[8], hi[8];
#pragma unroll
                for (int j = 0; j < 4; ++j) { lo[j] = acc[ai][0][m][0][j]; lo[4 + j] = acc[ai][0][m][1][j]; hi[j] = acc[ai][1][m][0][j]; hi[4 + j] = acc[ai][1][m][1][j]; }
                e.template tile8<16, 32>(row, u.pn, wc * 32 + 8 * fq, lo, hi, rsc);
            }
    }
};
template <class E> __device__ __forceinline__ void gemm_fast(LAS unsigned char* lds, const bf16_t* A, const bf16_t* Bt, int M, int N, int K, const E& e, int vb, int G) {
    pg8::Gemm g{A, Bt, M, N, K}; pg8::StaticOrder S; S.init(M, N, G, vb);
    EpiAd<E> Ea{e};
    pg8::gemm_phase<EpiAd<E>, pg8::StaticOrder, true, true>(lds, g, S, Ea);
}
#if FAST_GEMM
#define GEMM gemm_fast
#else
#define GEMM gemm_simple
#endif

__device__ __forceinline__ void conv_simple(const Params& p, LAS unsigned char* lds, int vb, int G) {
    LAS float* red = (LAS float*)lds;
    const bf16_t* A = (const bf16_t*)(p.ws + WS_R1); const bf16_t* SGA = A + (size_t)T * 1024; bf16_t* H0 = (bf16_t*)p.out;
    const float *cw = p.in[6], *cb = p.in[7], *lg = p.in[8], *lbeta = p.in[9], *sc = p.in[2];
    const int tid = opaque((int)threadIdx.x), c = tid * 2;
    for (int r = vb; r < T; r += G) {
        int t, rowbase; const float* hist;
        if (r < TP) { t = r & 2047; rowbase = r - t; hist = nullptr; } else { const int b = (r - TP) >> 3; t = (r - TP) & 7; rowbase = r - t; hist = sc + (size_t)b * 30 * 1024; }
        float y0 = cb[c], y1 = cb[c + 1];
        for (int j = 0; j < 31; ++j) { const int i = t + j - 30; float a0 = 0.f, a1 = 0.f;
            if (i >= 0) { const unsigned w = *(const unsigned*)(A + (size_t)(rowbase + i) * 1024 + c); a0 = bflo(w); a1 = bfhi(w); }
            else if (hist) { a0 = hist[(30 + i) * 1024 + c]; a1 = hist[(30 + i) * 1024 + c + 1]; }
            y0 += cw[j * 1024 + c] * a0; y1 += cw[j * 1024 + c + 1] * a1; }
        const float mean = block_sum(y0 + y1, red) * (1.f / 1024.f);
        const float d0 = y0 - mean, d1 = y1 - mean;
        const float rstd = rsqrtf(block_sum(d0 * d0 + d1 * d1, red) * (1.f / 1024.f) + EPS);
        const float n0 = d0 * rstd * lg[c] + lbeta[c], n1 = d1 * rstd * lg[c + 1] + lbeta[c + 1];
        const unsigned gw = *(const unsigned*)(SGA + (size_t)r * 1024 + c);
        *(unsigned*)(H0 + (size_t)r * 2048 + c) = pk2(silu(n0) * bflo(gw), silu(n1) * bfhi(gw));
    }
    for (int idx = vb * NTHR + tid; idx < 8 * 30 * 1024; idx += G * NTHR) { const int b = idx / 30720, rem = idx % 30720, i = rem >> 10, cc = rem & 1023;
        p.out[O_CP + idx] = bf2f(A[(size_t)(b * 2048 + 2018 + i) * 1024 + cc]); }
    for (int idx = vb * NTHR + tid; idx < 128 * 30 * 1024; idx += G * NTHR) { const int b = idx / 30720, rem = idx % 30720, i = rem >> 10, cc = rem & 1023;
        p.out[O_CS + idx] = (i < 22) ? sc[(size_t)(b * 30 + 8 + i) * 1024 + cc] : bf2f(A[(size_t)(TP + b * 8 + i - 22) * 1024 + cc]); }
}


typedef float f32x16 __attribute__((ext_vector_type(16)));
__device__ __forceinline__ bf16x8 ldfrag(const LAS unsigned char* img, int pitchB, int row0, int k0, int lane) {
    return *(const LAS bf16x8*)(img + (row0 + (lane & 31)) * pitchB + (k0 + 8 * (lane >> 5)) * 2);
}
__device__ __forceinline__ unsigned ld_u16(const void* base, unsigned boff) { return *(const unsigned short*)((const char*)base + boff); }
__device__ __forceinline__ void st_u16(void* base, unsigned boff, unsigned v) { *(unsigned short*)((char*)base + boff) = (unsigned short)v; }
#define MFMA32(a, b, c) __builtin_amdgcn_mfma_f32_32x32x16_bf16((a), (b), (c), 0, 0, 0)
__device__ __forceinline__ int accrow(int r, int lane) { return (r & 3) + 8 * (r >> 2) + 4 * (lane >> 5); }

__device__ __forceinline__ void conv_fast(const Params& p, LAS unsigned char* lds, int vb, int G) {
    LAS float* red = (LAS float*)lds;
    const bf16_t* A = (const bf16_t*)(p.ws + WS_R1); const bf16_t* SGA = A + (size_t)T * 1024; bf16_t* H0 = (bf16_t*)p.out;
    const float *cw = p.in[6], *cb = p.in[7], *lg = p.in[8], *lbeta = p.in[9], *sc = p.in[2];
    const int tid = opaque((int)threadIdx.x), lane = tid & 63, wave = tid >> 6, c = tid * 2;
    LAS float* cwl = (LAS float*)(lds + 1024);
    __syncthreads();
    for (int q = tid; q < 31 * 256; q += NTHR) *(LAS f32x4*)(cwl + q * 4) = *(const f32x4*)(cw + q * 4);
    __syncthreads();
    const float cb0 = cb[c], cb1 = cb[c + 1], g0 = lg[c], g1 = lg[c + 1], be0 = lbeta[c], be1 = lbeta[c + 1];
    for (int item = vb; item < 384; item += G) {
        int L, rowfirst; float w0[38], w1[38];
        if (item < 256) { const int b = item >> 5, t0 = (item & 31) * 64; L = 64; rowfirst = b * 2048 + t0;
#pragma unroll
            for (int i = 0; i < 30; ++i) { unsigned u = 0u; if (t0 > 0) u = *(const unsigned*)(A + (size_t)(rowfirst - 30 + i) * 1024 + c); w0[i] = bflo(u); w1[i] = bfhi(u); }
        } else { const int sb = item - 256; L = 8; rowfirst = TP + sb * 8; const float* hist = sc + (size_t)sb * 30 * 1024;
#pragma unroll
            for (int i = 0; i < 30; ++i) { const f32x2 hv = *(const f32x2*)(hist + i * 1024 + c); w0[i] = hv.x; w1[i] = hv.y; }
        }
        for (int g = 0; g < L; g += 8) {
#pragma unroll
            for (int k = 0; k < 8; ++k) { const unsigned u = *(const unsigned*)(A + (size_t)(rowfirst + g + k) * 1024 + c); w0[30 + k] = bflo(u); w1[30 + k] = bfhi(u); }
            float y0[8], y1[8], st[16];
#pragma unroll
            for (int k = 0; k < 8; ++k) { y0[k] = cb0; y1[k] = cb1; }
#pragma unroll
            for (int j = 0; j < 31; ++j) { const f32x2 w = *(const LAS f32x2*)(cwl + j * 1024 + c);
#pragma unroll
                for (int k = 0; k < 8; ++k) { y0[k] += w.x * w0[k + j]; y1[k] += w.y * w1[k + j]; } }
#pragma unroll
            for (int k = 0; k < 8; ++k) { st[k] = y0[k] + y1[k]; st[8 + k] = y0[k] * y0[k] + y1[k] * y1[k]; }
#pragma unroll
            for (int k = 0; k < 16; ++k) st[k] = wave_sum(st[k]);
            if (lane == 0) {
#pragma unroll
                for (int k = 0; k < 16; ++k) red[wave * 16 + k] = st[k]; }
            __syncthreads();
            if (tid < 16) { float s = 0.f;
#pragma unroll
                for (int w = 0; w < 8; ++w) s += red[w * 16 + tid];
                red[128 + tid] = s; }
            __syncthreads();
#pragma unroll
            for (int k = 0; k < 8; ++k) { const float mean = red[128 + k] * (1.f / 1024.f); const float var = red[136 + k] * (1.f / 1024.f) - mean * mean; const float rstd = rsqrtf(var + EPS);
                const float n0 = (y0[k] - mean) * rstd * g0 + be0, n1 = (y1[k] - mean) * rstd * g1 + be1;
                const size_t row = (size_t)(rowfirst + g + k);
                const unsigned gw = *(const unsigned*)(SGA + row * 1024 + c);
                *(unsigned*)(H0 + row * 2048 + c) = pk2(silu(n0) * bflo(gw), silu(n1) * bfhi(gw)); }
#pragma unroll
            for (int i = 0; i < 30; ++i) { w0[i] = w0[i + 8]; w1[i] = w1[i + 8]; }
        }
    }
    for (int idx = vb * NTHR + tid; idx < 8 * 30 * 1024; idx += G * NTHR) { const int b = idx / 30720, rem = idx % 30720, i = rem >> 10, cc = rem & 1023;
        p.out[O_CP + idx] = bf2f(A[(size_t)(b * 2048 + 2018 + i) * 1024 + cc]); }
    for (int idx = vb * NTHR + tid; idx < 128 * 30 * 1024; idx += G * NTHR) { const int b = idx / 30720, rem = idx % 30720, i = rem >> 10, cc = rem & 1023;
        p.out[O_CS + idx] = (i < 22) ? sc[(size_t)(b * 30 + 8 + i) * 1024 + cc] : bf2f(A[(size_t)(TP + b * 8 + i - 22) * 1024 + cc]); }
}

__device__ __forceinline__ void hgrn_simple(const Params& p, LAS unsigned char* lds, int vb, int G, int item_lo, int item_hi) {
    LAS float* sf = (LAS float*)lds; LAS float* sk = sf + 1024; LAS float* sq = sk + 1024; LAS float* si = sq + 1024; LAS float* so = si + 1024; LAS float* so2 = so + 4096;
    const int tid = opaque((int)threadIdx.x), v = tid & 127, dq = tid >> 7, lane = tid & 63, wave = tid >> 6;
    const bf16_t* Z = (const bf16_t*)(p.ws + WS_R1);
    const bf16_t *Q = Z + (size_t)2 * T * 1024, *LOGF = Z + (size_t)3 * T * 1024, *I = Z + (size_t)4 * T * 1024, *SGB = Z + (size_t)5 * T * 1024;
    const float* og = p.in[11]; bf16_t* H0 = (bf16_t*)p.out;
    for (int item = item_lo + vb; item < item_hi; item += G) {
        int h, L, rowbase; const float* s0; float* sout;
        if (item < 64) { const int b = item >> 3; h = item & 7; L = 2048; rowbase = b * 2048; s0 = nullptr; sout = p.out + O_HP + (size_t)item * 16384; }
        else { const int it = item - 64, b = it >> 3; h = it & 7; L = 8; rowbase = TP + b * 8; s0 = p.in[3] + (size_t)it * 16384; sout = p.out + O_HS + (size_t)it * 16384; }
        float S[32];
#pragma unroll
        for (int j = 0; j < 32; ++j) S[j] = s0 ? s0[(dq * 32 + j) * 128 + v] : 0.f;
        for (int t0 = 0; t0 < L; t0 += 8) {
            __syncthreads();
            for (int e = tid; e < 1024; e += NTHR) { const int tt = e >> 7, d = e & 127; const size_t off = (size_t)(rowbase + t0 + tt) * 1024 + h * 128 + d;
                const float f = __expf(bf2f(LOGF[off])); sf[e] = f; sk[e] = 1.f - f; sq[e] = bf2f(Q[off]); si[e] = bf2f(I[off]); }
            __syncthreads();
#pragma unroll 1
            for (int tt = 0; tt < 8; ++tt) { const float iv = si[tt * 128 + v]; float op = 0.f;
#pragma unroll
                for (int j = 0; j < 32; ++j) { const int d = dq * 32 + j; S[j] = sf[tt * 128 + d] * S[j] + sk[tt * 128 + d] * iv; op += S[j] * sq[tt * 128 + d]; }
                so[(tt * 4 + dq) * 128 + v] = op; }
            __syncthreads();
            for (int e = tid; e < 1024; e += NTHR) { const int tt = e >> 7, vv = e & 127; so2[e] = (so[(tt * 4 + 0) * 128 + vv] + so[(tt * 4 + 1) * 128 + vv]) + (so[(tt * 4 + 2) * 128 + vv] + so[(tt * 4 + 3) * 128 + vv]); }
            __syncthreads();
            { const int tt = wave; const size_t row = (size_t)(rowbase + t0 + tt);
              const float o0 = so2[tt * 128 + lane], o1 = so2[tt * 128 + 64 + lane];
              const float rs = rsqrtf(wave_sum(o0 * o0 + o1 * o1) * (1.f / 128.f) + EPS);
              const float r0 = o0 * rs * og[h * 128 + lane] * bf2f(SGB[row * 1024 + h * 128 + lane]);
              const float r1 = o1 * rs * og[h * 128 + 64 + lane] * bf2f(SGB[row * 1024 + h * 128 + 64 + lane]);
              H0[row * 2048 + 1024 + h * 128 + lane] = (bf16_t)f2bf(r0); H0[row * 2048 + 1024 + h * 128 + 64 + lane] = (bf16_t)f2bf(r1); }
        }
#pragma unroll
        for (int j = 0; j < 32; ++j) sout[(dq * 32 + j) * 128 + v] = S[j];
    }
}


constexpr size_t WS_BSUM = 131072;
constexpr int HA_QM = 0, HA_KM = 17408, HA_KMT = 34816, HA_VT = 53248, HA_P = 71680, HA_ST = 80896, HA_TOT = 115712, HA_DEC = 117760;
constexpr int PQ = 272, PS = 144;
__device__ __forceinline__ void hgrn_phaseA(const Params& p, LAS unsigned char* lds, int vb, int G) {
    const int tid = opaque((int)threadIdx.x), lane = tid & 63, wid = __builtin_amdgcn_readfirstlane(tid >> 6);
    const int d = tid & 127, tq = tid >> 7;
    bf16_t* Zb = (bf16_t*)(p.ws + WS_R1);
    bf16_t* Qg = Zb + (size_t)2 * T * 1024; bf16_t* LFg = Zb + (size_t)3 * T * 1024; const bf16_t* Ig = Zb + (size_t)4 * T * 1024;
    float* SEG = (float*)(p.ws + WS_SEG); float* BSUM = (float*)(p.ws + WS_BSUM);
    LAS float* TOT = (LAS float*)(lds + HA_TOT); LAS float* DEC = (LAS float*)(lds + HA_DEC);
    for (int item = vb; item < 256; item += G) {
        const int bh = item >> 2, seg = item & 3, b = bh >> 3, h = bh & 7;
        const size_t row0 = (size_t)b * 2048 + seg * 512; const int cb = h * 128;
        __syncthreads();
        for (int i = tid; i < 2176; i += NTHR) *(LAS u32x4*)(lds + HA_ST + i * 16) = (u32x4){0u, 0u, 0u, 0u};
        const int dt = wid >> 1, vts = (wid & 1) * 2;
        f32x16 S[2];
#pragma unroll
        for (int j2 = 0; j2 < 2; ++j2)
#pragma unroll
            for (int r = 0; r < 16; ++r) S[j2][r] = 0.f;
        float bsum = 0.f;
        unsigned rq[16], rf[16], ri[16];
        const unsigned toff = ((unsigned)(16 * tq) * 1024u + (unsigned)d) * 2u;
        { const bf16_t* qb = Qg + row0 * 1024 + cb; const bf16_t* fb = LFg + row0 * 1024 + cb; const bf16_t* ib = Ig + row0 * 1024 + cb;
#pragma unroll
          for (int j = 0; j < 16; ++j) { rq[j] = ld_u16(qb, toff + j * 2048u); rf[j] = ld_u16(fb, toff + j * 2048u); ri[j] = ld_u16(ib, toff + j * 2048u); } }
        for (int c = 0; c < 8; ++c) {
            const size_t r0 = row0 + c * 64;
            float bc[16]; float run = 0.f;
#pragma unroll
            for (int j = 0; j < 16; ++j) { run += bf2f(rf[j]); bc[j] = run; }
            TOT[tq * 128 + d] = run;
            __syncthreads();
            float pre = 0.f, bend = 0.f;
#pragma unroll
            for (int q = 0; q < 4; ++q) { const float t = TOT[q * 128 + d]; pre += (q < tq) ? t : 0.f; bend += t; }
            if (tq == 0) DEC[d] = __expf(bend);
            const float eseg = __expf(bsum);
            unsigned kmp[8], vtp[8]; const unsigned to1 = (unsigned)opaque((int)toff);
#pragma unroll
            for (int j = 0; j < 16; j += 2) {
                float km2[2];
#pragma unroll
                for (int u = 0; u < 2; ++u) { const int jj = j + u; const float bcum = pre + bc[jj]; const float f = __expf(bf2f(rf[jj]));
                    const float qm = bf2f(rq[jj]) * __expf(bcum), km = (1.f - f) * __expf(-bcum); km2[u] = km;
                    const int t = 16 * tq + jj;
                    *(LAS bf16_t*)(lds + HA_QM + t * PQ + d * 2) = (bf16_t)f2bf(qm); *(LAS bf16_t*)(lds + HA_KM + t * PQ + d * 2) = (bf16_t)f2bf(km);
                    st_u16(LFg + r0 * 1024 + cb, to1 + jj * 2048u, f2bf(qm * eseg)); }
                kmp[j >> 1] = pk2(km2[0], km2[1]); vtp[j >> 1] = ri[j] | (ri[j + 1] << 16);
            }
            *(LAS u32x4*)(lds + HA_KMT + d * PS + tq * 32) = (u32x4){kmp[0], kmp[1], kmp[2], kmp[3]}; *(LAS u32x4*)(lds + HA_KMT + d * PS + tq * 32 + 16) = (u32x4){kmp[4], kmp[5], kmp[6], kmp[7]};
            *(LAS u32x4*)(lds + HA_VT + d * PS + tq * 32) = (u32x4){vtp[0], vtp[1], vtp[2], vtp[3]}; *(LAS u32x4*)(lds + HA_VT + d * PS + tq * 32 + 16) = (u32x4){vtp[4], vtp[5], vtp[6], vtp[7]};
            bsum += bend;
            __syncthreads();
            f32x16 dS[2];
#pragma unroll
            for (int j2 = 0; j2 < 2; ++j2)
#pragma unroll
                for (int r = 0; r < 16; ++r) dS[j2][r] = 0.f;
            { bf16x8 af[4];
#pragma unroll
              for (int ks = 0; ks < 4; ++ks) af[ks] = ldfrag(lds + HA_KMT, PS, 32 * dt, 16 * ks, lane);
#pragma unroll
              for (int j2 = 0; j2 < 2; ++j2)
#pragma unroll
                  for (int ks = 0; ks < 4; ++ks) { const bf16x8 bb = ldfrag(lds + HA_VT, PS, 32 * (vts + j2), 16 * ks, lane); dS[j2] = MFMA32(af[ks], bb, dS[j2]); } }
            if (wid < 4) {
                const int mt = (wid + 1) >> 1, nt = (wid == 2 || wid == 3) ? 1 : 0;
                const int mtt = (wid == 3) ? 0 : mt;
                f32x16 acc;
#pragma unroll
                for (int r = 0; r < 16; ++r) acc[r] = 0.f;
                if (wid < 3) {
#pragma unroll
                    for (int ks = 0; ks < 8; ++ks) { const bf16x8 a = ldfrag(lds + HA_QM, PQ, 32 * mtt, 16 * ks, lane), bb = ldfrag(lds + HA_KM, PQ, 32 * nt, 16 * ks, lane); acc = MFMA32(a, bb, acc); }
                }
                const int lnx = opaque(lane); const int sx = 32 * nt + (lnx & 31), tb = 32 * mtt + 4 * (lnx >> 5);
                LAS unsigned char* pp = lds + HA_P + tb * PS + sx * 2;
#pragma unroll
                for (int r = 0; r < 16; ++r) { const int tr = (r & 3) + 8 * (r >> 2);
                    *(LAS bf16_t*)(pp + tr * PS) = (bf16_t)f2bf((sx <= tb + tr) ? acc[r] : 0.f); }
            }
            __syncthreads();
            if (c + 1 < 8) { const bf16_t* qb = Qg + (r0 + 64) * 1024 + cb; const bf16_t* fb = LFg + (r0 + 64) * 1024 + cb; const bf16_t* ib = Ig + (r0 + 64) * 1024 + cb;
                const unsigned to2 = (unsigned)opaque((int)toff);
#pragma unroll
                for (int j = 0; j < 16; ++j) { rq[j] = ld_u16(qb, to2 + j * 2048u); rf[j] = ld_u16(fb, to2 + j * 2048u); ri[j] = ld_u16(ib, to2 + j * 2048u); } }
            { const int mt = wid >> 2, vt = wid & 3; f32x16 o;
#pragma unroll
              for (int r = 0; r < 16; ++r) o[r] = 0.f;
#pragma unroll
              for (int ks = 0; ks < 4; ++ks) { const bf16x8 a = ldfrag(lds + HA_P, PS, 32 * mt, 16 * ks, lane), bb = ldfrag(lds + HA_VT, PS, 32 * vt, 16 * ks, lane); o = MFMA32(a, bb, o); }
#pragma unroll
              for (int ks = 0; ks < 8; ++ks) { const bf16x8 a = ldfrag(lds + HA_QM, PQ, 32 * mt, 16 * ks, lane), bb = ldfrag(lds + HA_ST, PQ, 32 * vt, 16 * ks, lane); o = MFMA32(a, bb, o); }
              const int lny = opaque(lane); const unsigned ob = ((unsigned)(32 * mt + 4 * (lny >> 5)) * 1024u + 32 * vt + (lny & 31)) * 2u;
#pragma unroll
              for (int r = 0; r < 16; ++r) st_u16(Qg + r0 * 1024 + cb, ob + ((r & 3) + 8 * (r >> 2)) * 2048u, f2bf(o[r])); }
            __syncthreads();
            { float dec[16]; const int lnu = opaque(lane); const LAS float* dp = DEC + 32 * dt + 4 * (lnu >> 5);
#pragma unroll
              for (int r = 0; r < 16; ++r) dec[r] = dp[(r & 3) + 8 * (r >> 2)];
#pragma unroll
              for (int j2 = 0; j2 < 2; ++j2) {
#pragma unroll
                  for (int r = 0; r < 16; ++r) S[j2][r] = dec[r] * (S[j2][r] + dS[j2][r]);
                  LAS unsigned char* sp2 = lds + HA_ST + (32 * (vts + j2) + (lnu & 31)) * PQ + (32 * dt + 4 * (lnu >> 5)) * 2;
#pragma unroll
                  for (int g = 0; g < 4; ++g)
                      *(LAS u32x2*)(sp2 + 16 * g) = (u32x2){pk2(S[j2][4 * g], S[j2][4 * g + 1]), pk2(S[j2][4 * g + 2], S[j2][4 * g + 3])};
              } }
        }
        { const int lns = opaque(lane); float* sp = SEG + (size_t)item * 16384 + (32 * dt + 4 * (lns >> 5)) * 128 + 32 * vts + (lns & 31);
#pragma unroll
            for (int j2 = 0; j2 < 2; ++j2)
#pragma unroll
                for (int r = 0; r < 16; ++r) sp[((r & 3) + 8 * (r >> 2)) * 128 + 32 * j2] = S[j2][r]; }
        if (tq == 0) BSUM[item * 128 + d] = bsum;
    }
}
constexpr int HB_AQ = 0, HB_SIN = 34816, HB_OT = 69632;
__device__ __forceinline__ void hgrn_phaseB(const Params& p, LAS unsigned char* lds, int vb, int G) {
    const int tid = opaque((int)threadIdx.x), lane = tid & 63, wid = __builtin_amdgcn_readfirstlane(tid >> 6);
    const int v = tid & 127, dg = tid >> 7;
    const bf16_t* Zb = (const bf16_t*)(p.ws + WS_R1);
    const bf16_t* OLg = Zb + (size_t)2 * T * 1024; const bf16_t* QSg = Zb + (size_t)3 * T * 1024; const bf16_t* SGB = Zb + (size_t)5 * T * 1024;
    const float* SEG = (const float*)(p.ws + WS_SEG); const float* BSUM = (const float*)(p.ws + WS_BSUM);
    const float* og = p.in[11]; bf16_t* H0 = (bf16_t*)p.out;
    LAS float* OT = (LAS float*)(lds + HB_OT);
    for (int item = vb; item < 256; item += G) {
        const int bh = item >> 2, seg = item & 3, b = bh >> 3, h = bh & 7;
        const size_t row0 = (size_t)b * 2048 + seg * 512; const int cb = h * 128;
        __syncthreads();
        if (seg > 0) {
            const float* S0 = SEG + (size_t)(bh * 4 + 0) * 16384; const float* S1 = S0 + 16384; const float* S2 = S1 + 16384; const float* S3 = S2 + 16384;
            const float* B1 = BSUM + (bh * 4 + 1) * 128; const float* B2 = B1 + 128; const float* B3 = B2 + 128;
            for (int d0 = dg * 32; d0 < dg * 32 + 32; d0 += 4) { float sv[4];
#pragma unroll
                for (int i = 0; i < 4; ++i) { const int dd = d0 + i; float s = S0[dd * 128 + v];
                    if (seg >= 2) s = __expf(B1[dd]) * s + S1[dd * 128 + v];
                    if (seg >= 3) s = __expf(B2[dd]) * s + S2[dd * 128 + v];
                    sv[i] = s;
                    if (seg == 3) p.out[O_HP + (size_t)bh * 16384 + dd * 128 + v] = __expf(B3[dd]) * s + S3[dd * 128 + v]; }
                *(LAS u32x2*)(lds + HB_SIN + v * PQ + d0 * 2) = (u32x2){pk2(sv[0], sv[1]), pk2(sv[2], sv[3])}; }
        }
        for (int rt = 0; rt < 4; ++rt) {
            const size_t r0 = row0 + rt * 128;
            if (seg > 0) {
                for (int q = tid; q < 2048; q += NTHR) { const int row = q >> 4, c16 = q & 15; *(LAS u32x4*)(lds + HB_AQ + row * PQ + c16 * 16) = *(const u32x4*)(QSg + (r0 + row) * 1024 + cb + c16 * 8); }
                __syncthreads();
                const int mt = wid >> 1, vt0 = (wid & 1) * 2; f32x16 acc0, acc1;
#pragma unroll
                for (int r = 0; r < 16; ++r) { acc0[r] = 0.f; acc1[r] = 0.f; }
#pragma unroll
                for (int ks = 0; ks < 8; ++ks) { const bf16x8 a = ldfrag(lds + HB_AQ, PQ, 32 * mt, 16 * ks, lane), b0 = ldfrag(lds + HB_SIN, PQ, 32 * vt0, 16 * ks, lane), b1 = ldfrag(lds + HB_SIN, PQ, 32 * (vt0 + 1), 16 * ks, lane);
                    acc0 = MFMA32(a, b0, acc0); acc1 = MFMA32(a, b1, acc1); }
#pragma unroll
                for (int r = 0; r < 16; ++r) { const int t = 32 * mt + accrow(r, lane); OT[t * 132 + 32 * vt0 + (lane & 31)] = acc0[r]; OT[t * 132 + 32 * (vt0 + 1) + (lane & 31)] = acc1[r]; }
                __syncthreads();
            }
            { const int row = tid >> 2, part = tid & 3; const size_t grow = r0 + row; const int c0 = cb + 32 * part;
              float o[32];
#pragma unroll
              for (int i = 0; i < 4; ++i) { const u32x4 w = *(const u32x4*)(OLg + grow * 1024 + c0 + 8 * i);
                  o[8 * i] = bflo(w.x); o[8 * i + 1] = bfhi(w.x); o[8 * i + 2] = bflo(w.y); o[8 * i + 3] = bfhi(w.y); o[8 * i + 4] = bflo(w.z); o[8 * i + 5] = bfhi(w.z); o[8 * i + 6] = bflo(w.w); o[8 * i + 7] = bfhi(w.w); }
              if (seg > 0) {
#pragma unroll
                  for (int i = 0; i < 8; ++i) { const f32x4 x = *(const LAS f32x4*)(OT + row * 132 + 32 * part + 4 * i); o[4 * i] += x.x; o[4 * i + 1] += x.y; o[4 * i + 2] += x.z; o[4 * i + 3] += x.w; } }
              float ss = 0.f;
#pragma unroll
              for (int i = 0; i < 32; ++i) ss += o[i] * o[i];
              ss += __shfl_xor(ss, 1); ss += __shfl_xor(ss, 2);
              const float rs = rsqrtf(ss * (1.f / 128.f) + EPS);
#pragma unroll
              for (int i = 0; i < 4; ++i) { const u32x4 gw = *(const u32x4*)(SGB + grow * 1024 + c0 + 8 * i);
                  const f32x4 g0 = *(const f32x4*)(og + h * 128 + 32 * part + 8 * i), g1 = *(const f32x4*)(og + h * 128 + 32 * part + 8 * i + 4);
                  float e[8];
                  e[0] = o[8 * i] * rs * g0.x * bflo(gw.x); e[1] = o[8 * i + 1] * rs * g0.y * bfhi(gw.x); e[2] = o[8 * i + 2] * rs * g0.z * bflo(gw.y); e[3] = o[8 * i + 3] * rs * g0.w * bfhi(gw.y);
                  e[4] = o[8 * i + 4] * rs * g1.x * bflo(gw.z); e[5] = o[8 * i + 5] * rs * g1.y * bfhi(gw.z); e[6] = o[8 * i + 6] * rs * g1.z * bflo(gw.w); e[7] = o[8 * i + 7] * rs * g1.w * bfhi(gw.w);
                  st8(H0 + grow * 2048 + 1024 + c0 + 8 * i, e); }
            }
        }
    }
}

__device__ __forceinline__ void gmlp_simple(const Params& p, LAS unsigned char* lds, int vb, int G, int row_lo) {
    LAS float* smean = (LAS float*)lds; LAS float* srstd = smean + 128;
    const f32x2* VST = (const f32x2*)(p.ws + WS_VST); const bf16_t* GV = (const bf16_t*)p.out; bf16_t* UG = (bf16_t*)(p.ws + WS_UG);
    const float *lg = p.in[15], *lb_ = p.in[16], *wsp = p.in[17], *bs = p.in[18];
    const int tid = opaque((int)threadIdx.x), ch = tid * 4, h = tid >> 6;
    const f32x4 g4 = *(const f32x4*)(lg + ch), b4 = *(const f32x4*)(lb_ + ch);
    for (int r = row_lo + vb; r < T; r += G) {
        int t, cstart;
        if (r < TP) { t = r & 127; cstart = r - t; } else { t = (r - TP) & 7; cstart = r - t; }
        __syncthreads();
        if (tid <= t) { const size_t row = (size_t)(cstart + tid); float s = 0.f, q = 0.f;
            for (int j = 0; j < 32; ++j) { const f32x2 st = VST[row * 32 + j]; s += st.x; q += st.y; }
            const float mean = s * (1.f / 2048.f); const float var = q * (1.f / 2048.f) - mean * mean; smean[tid] = mean; srstd[tid] = rsqrtf(var + EPS); }
        __syncthreads();
        float a0 = 0.f, a1 = 0.f, a2 = 0.f, a3 = 0.f, v0 = 0.f, v1 = 0.f, v2 = 0.f, v3 = 0.f;
        for (int s = 0; s <= t; ++s) {
            const float w = wsp[(size_t)(h * 128 + t) * 128 + s], m = smean[s], rs = srstd[s];
            const u32x2 gvw = *(const u32x2*)(GV + (size_t)(cstart + s) * DC + ch);
            v0 = (bflo(gvw.x) - m) * rs * g4.x + b4.x; v1 = (bfhi(gvw.x) - m) * rs * g4.y + b4.y; v2 = (bflo(gvw.y) - m) * rs * g4.z + b4.z; v3 = (bfhi(gvw.y) - m) * rs * g4.w + b4.w;
            a0 += w * v0; a1 += w * v1; a2 += w * v2; a3 += w * v3;
        }
        const float bias = bs[h * 128 + t];
        const u32x2 ugw = *(const u32x2*)(UG + (size_t)r * DC + ch);
        u32x2 o; o.x = pk2(bflo(ugw.x) * (a0 + bias), bfhi(ugw.x) * (a1 + bias)); o.y = pk2(bflo(ugw.y) * (a2 + bias), bfhi(ugw.y) * (a3 + bias));
        *(u32x2*)(UG + (size_t)r * DC + ch) = o;
        if (r < TP) { const int tt = (r & 2047) - 1920; if (tt >= 0) *(f32x4*)(p.out + O_GP + ((size_t)(r >> 11) * 128 + tt) * DC + ch) = (f32x4){v0, v1, v2, v3}; }
        else *(f32x4*)(p.out + O_GS + (size_t)(r - TP) * DC + ch) = (f32x4){v0, v1, v2, v3};
    }
}


constexpr int GM_W = 0, GM_VT = 34816, GM_MR = 34816 + 69632, GM_PITCH = 272;
__device__ __forceinline__ void gmlp_fast(const Params& p, LAS unsigned char* lds, int vb, int G) {
    LAS float* smean = (LAS float*)(lds + GM_MR); LAS float* srstd = smean + 128;
    const f32x2* VST = (const f32x2*)(p.ws + WS_VST); const bf16_t* GV = (const bf16_t*)p.out; bf16_t* UG = (bf16_t*)(p.ws + WS_UG);
    const float *lg = p.in[15], *lb_ = p.in[16], *wsp = p.in[17], *bs = p.in[18];
    const int tid = opaque((int)threadIdx.x), lane = tid & 63, wid = __builtin_amdgcn_readfirstlane(tid >> 6);
    for (int sitem = vb; sitem < 256; sitem += G) {
        const int chunk = sitem >> 1, hh = (sitem & 1) * 4; const size_t cstart = (size_t)chunk * 128;
        const bool lastchunk = (chunk & 15) == 15; const int bseq = chunk >> 4;
        __syncthreads();
        if (tid < 128) { const size_t row = cstart + tid; float s = 0.f, q = 0.f;
            for (int j = 0; j < 32; ++j) { const f32x2 st = VST[row * 32 + j]; s += st.x; q += st.y; }
            const float mean = s * (1.f / 2048.f); const float var = q * (1.f / 2048.f) - mean * mean; smean[tid] = mean; srstd[tid] = rsqrtf(var + EPS); }
        for (int h = hh; h < hh + 4; ++h) {
            __syncthreads();
            for (int q = tid; q < 4096; q += NTHR) { const int t = q >> 5, s0 = (q & 31) * 4; const f32x4 w = *(const f32x4*)(wsp + (size_t)(h * 128 + t) * 128 + s0);
                u32x2 o; o.x = pk2(s0 <= t ? w.x : 0.f, s0 + 1 <= t ? w.y : 0.f); o.y = pk2(s0 + 2 <= t ? w.z : 0.f, s0 + 3 <= t ? w.w : 0.f);
                *(LAS u32x2*)(lds + GM_W + t * GM_PITCH + s0 * 2) = o; }
            for (int q = tid; q < 2048; q += NTHR) { const int cc = q & 255, sg = q >> 8; const int col = h * 256 + cc; const float gg = lg[col], bb = lb_[col];
                float vn[16];
#pragma unroll
                for (int j = 0; j < 16; ++j) { const int srow = sg * 16 + j; vn[j] = (bf2f(GV[(cstart + srow) * DC + col]) - smean[srow]) * srstd[srow] * gg + bb; }
                u32x4 o0, o1; o0.x = pk2(vn[0], vn[1]); o0.y = pk2(vn[2], vn[3]); o0.z = pk2(vn[4], vn[5]); o0.w = pk2(vn[6], vn[7]); o1.x = pk2(vn[8], vn[9]); o1.y = pk2(vn[10], vn[11]); o1.z = pk2(vn[12], vn[13]); o1.w = pk2(vn[14], vn[15]);
                *(LAS u32x4*)(lds + GM_VT + cc * GM_PITCH + sg * 32) = o0; *(LAS u32x4*)(lds + GM_VT + cc * GM_PITCH + sg * 32 + 16) = o1;
                if (lastchunk) {
#pragma unroll
                    for (int j = 0; j < 16; ++j) p.out[O_GP + ((size_t)bseq * 128 + sg * 16 + j) * DC + col] = vn[j]; }
            }
            __syncthreads();
            f32x16 acc[4];
#pragma unroll
            for (int mt = 0; mt < 4; ++mt)
#pragma unroll
                for (int r = 0; r < 16; ++r) acc[mt][r] = 0.f;
#pragma unroll
            for (int ks = 0; ks < 8; ++ks) { const bf16x8 b = ldfrag(lds + GM_VT, GM_PITCH, 32 * wid, 16 * ks, lane);
#pragma unroll
                for (int mt = 0; mt < 4; ++mt) if (ks < 2 * (mt + 1)) { const bf16x8 a = ldfrag(lds + GM_W, GM_PITCH, 32 * mt, 16 * ks, lane); acc[mt] = MFMA32(a, b, acc[mt]); } }
            const int col = h * 256 + 32 * wid + (lane & 31);
#pragma unroll
            for (int mt = 0; mt < 4; ++mt)
#pragma unroll
                for (int r = 0; r < 16; ++r) { const int t = 32 * mt + accrow(r, lane); bf16_t* u = UG + (cstart + t) * DC + col;
                    *u = (bf16_t)f2bf(bf2f(*u) * (acc[mt][r] + bs[h * 128 + t])); }
        }
    }
}

__device__ __forceinline__ void final_norm(const Params& p, int vb, int G) {
    const int tid = opaque((int)threadIdx.x), lane = tid & 63, wave = tid >> 6;
    const int gw = vb * NWAVES + wave, NGW = G * NWAVES;
    const float* SSP = (const float*)(p.ws + WS_SSP2); const float* g = p.in[20];
    for (int r = gw; r < T; r += NGW) {
        const f32x4* s = (const f32x4*)(SSP + (size_t)r * 16); const f32x4 a = s[0], b = s[1], c = s[2], d = s[3];
        const float tot = ((a.x + a.y) + (a.z + a.w)) + ((b.x + b.y) + (b.z + b.w)) + ((c.x + c.y) + (c.z + c.w)) + ((d.x + d.y) + (d.z + d.w));
        const float rs = rsqrtf(tot * (1.f / 1024.f) + EPS);
        f32x4* y = (f32x4*)(p.out + (size_t)r * D) + lane;
#pragma unroll
        for (int j = 0; j < 4; ++j) { const f32x4 gg = ((const f32x4*)g)[lane + 64 * j]; f32x4 v = y[64 * j]; v.x *= rs * gg.x; v.y *= rs * gg.y; v.z *= rs * gg.z; v.w *= rs * gg.w; y[64 * j] = v; }
    }
}

__global__ void __launch_bounds__(NTHR, 2) fwd_kernel(Params p) {
    extern __shared__ __attribute__((aligned(16))) unsigned char lds_raw[];
    LAS unsigned char* lds = (LAS unsigned char*)lds_raw;
    cg::grid_group grid = cg::this_grid();
    const int G = gridDim.x, vb = blockIdx.x;
    bf16_t* WT1 = (bf16_t*)(p.ws + WS_WT1); bf16_t* WT2 = (bf16_t*)(p.ws + WS_WT2); bf16_t* WT3 = (bf16_t*)(p.ws + WS_WT3); bf16_t* WT4 = (bf16_t*)(p.ws + WS_WT4);
    bf16_t* ZR = (bf16_t*)(p.ws + WS_R1);

    phase0(p, lds, vb, G);
    grid.sync();
    { Epi1 E{ZR, (const float*)(p.ws + WS_LB)}; GEMM(lds, (const bf16_t*)p.out, WT1, T, N1, D, E, vb, G); }
    grid.sync();
    hgrn_phaseA(p, lds, vb, G);
    hgrn_simple(p, lds, vb, G, 64, 64 + 1024);
    conv_fast(p, lds, vb, G);
    grid.sync();
    hgrn_phaseB(p, lds, vb, G);
    grid.sync();
    { Epi2 E{p.in[0], p.in[1], (float*)(p.ws + WS_X1), (bf16_t*)(p.ws + WS_X1B), (float*)(p.ws + WS_SSP1)}; GEMM(lds, (const bf16_t*)p.out, WT2, T, D, 2048, E, vb, G); }
    grid.sync();
    { Epi3 E{(const float*)(p.ws + WS_SSP1), (bf16_t*)(p.ws + WS_UG), (bf16_t*)p.out, (f32x2*)(p.ws + WS_VST)}; GEMM(lds, (const bf16_t*)(p.ws + WS_X1B), WT3, T, N3, D, E, vb, G); }
    grid.sync();
    gmlp_fast(p, lds, vb, G);
    gmlp_simple(p, lds, vb, G, TP);
    grid.sync();
    { Epi4 E{(const float*)(p.ws + WS_X1), p.out, (float*)(p.ws + WS_SSP2)}; GEMM(lds, (const bf16_t*)(p.ws + WS_UG), WT4, T, D, 2048, E, vb, G); }
    grid.sync();
    final_norm(p, vb, G);
}

extern "C" void kernel_launch(void* const* d_in, const int* in_sizes, int n_in, void* d_out, int out_size, void* d_ws, size_t ws_size, hipStream_t stream) {
    static int grid = 0;
    if (grid == 0) {
        if (n_in != 21 || (size_t)out_size != O_END || ws_size < WS_END) { fprintf(stderr, "kernel_launch: unexpected shapes: n_in %d out %d ws %zu\n", n_in, out_size, ws_size); grid = -1; return; }
        int dev = 0, cus = 0, per_cu = 0;
        if (hipGetDevice(&dev) != hipSuccess || hipDeviceGetAttribute(&cus, hipDeviceAttributeMultiprocessorCount, dev) != hipSuccess) { grid = -1; return; }
        if (hipFuncSetAttribute((const void*)fwd_kernel, hipFuncAttributeMaxDynamicSharedMemorySize, LDS_BYTES) != hipSuccess) { fprintf(stderr, "kernel_launch: hipFuncSetAttribute failed\n"); grid = -1; return; }
        if (hipOccupancyMaxActiveBlocksPerMultiprocessor(&per_cu, (const void*)fwd_kernel, NTHR, LDS_BYTES) != hipSuccess || per_cu < 1) { fprintf(stderr, "kernel_launch: occupancy query says %d\n", per_cu); grid = -1; return; }
        grid = cus;
    }
    if (grid < 0) return;
    Params p{};
    for (int i = 0; i < 21; ++i) p.in[i] = (const float*)d_in[i];
    p.out = (float*)d_out; p.ws = (unsigned char*)d_ws;
    void* args[] = {&p};
    hipError_t e = hipLaunchCooperativeKernel((const void*)fwd_kernel, dim3(grid), dim3(NTHR), args, LDS_BYTES, stream);
    if (e != hipSuccess) fprintf(stderr, "kernel_launch: cooperative launch failed: %s (grid %d)\n", hipGetErrorString(e), grid);
}
```

```cpp
#include <hip/hip_runtime.h>
#include <cstdio>
#include <cstdint>

#ifndef FAST_GEMM
#define FAST_GEMM 1
#endif

#define LAS __attribute__((address_space(3)))
typedef unsigned short bf16_t;
typedef short bf16x8 __attribute__((ext_vector_type(8)));
typedef float f32x4 __attribute__((ext_vector_type(4)));
typedef float f32x2 __attribute__((ext_vector_type(2)));
typedef unsigned u32x4 __attribute__((ext_vector_type(4)));
typedef unsigned u32x2 __attribute__((ext_vector_type(2)));

constexpr int D = 1024, TP = 16384, TS = 1024, T = TP + TS;
constexpr int N1 = 7168, N3 = 6144, DC = 2048;
constexpr float EPS = 1e-6f;
constexpr int NWAVES = 8, NTHR = 512;
constexpr int LDS_BYTES = 147456;
constexpr size_t MiB = (size_t)1 << 20;
constexpr size_t WS_LB = 65536;
constexpr size_t WS_WT1 = 1 * MiB, WS_WT2 = 15 * MiB, WS_WT3 = 19 * MiB, WS_WT4 = 31 * MiB;
constexpr size_t WS_R1 = 35 * MiB;
constexpr size_t WS_X1 = WS_R1, WS_X1B = WS_R1 + 68 * MiB, WS_UG = WS_R1 + 102 * MiB;
constexpr size_t WS_SSP1 = WS_R1 + 170 * MiB, WS_VST = WS_R1 + 172 * MiB, WS_SSP2 = WS_R1 + 178 * MiB;
constexpr size_t WS_SEG = 239 * MiB;
constexpr size_t WS_END = 255 * MiB;
constexpr size_t O_YP = 0, O_YS = 16777216, O_CP = 17825792, O_HP = 18071552, O_GP = 19120128, O_CS = 21217280, O_HS = 25149440, O_GS = 41926656, O_END = 44023808;

struct Params { const float* in[21]; float* out; unsigned char* ws; };

__device__ __forceinline__ int opaque(int x) { asm volatile("" : "+v"(x)); return x; }
__device__ __forceinline__ float bf2f(unsigned b) { return __uint_as_float(b << 16); }
__device__ __forceinline__ float bflo(unsigned w) { return __uint_as_float(w << 16); }
__device__ __forceinline__ float bfhi(unsigned w) { return __uint_as_float(w & 0xffff0000u); }
__device__ __forceinline__ unsigned f2bf(float f) { unsigned u = __float_as_uint(f); return (u + 0x7fffu + ((u >> 16) & 1u)) >> 16; }
__device__ __forceinline__ unsigned pk2(float lo, float hi) { return f2bf(lo) | (f2bf(hi) << 16); }
__device__ __forceinline__ float sigm(float x) { return 1.0f / (1.0f + __expf(-x)); }
__device__ __forceinline__ float silu(float x) { return x * sigm(x); }
__device__ __forceinline__ float gelu_t(float x) { return x * sigm(1.5957691216057308f * (x + 0.044715f * x * x * x)); }
__device__ __forceinline__ float wave_sum(float v) {
#pragma unroll
    for (int o = 1; o < 64; o <<= 1) v += __shfl_xor(v, o);
    return v;
}
__device__ __forceinline__ void st8(bf16_t* p, const float (&v)[8]) {
    u32x4 w; w.x = pk2(v[0], v[1]); w.y = pk2(v[2], v[3]); w.z = pk2(v[4], v[5]); w.w = pk2(v[6], v[7]); *(u32x4*)p = w;
}
__device__ __forceinline__ float block_sum(float v, LAS float* red) {
    v = wave_sum(v);
    __syncthreads();
    if ((threadIdx.x & 63) == 0) red[threadIdx.x >> 6] = v;
    __syncthreads();
    float s = 0.f;
#pragma unroll
    for (int i = 0; i < 8; ++i) s += red[i];
    return s;
}


typedef __attribute__((address_space(1))) unsigned gu32;
#define XB_TMO      128
#define XB_XCNT(j)  (256  + 64 * (j))
#define XB_XSUB(j)  (1280 + 64 * (j))
#define XB_XGEN(j)  (2304 + 64 * (j))
#define XB_TOP      3328
#define XB_TOPGEN   3392
#define XCD_BAR_WORDS 3456
#define XB_SPIN_CAP (1u << 20)

__device__ __forceinline__ unsigned xb_ld(unsigned* p)              { return __hip_atomic_load(p, __ATOMIC_RELAXED, __HIP_MEMORY_SCOPE_AGENT); }
__device__ __forceinline__ unsigned xb_add(unsigned* p, unsigned v) { return __hip_atomic_fetch_add(p, v, __ATOMIC_RELAXED, __HIP_MEMORY_SCOPE_AGENT); }
__device__ __forceinline__ unsigned xb_xcc_id() { return (unsigned)__builtin_amdgcn_s_getreg((3 << 11) | 20) & 0xFu; }
#define XB_SPIN(cond, bar) do { unsigned _sp = 0; while (cond) { __builtin_amdgcn_s_sleep(1); \
    if ((++_sp & 255u) == 0u) { if (xb_ld(&(bar)[XB_TMO])) break; if (_sp > XB_SPIN_CAP) { atomicAdd(&(bar)[XB_TMO], 1u); break; } } } } while (0)

struct XcdBarrier {
    unsigned* bar; unsigned x;
    volatile LAS unsigned* st;
};

__device__ __forceinline__ XcdBarrier xcd_barrier_post(unsigned* bar, volatile LAS unsigned* st) {
    XcdBarrier b; b.bar = bar; b.x = xb_xcc_id(); b.st = st;
    if (threadIdx.x == 0) (void)xb_add(&bar[XB_XCNT(b.x)], 1u);
    return b;
}
__device__ __forceinline__ void xcd_barrier_complete(unsigned* bar, unsigned x, unsigned& nloc, unsigned& nx) {
    const unsigned G = gridDim.x * gridDim.y * gridDim.z;
    unsigned sum, cnt, mine, sp = 0u;
    for (;;) {
        sum = 0u; cnt = 0u; mine = 0u;
#pragma unroll
        for (unsigned j = 0; j < 16; ++j) { const unsigned c = xb_ld(&bar[XB_XCNT(j)]); sum += c; cnt += (c > 0u) ? 1u : 0u; mine = (j == x) ? c : mine; }
        if (sum == G) break;
        __builtin_amdgcn_s_sleep(1);
        if ((++sp & 255u) == 0u) { if (xb_ld(&bar[XB_TMO])) break; if (sp > XB_SPIN_CAP) { atomicAdd(&bar[XB_TMO], 1u); break; } }
    }
    nloc = mine > 0u ? mine : 1u; nx = cnt > 0u ? cnt : 1u;
}

__device__ __forceinline__ void xcd_barrier(const XcdBarrier& b) {
    asm volatile("s_waitcnt vmcnt(0)" ::: "memory");
    __syncthreads();
    if (threadIdx.x == 0) {
        unsigned* bar = b.bar;
        __builtin_amdgcn_s_waitcnt(0);
        unsigned nloc = b.st[0], nx = b.st[1];
        if (nloc == 0u) { xcd_barrier_complete(bar, b.x, nloc, nx); b.st[0] = nloc; b.st[1] = nx; }
        const unsigned old = xb_add(&bar[XB_XSUB(b.x)], 1u);
        const unsigned gen = old / nloc;
        if (old + 1u == (gen + 1u) * nloc) {
            __builtin_amdgcn_fence(__ATOMIC_RELEASE, "agent");
            asm volatile("s_waitcnt vmcnt(0)" ::: "memory");
            const unsigned og = xb_add(&bar[XB_TOP], 1u);
            const unsigned tg = og / nx;
            if (og + 1u == (tg + 1u) * nx) xb_add(&bar[XB_TOPGEN], 1u);
            else XB_SPIN(xb_ld(&bar[XB_TOPGEN]) == tg, bar);
            __builtin_amdgcn_fence(__ATOMIC_ACQUIRE, "agent");
            xb_add(&bar[XB_XGEN(b.x)], 1u);
            asm volatile("s_waitcnt vmcnt(0)" ::: "memory");
        } else {
            XB_SPIN(xb_ld(&bar[XB_XGEN(b.x)]) == gen, bar);
            __builtin_amdgcn_fence(__ATOMIC_ACQUIRE, "agent");
            asm volatile("s_waitcnt vmcnt(0)" ::: "memory");
        }
    }
    __syncthreads();
}

template <int MAP> __device__ __forceinline__ int vmap(int vc) {
    const int vt = vc >> 8, c = vc & 255;
    if (MAP == 1) return vt < 8 ? (c < 128 ? 128 * vt + c : 1024 + 128 * vt + (c - 128)) : vc;
    if (MAP == 3) return vt < 16 ? (c < 128 ? 128 * vt + c : 4096 + 128 * vt + (c - 128)) : vc - 2048;
    return vc;
}

template <int MAP> __device__ __forceinline__ void transpose_item(const float* W, int K, int N, bf16_t* WT, const float* kscale, LAS float* scr, int item, int lane) {
    const int nblk = N / 32, kb = item / nblk, nb = item % nblk, k0 = 64 * kb, n0 = 32 * nb;
    const int on0 = vmap<MAP>(n0);
#pragma unroll 8
    for (int i = 0; i < 32; ++i) { const int kk = 2 * i + (lane >> 5); float w = W[(size_t)(k0 + kk) * N + on0 + (lane & 31)]; if (kscale) w *= kscale[k0 + kk]; scr[kk * 33 + (lane & 31)] = w; }
    asm volatile("s_waitcnt lgkmcnt(0)" ::: "memory");
    const int c = lane & 7;
#pragma unroll
    for (int j = 0; j < 4; ++j) { const int n = (lane >> 3) + 8 * j; const LAS float* s = scr + (8 * c) * 33 + n;
        u32x4 o; o.x = pk2(s[0 * 33], s[1 * 33]); o.y = pk2(s[2 * 33], s[3 * 33]); o.z = pk2(s[4 * 33], s[5 * 33]); o.w = pk2(s[6 * 33], s[7 * 33]);
        *(u32x4*)(WT + (size_t)(n0 + n) * K + k0 + 8 * c) = o; }
    asm volatile("s_waitcnt lgkmcnt(0)" ::: "memory");
}
__device__ __forceinline__ void rms_row_to_bf16(const float* xrow, const float* g, bf16_t* orow, int lane) {
    const f32x4* xr = (const f32x4*)xrow + lane; f32x4 v[4]; float s = 0.f;
#pragma unroll
    for (int j = 0; j < 4; ++j) { v[j] = xr[64 * j]; s += (v[j].x * v[j].x + v[j].y * v[j].y) + (v[j].z * v[j].z + v[j].w * v[j].w); }
    const float rs = rsqrtf(wave_sum(s) * (1.f / 1024.f) + EPS);
    u32x2* o8 = (u32x2*)orow + lane;
#pragma unroll
    for (int j = 0; j < 4; ++j) { const f32x4 gg = ((const f32x4*)g)[lane + 64 * j]; u32x2 w; w.x = pk2(v[j].x * rs * gg.x, v[j].y * rs * gg.y); w.y = pk2(v[j].z * rs * gg.z, v[j].w * rs * gg.w); o8[64 * j] = w; }
}
__device__ __forceinline__ void phase0(const Params& p, LAS unsigned char* lds, int vb, int G) {
    const int tid = opaque((int)threadIdx.x), lane = tid & 63, wave = tid >> 6;
    const int gw = vb * NWAVES + wave, NGW = G * NWAVES;
    float* LB = (float*)(p.ws + WS_LB);
    for (int i = vb * NTHR + tid; i < 1024; i += G * NTHR) { const float l0 = p.in[10][i], l1 = p.in[10][1024 + i]; LB[i] = 1.0f / (1.0f + __expf(l1 - l0)); }
    LAS float* scr = (LAS float*)(lds + wave * 16384);
    constexpr int I1 = (D / 64) * (N1 / 32), I2 = (2048 / 64) * (D / 32), I3 = (D / 64) * (N3 / 32), I4 = I2;
    for (int it = gw; it < I1 + I2 + I3 + I4; it += NGW) {
        int r = it;
        if (r < I1) { transpose_item<1>(p.in[5], D, N1, (bf16_t*)(p.ws + WS_WT1), nullptr, scr, r, lane); continue; } r -= I1;
        if (r < I2) { transpose_item<0>(p.in[12], 2048, D, (bf16_t*)(p.ws + WS_WT2), nullptr, scr, r, lane); continue; } r -= I2;
        if (r < I3) { transpose_item<3>(p.in[14], D, N3, (bf16_t*)(p.ws + WS_WT3), p.in[13], scr, r, lane); continue; } r -= I3;
        transpose_item<0>(p.in[19], 2048, D, (bf16_t*)(p.ws + WS_WT4), nullptr, scr, r, lane);
    }
    bf16_t* XN0 = (bf16_t*)p.out;
    for (int r = gw; r < T; r += NGW) { const float* xr = r < TP ? p.in[0] + (size_t)r * D : p.in[1] + (size_t)(r - TP) * D; rms_row_to_bf16(xr, p.in[4], XN0 + (size_t)r * D, lane); }
}

struct Epi1 {
    bf16_t* Z; const float* LB;
    __device__ __forceinline__ float rowscale(int) const { return 1.f; }
    template <int X1M, int X2M> __device__ __forceinline__ void tile8(int row, int pn, int c0, const float (&lo)[8], const float (&hi)[8], float) const {
        if (pn < 8) { float a[8];
#pragma unroll
            for (int i = 0; i < 8; ++i) a[i] = lo[i] * sigm(hi[i]);
            st8(Z + (size_t)row * 1024 + 128 * pn + c0, a);
        } else {
            const int g = (pn - 8) >> 2, col = ((pn - 8) & 3) * 256 + c0;
            bf16_t* base = Z + (size_t)(g + 1) * T * 1024 + (size_t)row * 1024 + col;
            float x[8], y[8];
            if (g == 1) {
#pragma unroll
                for (int i = 0; i < 8; ++i) { x[i] = lo[i]; y[i] = hi[i]; }
            } else if (g == 2) {
#pragma unroll
                for (int i = 0; i < 8; ++i) { const float l0 = LB[col + i], l1 = LB[col + 128 + i]; x[i] = __logf(l0 + (1.f - l0) * sigm(lo[i])); y[i] = __logf(l1 + (1.f - l1) * sigm(hi[i])); }
            } else {
#pragma unroll
                for (int i = 0; i < 8; ++i) { x[i] = silu(lo[i]); y[i] = silu(hi[i]); }
            }
            st8(base, x); st8(base + 128, y);
        }
    }
};
struct Epi2 {
    const float* xp; const float* xs; float* X1; bf16_t* X1B; float* SSP;
    __device__ __forceinline__ float rowscale(int) const { return 1.f; }
    template <int X1M, int X2M> __device__ __forceinline__ void tile8(int row, int pn, int c0, const float (&lo)[8], const float (&hi)[8], float) const {
        const int col = 256 * pn + c0;
        const float* xr = (row < TP ? xp + (size_t)row * D : xs + (size_t)(row - TP) * D) + col;
        const f32x4 a0 = *(const f32x4*)xr, a1 = *(const f32x4*)(xr + 4), b0 = *(const f32x4*)(xr + 128), b1 = *(const f32x4*)(xr + 132);
        float v[8], w[8];
        v[0] = a0.x + lo[0]; v[1] = a0.y + lo[1]; v[2] = a0.z + lo[2]; v[3] = a0.w + lo[3]; v[4] = a1.x + lo[4]; v[5] = a1.y + lo[5]; v[6] = a1.z + lo[6]; v[7] = a1.w + lo[7];
        w[0] = b0.x + hi[0]; w[1] = b0.y + hi[1]; w[2] = b0.z + hi[2]; w[3] = b0.w + hi[3]; w[4] = b1.x + hi[4]; w[5] = b1.y + hi[5]; w[6] = b1.z + hi[6]; w[7] = b1.w + hi[7];
        float* o = X1 + (size_t)row * D + col;
        *(f32x4*)o = (f32x4){v[0], v[1], v[2], v[3]}; *(f32x4*)(o + 4) = (f32x4){v[4], v[5], v[6], v[7]};
        *(f32x4*)(o + 128) = (f32x4){w[0], w[1], w[2], w[3]}; *(f32x4*)(o + 132) = (f32x4){w[4], w[5], w[6], w[7]};
        bf16_t* ob = X1B + (size_t)row * D + col; st8(ob, v); st8(ob + 128, w);
        float ss = 0.f;
#pragma unroll
        for (int i = 0; i < 8; ++i) ss += v[i] * v[i] + w[i] * w[i];
        ss += __shfl_xor(ss, X1M); ss += __shfl_xor(ss, X2M);
        if ((c0 & 31) == 0) SSP[(size_t)row * 16 + pn * 4 + (c0 >> 5)] = ss;
    }
};
struct Epi3 {
    const float* SSP1; bf16_t* UG; bf16_t* GV; f32x2* VST;
    __device__ __forceinline__ float rowscale(int row) const {
        const f32x4* s = (const f32x4*)(SSP1 + (size_t)row * 16); const f32x4 a = s[0], b = s[1], c = s[2], d = s[3];
        const float t = ((a.x + a.y) + (a.z + a.w)) + ((b.x + b.y) + (b.z + b.w)) + ((c.x + c.y) + (c.z + c.w)) + ((d.x + d.y) + (d.z + d.w));
        return rsqrtf(t * (1.f / 1024.f) + EPS);
    }
    template <int X1M, int X2M> __device__ __forceinline__ void tile8(int row, int pn, int c0, const float (&lo)[8], const float (&hi)[8], float rs) const {
        if (pn < 16) { float a[8];
#pragma unroll
            for (int i = 0; i < 8; ++i) a[i] = gelu_t(lo[i] * rs) * silu(hi[i] * rs);
            st8(UG + (size_t)row * DC + 128 * pn + c0, a);
        } else {
            const int col = 256 * (pn - 16) + c0; float x[8], y[8], s = 0.f, q = 0.f;
#pragma unroll
            for (int i = 0; i < 8; ++i) { x[i] = gelu_t(lo[i] * rs); y[i] = gelu_t(hi[i] * rs); s += x[i] + y[i]; q += x[i] * x[i] + y[i] * y[i]; }
            bf16_t* o = GV + (size_t)row * DC + col; st8(o, x); st8(o + 128, y);
            s += __shfl_xor(s, X1M); q += __shfl_xor(q, X1M); s += __shfl_xor(s, X2M); q += __shfl_xor(q, X2M);
            if ((c0 & 31) == 0) VST[(size_t)row * 32 + (pn - 16) * 4 + (c0 >> 5)] = (f32x2){s, q};
        }
    }
};
struct Epi4 {
    const float* X1; float* Y; float* SSP;
    __device__ __forceinline__ float rowscale(int) const { return 1.f; }
    template <int X1M, int X2M> __device__ __forceinline__ void tile8(int row, int pn, int c0, const float (&lo)[8], const float (&hi)[8], float) const {
        const int col = 256 * pn + c0;
        const float* xr = X1 + (size_t)row * D + col;
        const f32x4 a0 = *(const f32x4*)xr, a1 = *(const f32x4*)(xr + 4), b0 = *(const f32x4*)(xr + 128), b1 = *(const f32x4*)(xr + 132);
        float v[8], w[8];
        v[0] = a0.x + lo[0]; v[1] = a0.y + lo[1]; v[2] = a0.z + lo[2]; v[3] = a0.w + lo[3]; v[4] = a1.x + lo[4]; v[5] = a1.y + lo[5]; v[6] = a1.z + lo[6]; v[7] = a1.w + lo[7];
        w[0] = b0.x + hi[0]; w[1] = b0.y + hi[1]; w[2] = b0.z + hi[2]; w[3] = b0.w + hi[3]; w[4] = b1.x + hi[4]; w[5] = b1.y + hi[5]; w[6] = b1.z + hi[6]; w[7] = b1.w + hi[7];
        float* o = Y + (size_t)row * D + col;
        *(f32x4*)o = (f32x4){v[0], v[1], v[2], v[3]}; *(f32x4*)(o + 4) = (f32x4){v[4], v[5], v[6], v[7]};
        *(f32x4*)(o + 128) = (f32x4){w[0], w[1], w[2], w[3]}; *(f32x4*)(o + 132) = (f32x4){w[4], w[5], w[6], w[7]};
        float ss = 0.f;
#pragma unroll
        for (int i = 0; i < 8; ++i) ss += v[i] * v[i] + w[i] * w[i];
        ss += __shfl_xor(ss, X1M); ss += __shfl_xor(ss, X2M);
        if ((c0 & 31) == 0) SSP[(size_t)row * 16 + pn * 4 + (c0 >> 5)] = ss;
    }
};

template <class Epi> __device__ __forceinline__ void gemm_simple(LAS unsigned char* lds, const bf16_t* A, const bf16_t* Bt, int M, int N, int K, const Epi& E, int vb, int G) {
    LAS bf16_t* sA = (LAS bf16_t*)lds;
    LAS bf16_t* sB = (LAS bf16_t*)(lds + 4096);
    const int tid = opaque((int)threadIdx.x), r = tid >> 4, c0 = (tid & 15) * 8;
    const int nN = N / 256, nunits = (M / 32) * nN;
    for (int u = vb; u < nunits; u += G) {
        const int ms = u / nN, pn = u % nN, row0 = ms * 32, col0 = pn * 256;
        float lo[8], hi[8];
#pragma unroll
        for (int i = 0; i < 8; ++i) { lo[i] = 0.f; hi[i] = 0.f; }
        for (int k0 = 0; k0 < K; k0 += 32) {
            __syncthreads();
            if (tid < 128) { const int rr = tid >> 2, kc = (tid & 3) * 8; *(LAS u32x4*)(sA + rr * 40 + kc) = *(const u32x4*)(A + (size_t)(row0 + rr) * K + k0 + kc); }
            for (int q = tid; q < 1024; q += NTHR) { const int rr = q >> 2, kc = (q & 3) * 8; *(LAS u32x4*)(sB + rr * 40 + kc) = *(const u32x4*)(Bt + (size_t)(col0 + rr) * K + k0 + kc); }
            __syncthreads();
#pragma unroll 1
            for (int kc = 0; kc < 32; kc += 8) {
                const u32x4 av = *(const LAS u32x4*)(sA + r * 40 + kc);
                const float a0 = bflo(av.x), a1 = bfhi(av.x), a2 = bflo(av.y), a3 = bfhi(av.y), a4 = bflo(av.z), a5 = bfhi(av.z), a6 = bflo(av.w), a7 = bfhi(av.w);
#pragma unroll
                for (int i = 0; i < 8; ++i) {
                    const u32x4 b = *(const LAS u32x4*)(sB + (c0 + i) * 40 + kc);
                    lo[i] += a0 * bflo(b.x) + a1 * bfhi(b.x) + a2 * bflo(b.y) + a3 * bfhi(b.y) + a4 * bflo(b.z) + a5 * bfhi(b.z) + a6 * bflo(b.w) + a7 * bfhi(b.w);
                    const u32x4 c = *(const LAS u32x4*)(sB + (128 + c0 + i) * 40 + kc);
                    hi[i] += a0 * bflo(c.x) + a1 * bfhi(c.x) + a2 * bflo(c.y) + a3 * bfhi(c.y) + a4 * bflo(c.z) + a5 * bfhi(c.z) + a6 * bflo(c.w) + a7 * bfhi(c.w);
                }
            }
        }
        const int row = row0 + r; const float rsc = E.rowscale(row);
        E.template tile8<1, 2>(row, pn, c0, lo, hi, rsc);
    }
}

namespace pg8 {
#define PG8_LAS __attribute__((address_space(3)))
constexpr int BM = 256, BK = 64, HALF = 128, HTB = HALF * BK * 2  , STAGE_BYTES = 8 * HTB, NXCD = 8, WGM = 8;

__host__ __device__ __forceinline__ int lds_byte(int r, int c) { const int st = (r >> 4) * 2 + (c >> 5), rr = r & 15, cc = c & 31, ob = rr * 64 + cc * 2; return st * 1024 + (ob ^ (((ob >> 9) & 1) << 5)); }
__host__ __device__ __forceinline__ void stage_rc(int b, int& R, int& C) { const int st = b / 1024, sb = b % 1024, swz = sb ^ (((sb >> 9) & 1) << 5); R = (st >> 1) * 16 + swz / 64; C = (st & 1) * 32 + (swz % 64) / 2; }
__host__ __device__ __forceinline__ int perm32(int rho) { const int n = rho >> 4, i = rho & 15; return 8 * (i >> 2) + 4 * n + (i & 3); }

struct Unit { int pm, pn; };
struct Gemm { const bf16_t* A; const bf16_t* Bt; int M, N, K; };

struct StaticOrder {
    int nM, nN, nwg, G, c;
    __host__ __device__ void init(int M, int N, int G_, int c_) { nM = M / BM; nN = N / BM; nwg = nM * nN; G = G_; c = c_; }
    __host__ __device__ bool next(int i, Unit& u) const {
        const long L = (long)i * G + c; if (L >= nwg) return false;
        int wgid = (int)L; { const int q = nwg / NXCD, r = nwg % NXCD, xcd = wgid % NXCD, off = wgid / NXCD; wgid = (xcd < r ? xcd * (q + 1) : r * (q + 1) + (xcd - r) * q) + off; }
        const int nig = WGM * nN, gid = wgid / nig, fm = gid * WGM, gsz = (nM - fm) < WGM ? (nM - fm) : WGM;
        u.pm = fm + ((wgid % nig) % gsz); u.pn = (wgid % nig) / gsz; return true;
    }
    __device__ __forceinline__ void a_ready(const Unit&) const {}
    __device__ __forceinline__ void done(const Unit&) const {}
};
template <class Epi, class Sched, bool ALIGN_EPI = false, bool SP2 = false>
__device__ __forceinline__ void gemm_phase(PG8_LAS unsigned char* lds, const Gemm g, const Sched& S, const Epi& E) {
    const int tid = opaque((int)threadIdx.x), wid = __builtin_amdgcn_readfirstlane(tid >> 6), lane = tid & 63, wr = wid >> 2, wc = wid & 3, fr = lane & 15, fq = lane >> 4;
    const int K = g.K, nt = K / BK;
    unsigned voffA[2], voffB[2];
#pragma unroll
    for (int i = 0; i < 2; ++i) { int R, C; stage_rc(tid * 16 + i * 8192, R, C); const int Rb = Epi::PERM ? ((R & ~31) + perm32(R & 31)) : R;
        voffA[i] = (unsigned)(R * K + C) * 2u; voffB[i] = (unsigned)(Rb * K + C) * 2u; }
    const size_t kstep = (size_t)(BK * 2);
    const size_t hstep = (size_t)HALF * K * 2;
    const size_t tstep = 2 * hstep;
    const unsigned ldsw = (unsigned)wid * 1024u;
    const int aoff = lds_byte(wr * 64 + fr, fq * 8), boff = lds_byte(wc * 32 + fr, fq * 8);
#define PG8_SA(b, h) (((b) * 2 + (h)) * HTB)
#define PG8_SB(b, h) ((4 + (b) * 2 + (h)) * HTB)
#define PG8_STAGE(bufoff, gbase, voff) do { _Pragma("unroll") for (int _i = 0; _i < 2; ++_i) \
        __builtin_amdgcn_global_load_lds((const unsigned*)((const char*)(gbase) + (voff)[_i]), (PG8_LAS unsigned*)(lds + (bufoff) + ldsw + _i * 8192), 16, 0, 0); } while (0)
#define PG8_LDA(dst, b, h) do { _Pragma("unroll") for (int m = 0; m < 4; ++m) _Pragma("unroll") for (int k = 0; k < 2; ++k) dst[m][k] = *(const PG8_LAS bf16x8*)(lds + PG8_SA(b, h) + aoff + m * 2048 + k * 1024); } while (0)
#define PG8_LDB(dst, b, h) do { _Pragma("unroll") for (int n = 0; n < 2; ++n) _Pragma("unroll") for (int k = 0; k < 2; ++k) dst[n][k] = *(const PG8_LAS bf16x8*)(lds + PG8_SB(b, h) + boff + n * 2048 + k * 1024); } while (0)
#define PG8_MMA(ai, bj, At, Bt) do { __builtin_amdgcn_s_setprio(1); _Pragma("unroll") for (int m = 0; m < 4; ++m) _Pragma("unroll") for (int n = 0; n < 2; ++n) _Pragma("unroll") for (int k = 0; k < 2; ++k) \
        acc[ai][bj][m][n] = __builtin_amdgcn_mfma_f32_16x16x32_bf16(Bt[n][k], At[m][k], acc[ai][bj][m][n], 0, 0, 0); __builtin_amdgcn_s_setprio(0); } while (0)
#define PG8_WAIT_V(n) asm volatile("s_waitcnt vmcnt(" #n ")" ::: "memory")
#define PG8_WAIT_L(n) asm volatile("s_waitcnt lgkmcnt(" #n ")" ::: "memory")
#define PG8_BAR __builtin_amdgcn_s_barrier()
#define PG8_SCHED __builtin_amdgcn_sched_barrier(0)
    Unit cur, nxt; int ui = 0;
    if (!S.next(0, cur)) return;
    f32x4 acc[2][2][4][2];
#pragma unroll
    for (int a = 0; a < 2; ++a)
#pragma unroll
        for (int b = 0; b < 2; ++b)
#pragma unroll
            for (int m = 0; m < 4; ++m)
#pragma unroll
                for (int n = 0; n < 2; ++n) acc[a][b][m][n] = (f32x4){0.f, 0.f, 0.f, 0.f};
    bf16x8 At[4][2], B0[2][2], B1[2][2];
    const char* cA = (const char*)g.A + (size_t)cur.pm * tstep; const char* cB = (const char*)g.Bt + (size_t)cur.pn * tstep;
    S.a_ready(cur);
    if constexpr (SP2) {
        PG8_STAGE(PG8_SB(0, 0), cB, voffB); PG8_STAGE(PG8_SB(0, 1), cB + hstep, voffB); PG8_STAGE(PG8_SA(0, 0), cA, voffA); PG8_STAGE(PG8_SA(0, 1), cA + hstep, voffA);
        if (wr == 1) PG8_BAR;
        PG8_WAIT_V(2); PG8_BAR;
        PG8_STAGE(PG8_SB(1, 0), cB + kstep, voffB); PG8_STAGE(PG8_SA(1, 0), cA + kstep, voffA); PG8_STAGE(PG8_SB(1, 1), cB + hstep + kstep, voffB);
        PG8_WAIT_V(6); PG8_BAR;
    } else {
        PG8_STAGE(PG8_SB(0, 0), cB, voffB); PG8_STAGE(PG8_SA(0, 0), cA, voffA); PG8_STAGE(PG8_SB(0, 1), cB + hstep, voffB); PG8_STAGE(PG8_SA(0, 1), cA + hstep, voffA);
        if (wr == 1) PG8_BAR;
        PG8_WAIT_V(4); PG8_BAR;
        PG8_STAGE(PG8_SB(1, 0), cB + kstep, voffB); PG8_STAGE(PG8_SA(1, 0), cA + kstep, voffA); PG8_STAGE(PG8_SB(1, 1), cB + hstep + kstep, voffB);
        PG8_WAIT_V(6); PG8_BAR;
    }
    for (;;) {
        const bool has_next = S.next(ui + 1, nxt);
        const char* nA = has_next ? (const char*)g.A + (size_t)nxt.pm * tstep : cA; const char* nB = has_next ? (const char*)g.Bt + (size_t)nxt.pn * tstep : cB;
        for (int t = 0; t < nt; t += 2) {
            const bool last = (t == nt - 2);
            const char* a1 = cA + (size_t)(t + 1) * kstep;
            const char* a2 = last ? nA : cA + (size_t)(t + 2) * kstep; const char* b2 = last ? nB : cB + (size_t)(t + 2) * kstep;
            const char* a3 = a2 + kstep; const char* b3 = b2 + kstep;
            if (last && has_next) S.a_ready(nxt);
            if constexpr (SP2) {
            PG8_LDB(B0, 0, 0); PG8_LDB(B1, 0, 1); PG8_SCHED; PG8_LDA(At, 0, 0); PG8_STAGE(PG8_SA(1, 1), a1 + hstep, voffA);
            PG8_WAIT_V(8); PG8_WAIT_L(0); PG8_BAR; PG8_MMA(0, 0, At, B0); PG8_MMA(0, 1, At, B1); PG8_BAR; PG8_SCHED;
            PG8_LDA(At, 0, 1); PG8_STAGE(PG8_SB(0, 0), b2, voffB); PG8_STAGE(PG8_SB(0, 1), b2 + hstep, voffB); PG8_STAGE(PG8_SA(0, 0), a2, voffA);
            PG8_WAIT_V(8); PG8_WAIT_L(0); PG8_BAR; PG8_MMA(1, 0, At, B0); PG8_MMA(1, 1, At, B1); PG8_BAR; PG8_SCHED;
            PG8_LDB(B0, 1, 0); PG8_LDB(B1, 1, 1); PG8_SCHED; PG8_LDA(At, 1, 0); PG8_STAGE(PG8_SA(0, 1), a2 + hstep, voffA);
            PG8_WAIT_V(8); PG8_WAIT_L(0); PG8_BAR; PG8_MMA(0, 0, At, B0); PG8_MMA(0, 1, At, B1); PG8_BAR; PG8_SCHED;
            PG8_LDA(At, 1, 1); PG8_STAGE(PG8_SB(1, 0), b3, voffB); PG8_STAGE(PG8_SB(1, 1), b3 + hstep, voffB); PG8_STAGE(PG8_SA(1, 0), a3, voffA);
            PG8_WAIT_V(8); PG8_WAIT_L(0); PG8_BAR; PG8_MMA(1, 0, At, B0); PG8_MMA(1, 1, At, B1); PG8_BAR; PG8_SCHED;
            } else {
            PG8_LDB(B0, 0, 0); PG8_SCHED; PG8_LDA(At, 0, 0); PG8_STAGE(PG8_SA(1, 1), a1 + hstep, voffA);
            PG8_WAIT_L(8); PG8_BAR; PG8_WAIT_L(0); PG8_MMA(0, 0, At, B0); PG8_BAR; PG8_SCHED;
            PG8_LDB(B1, 0, 1); PG8_STAGE(PG8_SB(0, 0), b2, voffB);
            PG8_BAR; PG8_WAIT_L(0); PG8_MMA(0, 1, At, B1); PG8_BAR;
            PG8_LDA(At, 0, 1); PG8_STAGE(PG8_SA(0, 0), a2, voffA);
            PG8_BAR; PG8_WAIT_L(0); PG8_MMA(1, 0, At, B0); PG8_BAR; PG8_SCHED;
            PG8_STAGE(PG8_SB(0, 1), b2 + hstep, voffB);
            PG8_WAIT_V(6); PG8_BAR; PG8_MMA(1, 1, At, B1); PG8_BAR;
            PG8_LDB(B0, 1, 0); PG8_SCHED; PG8_LDA(At, 1, 0); PG8_STAGE(PG8_SA(0, 1), a2 + hstep, voffA);
            PG8_WAIT_L(8); PG8_BAR; PG8_WAIT_L(0); PG8_MMA(0, 0, At, B0); PG8_BAR; PG8_SCHED;
            PG8_LDB(B1, 1, 1); PG8_STAGE(PG8_SB(1, 0), b3, voffB);
            PG8_BAR; PG8_WAIT_L(0); PG8_MMA(0, 1, At, B1); PG8_BAR;
            PG8_LDA(At, 1, 1); PG8_STAGE(PG8_SA(1, 0), a3, voffA);
            PG8_BAR; PG8_WAIT_L(0); PG8_MMA(1, 0, At, B0); PG8_BAR; PG8_SCHED;
            PG8_STAGE(PG8_SB(1, 1), b3 + hstep, voffB);
            PG8_WAIT_V(6); PG8_BAR; PG8_MMA(1, 1, At, B1); PG8_BAR;
            }
        }
        if constexpr (ALIGN_EPI) { if (wr == 0) PG8_BAR; }
        if constexpr (!Epi::AFTER_DRAIN) { E(acc, cur, wr, wc, fr, fq); S.done(cur); }
        if (!has_next) break;
#pragma unroll
        for (int a = 0; a < 2; ++a)
#pragma unroll
            for (int b = 0; b < 2; ++b)
#pragma unroll
                for (int m = 0; m < 4; ++m)
#pragma unroll
                    for (int n = 0; n < 2; ++n) acc[a][b][m][n] = (f32x4){0.f, 0.f, 0.f, 0.f};
        cur = nxt; cA = nA; cB = nB; ++ui;
        if constexpr (ALIGN_EPI) { if (wr == 1) PG8_BAR; }
    }
    PG8_WAIT_V(0);
    if constexpr (!ALIGN_EPI) { if (wr == 0) PG8_BAR; }
    PG8_BAR;
    if constexpr (Epi::AFTER_DRAIN) { E.fused(acc, cur, wr, wc, fr, fq, lds, wid, lane); S.done(cur); }
#undef PG8_SA
#undef PG8_SB
#undef PG8_STAGE
#undef PG8_LDA
#undef PG8_LDB
#undef PG8_MMA
#undef PG8_WAIT_V
#undef PG8_WAIT_L
#undef PG8_BAR
#undef PG8_SCHED
}
}

template <class E> struct EpiAd {
    static constexpr bool PERM = true, AFTER_DRAIN = false; E e;
    __device__ __forceinline__ void operator()(const f32x4 (&acc)[2][2][4][2], const pg8::Unit& u, int wr, int wc, int fr, int fq) const {
#pragma unroll
        for (int ai = 0; ai < 2; ++ai)
#pragma unroll
            for (int m = 0; m < 4; ++m) {
                const int row = u.pm * 256 + ai * 128 + wr * 64 + m * 16 + fr;
                const float rsc = e.rowscale(row);
                float lo[8], hi[8];
#pragma unroll
                for (int j = 0; j < 4; ++j) { lo[j] = acc[ai][0][m][0][j]; lo[4 + j] = acc[ai][0][m][1][j]; hi[j] = acc[ai][1][m][0][j]; hi[4 + j] = acc[ai][1][m][1][j]; }
                e.template tile8<16, 32>(row, u.pn, wc * 32 + 8 * fq, lo, hi, rsc);
            }
    }
};
template <class E> __device__ __forceinline__ void gemm_fast(LAS unsigned char* lds, const bf16_t* A, const bf16_t* Bt, int M, int N, int K, const E& e, int vb, int G) {
    pg8::Gemm g{A, Bt, M, N, K}; pg8::StaticOrder S; S.init(M, N, G, vb);
    EpiAd<E> Ea{e};
    pg8::gemm_phase<EpiAd<E>, pg8::StaticOrder, true, true>(lds, g, S, Ea);
}
#if FAST_GEMM
#define GEMM gemm_fast
#else
#define GEMM gemm_simple
#endif

__device__ __forceinline__ void conv_simple(const Params& p, LAS unsigned char* lds, int vb, int G) {
    LAS float* red = (LAS float*)lds;
    const bf16_t* A = (const bf16_t*)(p.ws + WS_R1); const bf16_t* SGA = A + (size_t)T * 1024; bf16_t* H0 = (bf16_t*)p.out;
    const float *cw = p.in[6], *cb = p.in[7], *lg = p.in[8], *lbeta = p.in[9], *sc = p.in[2];
    const int tid = opaque((int)threadIdx.x), c = tid * 2;
    for (int r = vb; r < T; r += G) {
        int t, rowbase; const float* hist;
        if (r < TP) { t = r & 2047; rowbase = r - t; hist = nullptr; } else { const int b = (r - TP) >> 3; t = (r - TP) & 7; rowbase = r - t; hist = sc + (size_t)b * 30 * 1024; }
        float y0 = cb[c], y1 = cb[c + 1];
        for (int j = 0; j < 31; ++j) { const int i = t + j - 30; float a0 = 0.f, a1 = 0.f;
            if (i >= 0) { const unsigned w = *(const unsigned*)(A + (size_t)(rowbase + i) * 1024 + c); a0 = bflo(w); a1 = bfhi(w); }
            else if (hist) { a0 = hist[(30 + i) * 1024 + c]; a1 = hist[(30 + i) * 1024 + c + 1]; }
            y0 += cw[j * 1024 + c] * a0; y1 += cw[j * 1024 + c + 1] * a1; }
        const float mean = block_sum(y0 + y1, red) * (1.f / 1024.f);
        const float d0 = y0 - mean, d1 = y1 - mean;
        const float rstd = rsqrtf(block_sum(d0 * d0 + d1 * d1, red) * (1.f / 1024.f) + EPS);
        const float n0 = d0 * rstd * lg[c] + lbeta[c], n1 = d1 * rstd * lg[c + 1] + lbeta[c + 1];
        const unsigned gw = *(const unsigned*)(SGA + (size_t)r * 1024 + c);
        *(unsigned*)(H0 + (size_t)r * 2048 + c) = pk2(silu(n0) * bflo(gw), silu(n1) * bfhi(gw));
    }
    for (int idx = vb * NTHR + tid; idx < 8 * 30 * 1024; idx += G * NTHR) { const int b = idx / 30720, rem = idx % 30720, i = rem >> 10, cc = rem & 1023;
        p.out[O_CP + idx] = bf2f(A[(size_t)(b * 2048 + 2018 + i) * 1024 + cc]); }
    for (int idx = vb * NTHR + tid; idx < 128 * 30 * 1024; idx += G * NTHR) { const int b = idx / 30720, rem = idx % 30720, i = rem >> 10, cc = rem & 1023;
        p.out[O_CS + idx] = (i < 22) ? sc[(size_t)(b * 30 + 8 + i) * 1024 + cc] : bf2f(A[(size_t)(TP + b * 8 + i - 22) * 1024 + cc]); }
}


typedef float f32x16 __attribute__((ext_vector_type(16)));
__device__ __forceinline__ bf16x8 ldfrag(const LAS unsigned char* img, int pitchB, int row0, int k0, int lane) {
    return *(const LAS bf16x8*)(img + (row0 + (lane & 31)) * pitchB + (k0 + 8 * (lane >> 5)) * 2);
}
__device__ __forceinline__ unsigned ld_u16(const void* base, unsigned boff) { return *(const unsigned short*)((const char*)base + boff); }
__device__ __forceinline__ void st_u16(void* base, unsigned boff, unsigned v) { *(unsigned short*)((char*)base + boff) = (unsigned short)v; }
#define MFMA32(a, b, c) __builtin_amdgcn_mfma_f32_32x32x16_bf16((a), (b), (c), 0, 0, 0)
__device__ __forceinline__ int accrow(int r, int lane) { return (r & 3) + 8 * (r >> 2) + 4 * (lane >> 5); }

__device__ __forceinline__ void conv_fast(const Params& p, LAS unsigned char* lds, int vb, int G) {
    LAS float* red = (LAS float*)lds;
    const bf16_t* A = (const bf16_t*)(p.ws + WS_R1); const bf16_t* SGA = A + (size_t)T * 1024; bf16_t* H0 = (bf16_t*)p.out;
    const float *cw = p.in[6], *cb = p.in[7], *lg = p.in[8], *lbeta = p.in[9], *sc = p.in[2];
    const int tid = opaque((int)threadIdx.x), lane = tid & 63, wave = tid >> 6, c = tid * 2;
    LAS float* cwl = (LAS float*)(lds + 1024);
    __syncthreads();
    for (int q = tid; q < 31 * 256; q += NTHR) *(LAS f32x4*)(cwl + q * 4) = *(const f32x4*)(cw + q * 4);
    __syncthreads();
    const float cb0 = cb[c], cb1 = cb[c + 1], g0 = lg[c], g1 = lg[c + 1], be0 = lbeta[c], be1 = lbeta[c + 1];
    for (int item = vb; item < 384; item += G) {
        int L, rowfirst; float w0[38], w1[38];
        if (item < 256) { const int b = item >> 5, t0 = (item & 31) * 64; L = 64; rowfirst = b * 2048 + t0;
#pragma unroll
            for (int i = 0; i < 30; ++i) { unsigned u = 0u; if (t0 > 0) u = *(const unsigned*)(A + (size_t)(rowfirst - 30 + i) * 1024 + c); w0[i] = bflo(u); w1[i] = bfhi(u); }
        } else { const int sb = item - 256; L = 8; rowfirst = TP + sb * 8; const float* hist = sc + (size_t)sb * 30 * 1024;
#pragma unroll
            for (int i = 0; i < 30; ++i) { const f32x2 hv = *(const f32x2*)(hist + i * 1024 + c); w0[i] = hv.x; w1[i] = hv.y; }
        }
        for (int g = 0; g < L; g += 8) {
#pragma unroll
            for (int k = 0; k < 8; ++k) { const unsigned u = *(const unsigned*)(A + (size_t)(rowfirst + g + k) * 1024 + c); w0[30 + k] = bflo(u); w1[30 + k] = bfhi(u); }
            float y0[8], y1[8], st[16];
#pragma unroll
            for (int k = 0; k < 8; ++k) { y0[k] = cb0; y1[k] = cb1; }
#pragma unroll
            for (int j = 0; j < 31; ++j) { const f32x2 w = *(const LAS f32x2*)(cwl + j * 1024 + c);
#pragma unroll
                for (int k = 0; k < 8; ++k) { y0[k] += w.x * w0[k + j]; y1[k] += w.y * w1[k + j]; } }
#pragma unroll
            for (int k = 0; k < 8; ++k) { st[k] = y0[k] + y1[k]; st[8 + k] = y0[k] * y0[k] + y1[k] * y1[k]; }
#pragma unroll
            for (int k = 0; k < 16; ++k) st[k] = wave_sum(st[k]);
            if (lane == 0) {
#pragma unroll
                for (int k = 0; k < 16; ++k) red[wave * 16 + k] = st[k]; }
            __syncthreads();
            if (tid < 16) { float s = 0.f;
#pragma unroll
                for (int w = 0; w < 8; ++w) s += red[w * 16 + tid];
                red[128 + tid] = s; }
            __syncthreads();
#pragma unroll
            for (int k = 0; k < 8; ++k) { const float mean = red[128 + k] * (1.f / 1024.f); const float var = red[136 + k] * (1.f / 1024.f) - mean * mean; const float rstd = rsqrtf(var + EPS);
                const float n0 = (y0[k] - mean) * rstd * g0 + be0, n1 = (y1[k] - mean) * rstd * g1 + be1;
                const size_t row = (size_t)(rowfirst + g + k);
                const unsigned gw = *(const unsigned*)(SGA + row * 1024 + c);
                *(unsigned*)(H0 + row * 2048 + c) = pk2(silu(n0) * bflo(gw), silu(n1) * bfhi(gw)); }
#pragma unroll
            for (int i = 0; i < 30; ++i) { w0[i] = w0[i + 8]; w1[i] = w1[i + 8]; }
        }
    }
    for (int idx = vb * NTHR + tid; idx < 8 * 30 * 1024; idx += G * NTHR) { const int b = idx / 30720, rem = idx % 30720, i = rem >> 10, cc = rem & 1023;
        p.out[O_CP + idx] = bf2f(A[(size_t)(b * 2048 + 2018 + i) * 1024 + cc]); }
    for (int idx = vb * NTHR + tid; idx < 128 * 30 * 1024; idx += G * NTHR) { const int b = idx / 30720, rem = idx % 30720, i = rem >> 10, cc = rem & 1023;
        p.out[O_CS + idx] = (i < 22) ? sc[(size_t)(b * 30 + 8 + i) * 1024 + cc] : bf2f(A[(size_t)(TP + b * 8 + i - 22) * 1024 + cc]); }
}

__device__ __forceinline__ void hgrn_simple(const Params& p, LAS unsigned char* lds, int vb, int G, int item_lo, int item_hi) {
    LAS float* sf = (LAS float*)lds; LAS float* sk = sf + 1024; LAS float* sq = sk + 1024; LAS float* si = sq + 1024; LAS float* so = si + 1024; LAS float* so2 = so + 4096;
    const int tid = opaque((int)threadIdx.x), v = tid & 127, dq = tid >> 7, lane = tid & 63, wave = tid >> 6;
    const bf16_t* Z = (const bf16_t*)(p.ws + WS_R1);
    const bf16_t *Q = Z + (size_t)2 * T * 1024, *LOGF = Z + (size_t)3 * T * 1024, *I = Z + (size_t)4 * T * 1024, *SGB = Z + (size_t)5 * T * 1024;
    const float* og = p.in[11]; bf16_t* H0 = (bf16_t*)p.out;
    for (int item = item_lo + vb; item < item_hi; item += G) {
        int h, L, rowbase; const float* s0; float* sout;
        if (item < 64) { const int b = item >> 3; h = item & 7; L = 2048; rowbase = b * 2048; s0 = nullptr; sout = p.out + O_HP + (size_t)item * 16384; }
        else { const int it = item - 64, b = it >> 3; h = it & 7; L = 8; rowbase = TP + b * 8; s0 = p.in[3] + (size_t)it * 16384; sout = p.out + O_HS + (size_t)it * 16384; }
        float S[32];
#pragma unroll
        for (int j = 0; j < 32; ++j) S[j] = s0 ? s0[(dq * 32 + j) * 128 + v] : 0.f;
        for (int t0 = 0; t0 < L; t0 += 8) {
            __syncthreads();
            for (int e = tid; e < 1024; e += NTHR) { const int tt = e >> 7, d = e & 127; const size_t off = (size_t)(rowbase + t0 + tt) * 1024 + h * 128 + d;
                const float f = __expf(bf2f(LOGF[off])); sf[e] = f; sk[e] = 1.f - f; sq[e] = bf2f(Q[off]); si[e] = bf2f(I[off]); }
            __syncthreads();
#pragma unroll 1
            for (int tt = 0; tt < 8; ++tt) { const float iv = si[tt * 128 + v]; float op = 0.f;
#pragma unroll
                for (int j = 0; j < 32; ++j) { const int d = dq * 32 + j; S[j] = sf[tt * 128 + d] * S[j] + sk[tt * 128 + d] * iv; op += S[j] * sq[tt * 128 + d]; }
                so[(tt * 4 + dq) * 128 + v] = op; }
            __syncthreads();
            for (int e = tid; e < 1024; e += NTHR) { const int tt = e >> 7, vv = e & 127; so2[e] = (so[(tt * 4 + 0) * 128 + vv] + so[(tt * 4 + 1) * 128 + vv]) + (so[(tt * 4 + 2) * 128 + vv] + so[(tt * 4 + 3) * 128 + vv]); }
            __syncthreads();
            { const int tt = wave; const size_t row = (size_t)(rowbase + t0 + tt);
              const float o0 = so2[tt * 128 + lane], o1 = so2[tt * 128 + 64 + lane];
              const float rs = rsqrtf(wave_sum(o0 * o0 + o1 * o1) * (1.f / 128.f) + EPS);
              const float r0 = o0 * rs * og[h * 128 + lane] * bf2f(SGB[row * 1024 + h * 128 + lane]);
              const float r1 = o1 * rs * og[h * 128 + 64 + lane] * bf2f(SGB[row * 1024 + h * 128 + 64 + lane]);
              H0[row * 2048 + 1024 + h * 128 + lane] = (bf16_t)f2bf(r0); H0[row * 2048 + 1024 + h * 128 + 64 + lane] = (bf16_t)f2bf(r1); }
        }
#pragma unroll
        for (int j = 0; j < 32; ++j) sout[(dq * 32 + j) * 128 + v] = S[j];
    }
}


constexpr size_t WS_BSUM = 131072;
constexpr int HA_QM = 0, HA_KM = 17408, HA_KMT = 34816, HA_VT = 53248, HA_P = 71680, HA_ST = 80896, HA_TOT = 115712, HA_DEC = 117760;
constexpr int PQ = 272, PS = 144;
__device__ __forceinline__ void hgrn_phaseA(const Params& p, LAS unsigned char* lds, int vb, int G) {
    const int tid = opaque((int)threadIdx.x), lane = tid & 63, wid = __builtin_amdgcn_readfirstlane(tid >> 6);
    const int d = tid & 127, tq = tid >> 7;
    bf16_t* Zb = (bf16_t*)(p.ws + WS_R1);
    bf16_t* Qg = Zb + (size_t)2 * T * 1024; bf16_t* LFg = Zb + (size_t)3 * T * 1024; const bf16_t* Ig = Zb + (size_t)4 * T * 1024;
    float* SEG = (float*)(p.ws + WS_SEG); float* BSUM = (float*)(p.ws + WS_BSUM);
    LAS float* TOT = (LAS float*)(lds + HA_TOT); LAS float* DEC = (LAS float*)(lds + HA_DEC);
    for (int item = vb; item < 256; item += G) {
        const int bh = item >> 2, seg = item & 3, b = bh >> 3, h = bh & 7;
        const size_t row0 = (size_t)b * 2048 + seg * 512; const int cb = h * 128;
        __syncthreads();
        for (int i = tid; i < 2176; i += NTHR) *(LAS u32x4*)(lds + HA_ST + i * 16) = (u32x4){0u, 0u, 0u, 0u};
        const int dt = wid >> 1, vts = (wid & 1) * 2;
        f32x16 S[2];
#pragma unroll
        for (int j2 = 0; j2 < 2; ++j2)
#pragma unroll
            for (int r = 0; r < 16; ++r) S[j2][r] = 0.f;
        float bsum = 0.f;
        unsigned rq[16], rf[16], ri[16];
        const unsigned toff = ((unsigned)(16 * tq) * 1024u + (unsigned)d) * 2u;
        { const bf16_t* qb = Qg + row0 * 1024 + cb; const bf16_t* fb = LFg + row0 * 1024 + cb; const bf16_t* ib = Ig + row0 * 1024 + cb;
#pragma unroll
          for (int j = 0; j < 16; ++j) { rq[j] = ld_u16(qb, toff + j * 2048u); rf[j] = ld_u16(fb, toff + j * 2048u); ri[j] = ld_u16(ib, toff + j * 2048u); } }
        for (int c = 0; c < 8; ++c) {
            const size_t r0 = row0 + c * 64;
            float bc[16]; float run = 0.f;
#pragma unroll
            for (int j = 0; j < 16; ++j) { run += bf2f(rf[j]); bc[j] = run; }
            TOT[tq * 128 + d] = run;
            __syncthreads();
            float pre = 0.f, bend = 0.f;
#pragma unroll
            for (int q = 0; q < 4; ++q) { const float t = TOT[q * 128 + d]; pre += (q < tq) ? t : 0.f; bend += t; }
            if (tq == 0) DEC[d] = __expf(bend);
            const float eseg = __expf(bsum);
            unsigned kmp[8], vtp[8]; const unsigned to1 = (unsigned)opaque((int)toff);
#pragma unroll
            for (int j = 0; j < 16; j += 2) {
                float km2[2];
#pragma unroll
                for (int u = 0; u < 2; ++u) { const int jj = j + u; const float bcum = pre + bc[jj]; const float f = __expf(bf2f(rf[jj]));
                    const float qm = bf2f(rq[jj]) * __expf(bcum), km = (1.f - f) * __expf(-bcum); km2[u] = km;
                    const int t = 16 * tq + jj;
                    *(LAS bf16_t*)(lds + HA_QM + t * PQ + d * 2) = (bf16_t)f2bf(qm); *(LAS bf16_t*)(lds + HA_KM + t * PQ + d * 2) = (bf16_t)f2bf(km);
                    st_u16(LFg + r0 * 1024 + cb, to1 + jj * 2048u, f2bf(qm * eseg)); }
                kmp[j >> 1] = pk2(km2[0], km2[1]); vtp[j >> 1] = ri[j] | (ri[j + 1] << 16);
            }
            *(LAS u32x4*)(lds + HA_KMT + d * PS + tq * 32) = (u32x4){kmp[0], kmp[1], kmp[2], kmp[3]}; *(LAS u32x4*)(lds + HA_KMT + d * PS + tq * 32 + 16) = (u32x4){kmp[4], kmp[5], kmp[6], kmp[7]};
            *(LAS u32x4*)(lds + HA_VT + d * PS + tq * 32) = (u32x4){vtp[0], vtp[1], vtp[2], vtp[3]}; *(LAS u32x4*)(lds + HA_VT + d * PS + tq * 32 + 16) = (u32x4){vtp[4], vtp[5], vtp[6], vtp[7]};
            bsum += bend;
            __syncthreads();
            f32x16 dS[2];
#pragma unroll
            for (int j2 = 0; j2 < 2; ++j2)
#pragma unroll
                for (int r = 0; r < 16; ++r) dS[j2][r] = 0.f;
            { bf16x8 af[4];
#pragma unroll
              for (int ks = 0; ks < 4; ++ks) af[ks] = ldfrag(lds + HA_KMT, PS, 32 * dt, 16 * ks, lane);
#pragma unroll
              for (int j2 = 0; j2 < 2; ++j2)
#pragma unroll
                  for (int ks = 0; ks < 4; ++ks) { const bf16x8 bb = ldfrag(lds + HA_VT, PS, 32 * (vts + j2), 16 * ks, lane); dS[j2] = MFMA32(af[ks], bb, dS[j2]); } }
            if (wid < 4) {
                const int mt = (wid + 1) >> 1, nt = (wid == 2 || wid == 3) ? 1 : 0;
                const int mtt = (wid == 3) ? 0 : mt;
                f32x16 acc;
#pragma unroll
                for (int r = 0; r < 16; ++r) acc[r] = 0.f;
                if (wid < 3) {
#pragma unroll
                    for (int ks = 0; ks < 8; ++ks) { const bf16x8 a = ldfrag(lds + HA_QM, PQ, 32 * mtt, 16 * ks, lane), bb = ldfrag(lds + HA_KM, PQ, 32 * nt, 16 * ks, lane); acc = MFMA32(a, bb, acc); }
                }
                const int lnx = opaque(lane); const int sx = 32 * nt + (lnx & 31), tb = 32 * mtt + 4 * (lnx >> 5);
                LAS unsigned char* pp = lds + HA_P + tb * PS + sx * 2;
#pragma unroll
                for (int r = 0; r < 16; ++r) { const int tr = (r & 3) + 8 * (r >> 2);
                    *(LAS bf16_t*)(pp + tr * PS) = (bf16_t)f2bf((sx <= tb + tr) ? acc[r] : 0.f); }
            }
            __syncthreads();
            if (c + 1 < 8) { const bf16_t* qb = Qg + (r0 + 64) * 1024 + cb; const bf16_t* fb = LFg + (r0 + 64) * 1024 + cb; const bf16_t* ib = Ig + (r0 + 64) * 1024 + cb;
                const unsigned to2 = (unsigned)opaque((int)toff);
#pragma unroll
                for (int j = 0; j < 16; ++j) { rq[j] = ld_u16(qb, to2 + j * 2048u); rf[j] = ld_u16(fb, to2 + j * 2048u); ri[j] = ld_u16(ib, to2 + j * 2048u); } }
            { const int mt = wid >> 2, vt = wid & 3; f32x16 o;
#pragma unroll
              for (int r = 0; r < 16; ++r) o[r] = 0.f;
#pragma unroll
              for (int ks = 0; ks < 4; ++ks) { const bf16x8 a = ldfrag(lds + HA_P, PS, 32 * mt, 16 * ks, lane), bb = ldfrag(lds + HA_VT, PS, 32 * vt, 16 * ks, lane); o = MFMA32(a, bb, o); }
#pragma unroll
              for (int ks = 0; ks < 8; ++ks) { const bf16x8 a = ldfrag(lds + HA_QM, PQ, 32 * mt, 16 * ks, lane), bb = ldfrag(lds + HA_ST, PQ, 32 * vt, 16 * ks, lane); o = MFMA32(a, bb, o); }
              const int lny = opaque(lane); const unsigned ob = ((unsigned)(32 * mt + 4 * (lny >> 5)) * 1024u + 32 * vt + (lny & 31)) * 2u;
#pragma unroll
              for (int r = 0; r < 16; ++r) st_u16(Qg + r0 * 1024 + cb, ob + ((r & 3) + 8 * (r >> 2)) * 2048u, f2bf(o[r])); }
            __syncthreads();
            { float dec[16]; const int lnu = opaque(lane); const LAS float* dp = DEC + 32 * dt + 4 * (lnu >> 5);
#pragma unroll
              for (int r = 0; r < 16; ++r) dec[r] = dp[(r & 3) + 8 * (r >> 2)];
#pragma unroll
              for (int j2 = 0; j2 < 2; ++j2) {
#pragma unroll
                  for (int r = 0; r < 16; ++r) S[j2][r] = dec[r] * (S[j2][r] + dS[j2][r]);
                  LAS unsigned char* sp2 = lds + HA_ST + (32 * (vts + j2) + (lnu & 31)) * PQ + (32 * dt + 4 * (lnu >> 5)) * 2;
#pragma unroll
                  for (int g = 0; g < 4; ++g)
                      *(LAS u32x2*)(sp2 + 16 * g) = (u32x2){pk2(S[j2][4 * g], S[j2][4 * g + 1]), pk2(S[j2][4 * g + 2], S[j2][4 * g + 3])};
              } }
        }
        { const int lns = opaque(lane); float* sp = SEG + (size_t)item * 16384 + (32 * dt + 4 * (lns >> 5)) * 128 + 32 * vts + (lns & 31);
#pragma unroll
            for (int j2 = 0; j2 < 2; ++j2)
#pragma unroll
                for (int r = 0; r < 16; ++r) sp[((r & 3) + 8 * (r >> 2)) * 128 + 32 * j2] = S[j2][r]; }
        if (tq == 0) BSUM[item * 128 + d] = bsum;
    }
}
constexpr int HB_AQ = 0, HB_SIN = 34816, HB_OT = 69632;
__device__ __forceinline__ void hgrn_phaseB(const Params& p, LAS unsigned char* lds, int vb, int G) {
    const int tid = opaque((int)threadIdx.x), lane = tid & 63, wid = __builtin_amdgcn_readfirstlane(tid >> 6);
    const int v = tid & 127, dg = tid >> 7;
    const bf16_t* Zb = (const bf16_t*)(p.ws + WS_R1);
    const bf16_t* OLg = Zb + (size_t)2 * T * 1024; const bf16_t* QSg = Zb + (size_t)3 * T * 1024; const bf16_t* SGB = Zb + (size_t)5 * T * 1024;
    const float* SEG = (const float*)(p.ws + WS_SEG); const float* BSUM = (const float*)(p.ws + WS_BSUM);
    const float* og = p.in[11]; bf16_t* H0 = (bf16_t*)p.out;
    LAS float* OT = (LAS float*)(lds + HB_OT);
    for (int item = vb; item < 256; item += G) {
        const int bh = item >> 2, seg = item & 3, b = bh >> 3, h = bh & 7;
        const size_t row0 = (size_t)b * 2048 + seg * 512; const int cb = h * 128;
        __syncthreads();
        if (seg > 0) {
            const float* S0 = SEG + (size_t)(bh * 4 + 0) * 16384; const float* S1 = S0 + 16384; const float* S2 = S1 + 16384; const float* S3 = S2 + 16384;
            const float* B1 = BSUM + (bh * 4 + 1) * 128; const float* B2 = B1 + 128; const float* B3 = B2 + 128;
            for (int d0 = dg * 32; d0 < dg * 32 + 32; d0 += 4) { float sv[4];
#pragma unroll
                for (int i = 0; i < 4; ++i) { const int dd = d0 + i; float s = S0[dd * 128 + v];
                    if (seg >= 2) s = __expf(B1[dd]) * s + S1[dd * 128 + v];
                    if (seg >= 3) s = __expf(B2[dd]) * s + S2[dd * 128 + v];
                    sv[i] = s;
                    if (seg == 3) p.out[O_HP + (size_t)bh * 16384 + dd * 128 + v] = __expf(B3[dd]) * s + S3[dd * 128 + v]; }
                *(LAS u32x2*)(lds + HB_SIN + v * PQ + d0 * 2) = (u32x2){pk2(sv[0], sv[1]), pk2(sv[2], sv[3])}; }
        }
        for (int rt = 0; rt < 4; ++rt) {
            const size_t r0 = row0 + rt * 128;
            if (seg > 0) {
                for (int q = tid; q < 2048; q += NTHR) { const int row = q >> 4, c16 = q & 15; *(LAS u32x4*)(lds + HB_AQ + row * PQ + c16 * 16) = *(const u32x4*)(QSg + (r0 + row) * 1024 + cb + c16 * 8); }
                __syncthreads();
                const int mt = wid >> 1, vt0 = (wid & 1) * 2; f32x16 acc0, acc1;
#pragma unroll
                for (int r = 0; r < 16; ++r) { acc0[r] = 0.f; acc1[r] = 0.f; }
#pragma unroll
                for (int ks = 0; ks < 8; ++ks) { const bf16x8 a = ldfrag(lds + HB_AQ, PQ, 32 * mt, 16 * ks, lane), b0 = ldfrag(lds + HB_SIN, PQ, 32 * vt0, 16 * ks, lane), b1 = ldfrag(lds + HB_SIN, PQ, 32 * (vt0 + 1), 16 * ks, lane);
                    acc0 = MFMA32(a, b0, acc0); acc1 = MFMA32(a, b1, acc1); }
#pragma unroll
                for (int r = 0; r < 16; ++r) { const int t = 32 * mt + accrow(r, lane); OT[t * 132 + 32 * vt0 + (lane & 31)] = acc0[r]; OT[t * 132 + 32 * (vt0 + 1) + (lane & 31)] = acc1[r]; }
                __syncthreads();
            }
            { const int row = tid >> 2, part = tid & 3; const size_t grow = r0 + row; const int c0 = cb + 32 * part;
              float o[32];
#pragma unroll
              for (int i = 0; i < 4; ++i) { const u32x4 w = *(const u32x4*)(OLg + grow * 1024 + c0 + 8 * i);
                  o[8 * i] = bflo(w.x); o[8 * i + 1] = bfhi(w.x); o[8 * i + 2] = bflo(w.y); o[8 * i + 3] = bfhi(w.y); o[8 * i + 4] = bflo(w.z); o[8 * i + 5] = bfhi(w.z); o[8 * i + 6] = bflo(w.w); o[8 * i + 7] = bfhi(w.w); }
              if (seg > 0) {
#pragma unroll
                  for (int i = 0; i < 8; ++i) { const f32x4 x = *(const LAS f32x4*)(OT + row * 132 + 32 * part + 4 * i); o[4 * i] += x.x; o[4 * i + 1] += x.y; o[4 * i + 2] += x.z; o[4 * i + 3] += x.w; } }
              float ss = 0.f;
#pragma unroll
              for (int i = 0; i < 32; ++i) ss += o[i] * o[i];
              ss += __shfl_xor(ss, 1); ss += __shfl_xor(ss, 2);
              const float rs = rsqrtf(ss * (1.f / 128.f) + EPS);
#pragma unroll
              for (int i = 0; i < 4; ++i) { const u32x4 gw = *(const u32x4*)(SGB + grow * 1024 + c0 + 8 * i);
                  const f32x4 g0 = *(const f32x4*)(og + h * 128 + 32 * part + 8 * i), g1 = *(const f32x4*)(og + h * 128 + 32 * part + 8 * i + 4);
                  float e[8];
                  e[0] = o[8 * i] * rs * g0.x * bflo(gw.x); e[1] = o[8 * i + 1] * rs * g0.y * bfhi(gw.x); e[2] = o[8 * i + 2] * rs * g0.z * bflo(gw.y); e[3] = o[8 * i + 3] * rs * g0.w * bfhi(gw.y);
                  e[4] = o[8 * i + 4] * rs * g1.x * bflo(gw.z); e[5] = o[8 * i + 5] * rs * g1.y * bfhi(gw.z); e[6] = o[8 * i + 6] * rs * g1.z * bflo(gw.w); e[7] = o[8 * i + 7] * rs * g1.w * bfhi(gw.w);
                  st8(H0 + grow * 2048 + 1024 + c0 + 8 * i, e); }
            }
        }
    }
}

__device__ __forceinline__ void gmlp_simple(const Params& p, LAS unsigned char* lds, int vb, int G, int row_lo) {
    LAS float* smean = (LAS float*)lds; LAS float* srstd = smean + 128;
    const f32x2* VST = (const f32x2*)(p.ws + WS_VST); const bf16_t* GV = (const bf16_t*)p.out; bf16_t* UG = (bf16_t*)(p.ws + WS_UG);
    const float *lg = p.in[15], *lb_ = p.in[16], *wsp = p.in[17], *bs = p.in[18];
    const int tid = opaque((int)threadIdx.x), ch = tid * 4, h = tid >> 6;
    const f32x4 g4 = *(const f32x4*)(lg + ch), b4 = *(const f32x4*)(lb_ + ch);
    for (int r = row_lo + vb; r < T; r += G) {
        int t, cstart;
        if (r < TP) { t = r & 127; cstart = r - t; } else { t = (r - TP) & 7; cstart = r - t; }
        __syncthreads();
        if (tid <= t) { const size_t row = (size_t)(cstart + tid); float s = 0.f, q = 0.f;
            for (int j = 0; j < 32; ++j) { const f32x2 st = VST[row * 32 + j]; s += st.x; q += st.y; }
            const float mean = s * (1.f / 2048.f); const float var = q * (1.f / 2048.f) - mean * mean; smean[tid] = mean; srstd[tid] = rsqrtf(var + EPS); }
        __syncthreads();
        float a0 = 0.f, a1 = 0.f, a2 = 0.f, a3 = 0.f, v0 = 0.f, v1 = 0.f, v2 = 0.f, v3 = 0.f;
        for (int s = 0; s <= t; ++s) {
            const float w = wsp[(size_t)(h * 128 + t) * 128 + s], m = smean[s], rs = srstd[s];
            const u32x2 gvw = *(const u32x2*)(GV + (size_t)(cstart + s) * DC + ch);
            v0 = (bflo(gvw.x) - m) * rs * g4.x + b4.x; v1 = (bfhi(gvw.x) - m) * rs * g4.y + b4.y; v2 = (bflo(gvw.y) - m) * rs * g4.z + b4.z; v3 = (bfhi(gvw.y) - m) * rs * g4.w + b4.w;
            a0 += w * v0; a1 += w * v1; a2 += w * v2; a3 += w * v3;
        }
        const float bias = bs[h * 128 + t];
        const u32x2 ugw = *(const u32x2*)(UG + (size_t)r * DC + ch);
        u32x2 o; o.x = pk2(bflo(ugw.x) * (a0 + bias), bfhi(ugw.x) * (a1 + bias)); o.y = pk2(bflo(ugw.y) * (a2 + bias), bfhi(ugw.y) * (a3 + bias));
        *(u32x2*)(UG + (size_t)r * DC + ch) = o;
        if (r < TP) { const int tt = (r & 2047) - 1920; if (tt >= 0) *(f32x4*)(p.out + O_GP + ((size_t)(r >> 11) * 128 + tt) * DC + ch) = (f32x4){v0, v1, v2, v3}; }
        else *(f32x4*)(p.out + O_GS + (size_t)(r - TP) * DC + ch) = (f32x4){v0, v1, v2, v3};
    }
}


constexpr int GM_W = 0, GM_VT = 34816, GM_MR = 34816 + 69632, GM_PITCH = 272;
__device__ __forceinline__ void gmlp_fast(const Params& p, LAS unsigned char* lds, int vb, int G) {
    LAS float* smean = (LAS float*)(lds + GM_MR); LAS float* srstd = smean + 128;
    const f32x2* VST = (const f32x2*)(p.ws + WS_VST); const bf16_t* GV = (const bf16_t*)p.out; bf16_t* UG = (bf16_t*)(p.ws + WS_UG);
    const float *lg = p.in[15], *lb_ = p.in[16], *wsp = p.in[17], *bs = p.in[18];
    const int tid = opaque((int)threadIdx.x), lane = tid & 63, wid = __builtin_amdgcn_readfirstlane(tid >> 6);
    for (int sitem = vb; sitem < 256; sitem += G) {
        const int chunk = sitem >> 1, hh = (sitem & 1) * 4; const size_t cstart = (size_t)chunk * 128;
        const bool lastchunk = (chunk & 15) == 15; const int bseq = chunk >> 4;
        __syncthreads();
        if (tid < 128) { const size_t row = cstart + tid; float s = 0.f, q = 0.f;
            for (int j = 0; j < 32; ++j) { const f32x2 st = VST[row * 32 + j]; s += st.x; q += st.y; }
            const float mean = s * (1.f / 2048.f); const float var = q * (1.f / 2048.f) - mean * mean; smean[tid] = mean; srstd[tid] = rsqrtf(var + EPS); }
        for (int h = hh; h < hh + 4; ++h) {
            __syncthreads();
            for (int q = tid; q < 4096; q += NTHR) { const int t = q >> 5, s0 = (q & 31) * 4; const f32x4 w = *(const f32x4*)(wsp + (size_t)(h * 128 + t) * 128 + s0);
                u32x2 o; o.x = pk2(s0 <= t ? w.x : 0.f, s0 + 1 <= t ? w.y : 0.f); o.y = pk2(s0 + 2 <= t ? w.z : 0.f, s0 + 3 <= t ? w.w : 0.f);
                *(LAS u32x2*)(lds + GM_W + t * GM_PITCH + s0 * 2) = o; }
            for (int q = tid; q < 2048; q += NTHR) { const int cc = q & 255, sg = q >> 8; const int col = h * 256 + cc; const float gg = lg[col], bb = lb_[col];
                float vn[16];
#pragma unroll
                for (int j = 0; j < 16; ++j) { const int srow = sg * 16 + j; vn[j] = (bf2f(GV[(cstart + srow) * DC + col]) - smean[srow]) * srstd[srow] * gg + bb; }
                u32x4 o0, o1; o0.x = pk2(vn[0], vn[1]); o0.y = pk2(vn[2], vn[3]); o0.z = pk2(vn[4], vn[5]); o0.w = pk2(vn[6], vn[7]); o1.x = pk2(vn[8], vn[9]); o1.y = pk2(vn[10], vn[11]); o1.z = pk2(vn[12], vn[13]); o1.w = pk2(vn[14], vn[15]);
                *(LAS u32x4*)(lds + GM_VT + cc * GM_PITCH + sg * 32) = o0; *(LAS u32x4*)(lds + GM_VT + cc * GM_PITCH + sg * 32 + 16) = o1;
                if (lastchunk) {
#pragma unroll
                    for (int j = 0; j < 16; ++j) p.out[O_GP + ((size_t)bseq * 128 + sg * 16 + j) * DC + col] = vn[j]; }
            }
            __syncthreads();
            f32x16 acc[4];
#pragma unroll
            for (int mt = 0; mt < 4; ++mt)
#pragma unroll
                for (int r = 0; r < 16; ++r) acc[mt][r] = 0.f;
#pragma unroll
            for (int ks = 0; ks < 8; ++ks) { const bf16x8 b = ldfrag(lds + GM_VT, GM_PITCH, 32 * wid, 16 * ks, lane);
#pragma unroll
                for (int mt = 0; mt < 4; ++mt) if (ks < 2 * (mt + 1)) { const bf16x8 a = ldfrag(lds + GM_W, GM_PITCH, 32 * mt, 16 * ks, lane); acc[mt] = MFMA32(a, b, acc[mt]); } }
            const int col = h * 256 + 32 * wid + (lane & 31);
#pragma unroll
            for (int mt = 0; mt < 4; ++mt)
#pragma unroll
                for (int r = 0; r < 16; ++r) { const int t = 32 * mt + accrow(r, lane); bf16_t* u = UG + (cstart + t) * DC + col;
                    *u = (bf16_t)f2bf(bf2f(*u) * (acc[mt][r] + bs[h * 128 + t])); }
        }
    }
}

__device__ __forceinline__ void final_norm(const Params& p, int vb, int G) {
    const int tid = opaque((int)threadIdx.x), lane = tid & 63, wave = tid >> 6;
    const int gw = vb * NWAVES + wave, NGW = G * NWAVES;
    const float* SSP = (const float*)(p.ws + WS_SSP2); const float* g = p.in[20];
    for (int r = gw; r < T; r += NGW) {
        const f32x4* s = (const f32x4*)(SSP + (size_t)r * 16); const f32x4 a = s[0], b = s[1], c = s[2], d = s[3];
        const float tot = ((a.x + a.y) + (a.z + a.w)) + ((b.x + b.y) + (b.z + b.w)) + ((c.x + c.y) + (c.z + c.w)) + ((d.x + d.y) + (d.z + d.w));
        const float rs = rsqrtf(tot * (1.f / 1024.f) + EPS);
        f32x4* y = (f32x4*)(p.out + (size_t)r * D) + lane;
#pragma unroll
        for (int j = 0; j < 4; ++j) { const f32x4 gg = ((const f32x4*)g)[lane + 64 * j]; f32x4 v = y[64 * j]; v.x *= rs * gg.x; v.y *= rs * gg.y; v.z *= rs * gg.z; v.w *= rs * gg.w; y[64 * j] = v; }
    }
}

__global__ void __launch_bounds__(NTHR, 2) fwd_kernel(Params p) {
    extern __shared__ __attribute__((aligned(16))) unsigned char lds_raw[];
    LAS unsigned char* lds = (LAS unsigned char*)lds_raw;
    { volatile LAS unsigned* st0 = (volatile LAS unsigned*)(lds + LDS_BYTES - 64); if (threadIdx.x < 16) st0[threadIdx.x] = 0u; }
    __syncthreads();
    const XcdBarrier bar = xcd_barrier_post((unsigned*)p.ws, (volatile LAS unsigned*)(lds + LDS_BYTES - 64));
    const int G = gridDim.x, vb = blockIdx.x;
    bf16_t* WT1 = (bf16_t*)(p.ws + WS_WT1); bf16_t* WT2 = (bf16_t*)(p.ws + WS_WT2); bf16_t* WT3 = (bf16_t*)(p.ws + WS_WT3); bf16_t* WT4 = (bf16_t*)(p.ws + WS_WT4);
    bf16_t* ZR = (bf16_t*)(p.ws + WS_R1);

    phase0(p, lds, vb, G);
    xcd_barrier(bar);
    { Epi1 E{ZR, (const float*)(p.ws + WS_LB)}; GEMM(lds, (const bf16_t*)p.out, WT1, T, N1, D, E, vb, G); }
    xcd_barrier(bar);
    hgrn_phaseA(p, lds, vb, G);
    hgrn_simple(p, lds, vb, G, 64, 64 + 1024);
    conv_fast(p, lds, vb, G);
    xcd_barrier(bar);
    hgrn_phaseB(p, lds, vb, G);
    xcd_barrier(bar);
    { Epi2 E{p.in[0], p.in[1], (float*)(p.ws + WS_X1), (bf16_t*)(p.ws + WS_X1B), (float*)(p.ws + WS_SSP1)}; GEMM(lds, (const bf16_t*)p.out, WT2, T, D, 2048, E, vb, G); }
    xcd_barrier(bar);
    { Epi3 E{(const float*)(p.ws + WS_SSP1), (bf16_t*)(p.ws + WS_UG), (bf16_t*)p.out, (f32x2*)(p.ws + WS_VST)}; GEMM(lds, (const bf16_t*)(p.ws + WS_X1B), WT3, T, N3, D, E, vb, G); }
    xcd_barrier(bar);
    gmlp_fast(p, lds, vb, G);
    gmlp_simple(p, lds, vb, G, TP);
    xcd_barrier(bar);
    { Epi4 E{(const float*)(p.ws + WS_X1), p.out, (float*)(p.ws + WS_SSP2)}; GEMM(lds, (const bf16_t*)(p.ws + WS_UG), WT4, T, D, 2048, E, vb, G); }
    xcd_barrier(bar);
    final_norm(p, vb, G);
}

extern "C" void kernel_launch(void* const* d_in, const int* in_sizes, int n_in, void* d_out, int out_size, void* d_ws, size_t ws_size, hipStream_t stream) {
    static int grid = 0;
    if (grid == 0) {
        if (n_in != 21 || (size_t)out_size != O_END || ws_size < WS_END) { fprintf(stderr, "kernel_launch: unexpected shapes: n_in %d out %d ws %zu\n", n_in, out_size, ws_size); grid = -1; return; }
        int dev = 0, cus = 0, per_cu = 0;
        if (hipGetDevice(&dev) != hipSuccess || hipDeviceGetAttribute(&cus, hipDeviceAttributeMultiprocessorCount, dev) != hipSuccess) { grid = -1; return; }
        if (hipFuncSetAttribute((const void*)fwd_kernel, hipFuncAttributeMaxDynamicSharedMemorySize, LDS_BYTES) != hipSuccess) { fprintf(stderr, "kernel_launch: hipFuncSetAttribute failed\n"); grid = -1; return; }
        if (hipOccupancyMaxActiveBlocksPerMultiprocessor(&per_cu, (const void*)fwd_kernel, NTHR, LDS_BYTES) != hipSuccess || per_cu < 1) { fprintf(stderr, "kernel_launch: occupancy query says %d\n", per_cu); grid = -1; return; }
        grid = cus;
    }
    if (grid < 0) return;
    if (hipMemsetAsync(d_ws, 0, 16384, stream) != hipSuccess) { fprintf(stderr, "kernel_launch: memset failed\n"); return; }
    Params p{};
    for (int i = 0; i < 21; ++i) p.in[i] = (const float*)d_in[i];
    p.out = (float*)d_out; p.ws = (unsigned char*)d_ws;
    void* args[] = {&p};
    hipError_t e = hipLaunchCooperativeKernel((const void*)fwd_kernel, dim3(grid), dim3(NTHR), args, LDS_BYTES, stream);
    if (e != hipSuccess) fprintf(stderr, "kernel_launch: cooperative launch failed: %s (grid %d)\n", hipGetErrorString(e), grid);
}
```

```cpp
#include <hip/hip_runtime.h>
#include <cstdio>
#include <cstdint>

#ifndef PROBE_A
#define PROBE_A -1
#define PROBE_B -1
#endif
#ifndef FAST_GEMM
#define FAST_GEMM 1
#endif

#define LAS __attribute__((address_space(3)))
typedef unsigned short bf16_t;
typedef short bf16x8 __attribute__((ext_vector_type(8)));
typedef float f32x4 __attribute__((ext_vector_type(4)));
typedef float f32x2 __attribute__((ext_vector_type(2)));
typedef unsigned u32x4 __attribute__((ext_vector_type(4)));
typedef unsigned u32x2 __attribute__((ext_vector_type(2)));

constexpr int D = 1024, TP = 16384, TS = 1024, T = TP + TS;
constexpr int N1 = 7168, N3 = 6144, DC = 2048;
constexpr float EPS = 1e-6f;
constexpr int NWAVES = 8, NTHR = 512;
constexpr int LDS_BYTES = 147456;
constexpr size_t MiB = (size_t)1 << 20;
constexpr size_t WS_LB = 65536;
constexpr size_t WS_WT1 = 1 * MiB, WS_WT2 = 15 * MiB, WS_WT3 = 19 * MiB, WS_WT4 = 31 * MiB;
constexpr size_t WS_R1 = 35 * MiB;
constexpr size_t WS_X1 = WS_R1, WS_X1B = WS_R1 + 68 * MiB, WS_UG = WS_R1 + 102 * MiB;
constexpr size_t WS_SSP1 = WS_R1 + 170 * MiB, WS_VST = WS_R1 + 172 * MiB, WS_SSP2 = WS_R1 + 178 * MiB;
constexpr size_t WS_SEG = 239 * MiB;
constexpr size_t WS_END = 255 * MiB;
constexpr size_t O_YP = 0, O_YS = 16777216, O_CP = 17825792, O_HP = 18071552, O_GP = 19120128, O_CS = 21217280, O_HS = 25149440, O_GS = 41926656, O_END = 44023808;

struct Params { const float* in[21]; float* out; unsigned char* ws; };

__device__ __forceinline__ int opaque(int x) { asm volatile("" : "+v"(x)); return x; }
__device__ __forceinline__ float bf2f(unsigned b) { return __uint_as_float(b << 16); }
__device__ __forceinline__ float bflo(unsigned w) { return __uint_as_float(w << 16); }
__device__ __forceinline__ float bfhi(unsigned w) { return __uint_as_float(w & 0xffff0000u); }
__device__ __forceinline__ unsigned f2bf(float f) { unsigned u = __float_as_uint(f); return (u + 0x7fffu + ((u >> 16) & 1u)) >> 16; }
__device__ __forceinline__ unsigned pk2(float lo, float hi) { return f2bf(lo) | (f2bf(hi) << 16); }
__device__ __forceinline__ float sigm(float x) { return 1.0f / (1.0f + __expf(-x)); }
__device__ __forceinline__ float silu(float x) { return x * sigm(x); }
__device__ __forceinline__ float gelu_t(float x) { return x * sigm(1.5957691216057308f * (x + 0.044715f * x * x * x)); }
__device__ __forceinline__ float wave_sum(float v) {
#pragma unroll
    for (int o = 1; o < 64; o <<= 1) v += __shfl_xor(v, o);
    return v;
}
__device__ __forceinline__ void st8(bf16_t* p, const float (&v)[8]) {
    u32x4 w; w.x = pk2(v[0], v[1]); w.y = pk2(v[2], v[3]); w.z = pk2(v[4], v[5]); w.w = pk2(v[6], v[7]); *(u32x4*)p = w;
}
__device__ __forceinline__ float block_sum(float v, LAS float* red) {
    v = wave_sum(v);
    __syncthreads();
    if ((threadIdx.x & 63) == 0) red[threadIdx.x >> 6] = v;
    __syncthreads();
    float s = 0.f;
#pragma unroll
    for (int i = 0; i < 8; ++i) s += red[i];
    return s;
}


typedef __attribute__((address_space(1))) unsigned gu32;
#define XB_TMO      128
#define XB_XCNT(j)  (256  + 64 * (j))
#define XB_XSUB(j)  (1280 + 64 * (j))
#define XB_XGEN(j)  (2304 + 64 * (j))
#define XB_TOP      3328
#define XB_TOPGEN   3392
#define XCD_BAR_WORDS 3456
#define XB_SPIN_CAP (1u << 20)

__device__ __forceinline__ unsigned xb_ld(unsigned* p)              { return __hip_atomic_load(p, __ATOMIC_RELAXED, __HIP_MEMORY_SCOPE_AGENT); }
__device__ __forceinline__ unsigned xb_add(unsigned* p, unsigned v) { return __hip_atomic_fetch_add(p, v, __ATOMIC_RELAXED, __HIP_MEMORY_SCOPE_AGENT); }
__device__ __forceinline__ unsigned xb_xcc_id() { return (unsigned)__builtin_amdgcn_s_getreg((3 << 11) | 20) & 0xFu; }
#define XB_SPIN(cond, bar) do { unsigned _sp = 0; while (cond) { __builtin_amdgcn_s_sleep(1); \
    if ((++_sp & 255u) == 0u) { if (xb_ld(&(bar)[XB_TMO])) break; if (_sp > XB_SPIN_CAP) { atomicAdd(&(bar)[XB_TMO], 1u); break; } } } } while (0)

struct XcdBarrier {
    unsigned* bar; unsigned x;
    volatile LAS unsigned* st;
};

__device__ __forceinline__ XcdBarrier xcd_barrier_post(unsigned* bar, volatile LAS unsigned* st) {
    XcdBarrier b; b.bar = bar; b.x = xb_xcc_id(); b.st = st;
    if (threadIdx.x == 0) (void)xb_add(&bar[XB_XCNT(b.x)], 1u);
    return b;
}
__device__ __forceinline__ void xcd_barrier_complete(unsigned* bar, unsigned x, unsigned& nloc, unsigned& nx) {
    const unsigned G = gridDim.x * gridDim.y * gridDim.z;
    unsigned sum, cnt, mine, sp = 0u;
    for (;;) {
        sum = 0u; cnt = 0u; mine = 0u;
#pragma unroll
        for (unsigned j = 0; j < 16; ++j) { const unsigned c = xb_ld(&bar[XB_XCNT(j)]); sum += c; cnt += (c > 0u) ? 1u : 0u; mine = (j == x) ? c : mine; }
        if (sum == G) break;
        __builtin_amdgcn_s_sleep(1);
        if ((++sp & 255u) == 0u) { if (xb_ld(&bar[XB_TMO])) break; if (sp > XB_SPIN_CAP) { atomicAdd(&bar[XB_TMO], 1u); break; } }
    }
    nloc = mine > 0u ? mine : 1u; nx = cnt > 0u ? cnt : 1u;
}

__device__ __forceinline__ void xcd_barrier(const XcdBarrier& b) {
    asm volatile("s_waitcnt vmcnt(0)" ::: "memory");
    __syncthreads();
    if (threadIdx.x == 0) {
        unsigned* bar = b.bar;
        __builtin_amdgcn_s_waitcnt(0);
        unsigned nloc = b.st[0], nx = b.st[1];
        if (nloc == 0u) { xcd_barrier_complete(bar, b.x, nloc, nx); b.st[0] = nloc; b.st[1] = nx; }
        const unsigned old = xb_add(&bar[XB_XSUB(b.x)], 1u);
        const unsigned gen = old / nloc;
        if (old + 1u == (gen + 1u) * nloc) {
            __builtin_amdgcn_fence(__ATOMIC_RELEASE, "agent");
            asm volatile("s_waitcnt vmcnt(0)" ::: "memory");
            const unsigned og = xb_add(&bar[XB_TOP], 1u);
            const unsigned tg = og / nx;
            if (og + 1u == (tg + 1u) * nx) xb_add(&bar[XB_TOPGEN], 1u);
            else XB_SPIN(xb_ld(&bar[XB_TOPGEN]) == tg, bar);
            __builtin_amdgcn_fence(__ATOMIC_ACQUIRE, "agent");
            xb_add(&bar[XB_XGEN(b.x)], 1u);
            asm volatile("s_waitcnt vmcnt(0)" ::: "memory");
        } else {
            XB_SPIN(xb_ld(&bar[XB_XGEN(b.x)]) == gen, bar);
            __builtin_amdgcn_fence(__ATOMIC_ACQUIRE, "agent");
            asm volatile("s_waitcnt vmcnt(0)" ::: "memory");
        }
    }
    __syncthreads();
}

template <int MAP> __device__ __forceinline__ int vmap(int vc) {
    const int vt = vc >> 8, c = vc & 255;
    if (MAP == 1) return vt < 8 ? (c < 128 ? 128 * vt + c : 1024 + 128 * vt + (c - 128)) : vc;
    if (MAP == 3) return vt < 16 ? (c < 128 ? 128 * vt + c : 4096 + 128 * vt + (c - 128)) : vc - 2048;
    return vc;
}

template <int MAP> __device__ __forceinline__ void transpose_item(const float* W, int K, int N, bf16_t* WT, const float* kscale, LAS float* scr, int item, int lane) {
    const int nblk = N / 32, kb = item / nblk, nb = item % nblk, k0 = 64 * kb, n0 = 32 * nb;
    const int on0 = vmap<MAP>(n0);
#pragma unroll 8
    for (int i = 0; i < 32; ++i) { const int kk = 2 * i + (lane >> 5); float w = W[(size_t)(k0 + kk) * N + on0 + (lane & 31)]; if (kscale) w *= kscale[k0 + kk]; scr[kk * 33 + (lane & 31)] = w; }
    asm volatile("s_waitcnt lgkmcnt(0)" ::: "memory");
    const int c = lane & 7;
#pragma unroll
    for (int j = 0; j < 4; ++j) { const int n = (lane >> 3) + 8 * j; const LAS float* s = scr + (8 * c) * 33 + n;
        u32x4 o; o.x = pk2(s[0 * 33], s[1 * 33]); o.y = pk2(s[2 * 33], s[3 * 33]); o.z = pk2(s[4 * 33], s[5 * 33]); o.w = pk2(s[6 * 33], s[7 * 33]);
        *(u32x4*)(WT + (size_t)(n0 + n) * K + k0 + 8 * c) = o; }
    asm volatile("s_waitcnt lgkmcnt(0)" ::: "memory");
}
__device__ __forceinline__ void rms_row_to_bf16(const float* xrow, const float* g, bf16_t* orow, int lane) {
    const f32x4* xr = (const f32x4*)xrow + lane; f32x4 v[4]; float s = 0.f;
#pragma unroll
    for (int j = 0; j < 4; ++j) { v[j] = xr[64 * j]; s += (v[j].x * v[j].x + v[j].y * v[j].y) + (v[j].z * v[j].z + v[j].w * v[j].w); }
    const float rs = rsqrtf(wave_sum(s) * (1.f / 1024.f) + EPS);
    u32x2* o8 = (u32x2*)orow + lane;
#pragma unroll
    for (int j = 0; j < 4; ++j) { const f32x4 gg = ((const f32x4*)g)[lane + 64 * j]; u32x2 w; w.x = pk2(v[j].x * rs * gg.x, v[j].y * rs * gg.y); w.y = pk2(v[j].z * rs * gg.z, v[j].w * rs * gg.w); o8[64 * j] = w; }
}
__device__ __forceinline__ void phase0(const Params& p, LAS unsigned char* lds, int vb, int G) {
    const int tid = opaque((int)threadIdx.x), lane = tid & 63, wave = tid >> 6;
    const int gw = vb * NWAVES + wave, NGW = G * NWAVES;
    float* LB = (float*)(p.ws + WS_LB);
    for (int i = vb * NTHR + tid; i < 1024; i += G * NTHR) { const float l0 = p.in[10][i], l1 = p.in[10][1024 + i]; LB[i] = 1.0f / (1.0f + __expf(l1 - l0)); }
    LAS float* scr = (LAS float*)(lds + wave * 16384);
    constexpr int I1 = (D / 64) * (N1 / 32), I2 = (2048 / 64) * (D / 32), I3 = (D / 64) * (N3 / 32), I4 = I2;
    for (int it = gw; it < I1 + I2 + I3 + I4; it += NGW) {
        int r = it;
        if (r < I1) { transpose_item<1>(p.in[5], D, N1, (bf16_t*)(p.ws + WS_WT1), nullptr, scr, r, lane); continue; } r -= I1;
        if (r < I2) { transpose_item<0>(p.in[12], 2048, D, (bf16_t*)(p.ws + WS_WT2), nullptr, scr, r, lane); continue; } r -= I2;
        if (r < I3) { transpose_item<3>(p.in[14], D, N3, (bf16_t*)(p.ws + WS_WT3), p.in[13], scr, r, lane); continue; } r -= I3;
        transpose_item<0>(p.in[19], 2048, D, (bf16_t*)(p.ws + WS_WT4), nullptr, scr, r, lane);
    }
    bf16_t* XN0 = (bf16_t*)p.out;
    for (int r = gw; r < T; r += NGW) { const float* xr = r < TP ? p.in[0] + (size_t)r * D : p.in[1] + (size_t)(r - TP) * D; rms_row_to_bf16(xr, p.in[4], XN0 + (size_t)r * D, lane); }
}

struct Epi1 {
    bf16_t* Z; const float* LB;
    __device__ __forceinline__ float rowscale(int) const { return 1.f; }
    template <int X1M, int X2M> __device__ __forceinline__ void tile8(int row, int pn, int c0, const float (&lo)[8], const float (&hi)[8], float) const {
        if (pn < 8) { float a[8];
#pragma unroll
            for (int i = 0; i < 8; ++i) a[i] = lo[i] * sigm(hi[i]);
            st8(Z + (size_t)row * 1024 + 128 * pn + c0, a);
        } else {
            const int g = (pn - 8) >> 2, col = ((pn - 8) & 3) * 256 + c0;
            bf16_t* base = Z + (size_t)(g + 1) * T * 1024 + (size_t)row * 1024 + col;
            float x[8], y[8];
            if (g == 1) {
#pragma unroll
                for (int i = 0; i < 8; ++i) { x[i] = lo[i]; y[i] = hi[i]; }
            } else if (g == 2) {
#pragma unroll
                for (int i = 0; i < 8; ++i) { const float l0 = LB[col + i], l1 = LB[col + 128 + i]; x[i] = __logf(l0 + (1.f - l0) * sigm(lo[i])); y[i] = __logf(l1 + (1.f - l1) * sigm(hi[i])); }
            } else {
#pragma unroll
                for (int i = 0; i < 8; ++i) { x[i] = silu(lo[i]); y[i] = silu(hi[i]); }
            }
            st8(base, x); st8(base + 128, y);
        }
    }
};
struct Epi2 {
    const float* xp; const float* xs; float* X1; bf16_t* X1B; float* SSP;
    __device__ __forceinline__ float rowscale(int) const { return 1.f; }
    template <int X1M, int X2M> __device__ __forceinline__ void tile8(int row, int pn, int c0, const float (&lo)[8], const float (&hi)[8], float) const {
        const int col = 256 * pn + c0;
        const float* xr = (row < TP ? xp + (size_t)row * D : xs + (size_t)(row - TP) * D) + col;
        const f32x4 a0 = *(const f32x4*)xr, a1 = *(const f32x4*)(xr + 4), b0 = *(const f32x4*)(xr + 128), b1 = *(const f32x4*)(xr + 132);
        float v[8], w[8];
        v[0] = a0.x + lo[0]; v[1] = a0.y + lo[1]; v[2] = a0.z + lo[2]; v[3] = a0.w + lo[3]; v[4] = a1.x + lo[4]; v[5] = a1.y + lo[5]; v[6] = a1.z + lo[6]; v[7] = a1.w + lo[7];
        w[0] = b0.x + hi[0]; w[1] = b0.y + hi[1]; w[2] = b0.z + hi[2]; w[3] = b0.w + hi[3]; w[4] = b1.x + hi[4]; w[5] = b1.y + hi[5]; w[6] = b1.z + hi[6]; w[7] = b1.w + hi[7];
        float* o = X1 + (size_t)row * D + col;
        *(f32x4*)o = (f32x4){v[0], v[1], v[2], v[3]}; *(f32x4*)(o + 4) = (f32x4){v[4], v[5], v[6], v[7]};
        *(f32x4*)(o + 128) = (f32x4){w[0], w[1], w[2], w[3]}; *(f32x4*)(o + 132) = (f32x4){w[4], w[5], w[6], w[7]};
        bf16_t* ob = X1B + (size_t)row * D + col; st8(ob, v); st8(ob + 128, w);
        float ss = 0.f;
#pragma unroll
        for (int i = 0; i < 8; ++i) ss += v[i] * v[i] + w[i] * w[i];
        ss += __shfl_xor(ss, X1M); ss += __shfl_xor(ss, X2M);
        if ((c0 & 31) == 0) SSP[(size_t)row * 16 + pn * 4 + (c0 >> 5)] = ss;
    }
};
struct Epi3 {
    const float* SSP1; bf16_t* UG; bf16_t* GV; f32x2* VST;
    __device__ __forceinline__ float rowscale(int row) const {
        const f32x4* s = (const f32x4*)(SSP1 + (size_t)row * 16); const f32x4 a = s[0], b = s[1], c = s[2], d = s[3];
        const float t = ((a.x + a.y) + (a.z + a.w)) + ((b.x + b.y) + (b.z + b.w)) + ((c.x + c.y) + (c.z + c.w)) + ((d.x + d.y) + (d.z + d.w));
        return rsqrtf(t * (1.f / 1024.f) + EPS);
    }
    template <int X1M, int X2M> __device__ __forceinline__ void tile8(int row, int pn, int c0, const float (&lo)[8], const float (&hi)[8], float rs) const {
        if (pn < 16) { float a[8];
#pragma unroll
            for (int i = 0; i < 8; ++i) a[i] = gelu_t(lo[i] * rs) * silu(hi[i] * rs);
            st8(UG + (size_t)row * DC + 128 * pn + c0, a);
        } else {
            const int col = 256 * (pn - 16) + c0; float x[8], y[8], s = 0.f, q = 0.f;
#pragma unroll
            for (int i = 0; i < 8; ++i) { x[i] = gelu_t(lo[i] * rs); y[i] = gelu_t(hi[i] * rs); s += x[i] + y[i]; q += x[i] * x[i] + y[i] * y[i]; }
            bf16_t* o = GV + (size_t)row * DC + col; st8(o, x); st8(o + 128, y);
            s += __shfl_xor(s, X1M); q += __shfl_xor(q, X1M); s += __shfl_xor(s, X2M); q += __shfl_xor(q, X2M);
            if ((c0 & 31) == 0) VST[(size_t)row * 32 + (pn - 16) * 4 + (c0 >> 5)] = (f32x2){s, q};
        }
    }
};
struct Epi4 {
    const float* X1; float* Y; float* SSP;
    __device__ __forceinline__ float rowscale(int) const { return 1.f; }
    template <int X1M, int X2M> __device__ __forceinline__ void tile8(int row, int pn, int c0, const float (&lo)[8], const float (&hi)[8], float) const {
        const int col = 256 * pn + c0;
        const float* xr = X1 + (size_t)row * D + col;
        const f32x4 a0 = *(const f32x4*)xr, a1 = *(const f32x4*)(xr + 4), b0 = *(const f32x4*)(xr + 128), b1 = *(const f32x4*)(xr + 132);
        float v[8], w[8];
        v[0] = a0.x + lo[0]; v[1] = a0.y + lo[1]; v[2] = a0.z + lo[2]; v[3] = a0.w + lo[3]; v[4] = a1.x + lo[4]; v[5] = a1.y + lo[5]; v[6] = a1.z + lo[6]; v[7] = a1.w + lo[7];
        w[0] = b0.x + hi[0]; w[1] = b0.y + hi[1]; w[2] = b0.z + hi[2]; w[3] = b0.w + hi[3]; w[4] = b1.x + hi[4]; w[5] = b1.y + hi[5]; w[6] = b1.z + hi[6]; w[7] = b1.w + hi[7];
        float* o = Y + (size_t)row * D + col;
        *(f32x4*)o = (f32x4){v[0], v[1], v[2], v[3]}; *(f32x4*)(o + 4) = (f32x4){v[4], v[5], v[6], v[7]};
        *(f32x4*)(o + 128) = (f32x4){w[0], w[1], w[2], w[3]}; *(f32x4*)(o + 132) = (f32x4){w[4], w[5], w[6], w[7]};
        float ss = 0.f;
#pragma unroll
        for (int i = 0; i < 8; ++i) ss += v[i] * v[i] + w[i] * w[i];
        ss += __shfl_xor(ss, X1M); ss += __shfl_xor(ss, X2M);
        if ((c0 & 31) == 0) SSP[(size_t)row * 16 + pn * 4 + (c0 >> 5)] = ss;
    }
};

template <class Epi> __device__ __forceinline__ void gemm_simple(LAS unsigned char* lds, const bf16_t* A, const bf16_t* Bt, int M, int N, int K, const Epi& E, int vb, int G) {
    LAS bf16_t* sA = (LAS bf16_t*)lds;
    LAS bf16_t* sB = (LAS bf16_t*)(lds + 4096);
    const int tid = opaque((int)threadIdx.x), r = tid >> 4, c0 = (tid & 15) * 8;
    const int nN = N / 256, nunits = (M / 32) * nN;
    for (int u = vb; u < nunits; u += G) {
        const int ms = u / nN, pn = u % nN, row0 = ms * 32, col0 = pn * 256;
        float lo[8], hi[8];
#pragma unroll
        for (int i = 0; i < 8; ++i) { lo[i] = 0.f; hi[i] = 0.f; }
        for (int k0 = 0; k0 < K; k0 += 32) {
            __syncthreads();
            if (tid < 128) { const int rr = tid >> 2, kc = (tid & 3) * 8; *(LAS u32x4*)(sA + rr * 40 + kc) = *(const u32x4*)(A + (size_t)(row0 + rr) * K + k0 + kc); }
            for (int q = tid; q < 1024; q += NTHR) { const int rr = q >> 2, kc = (q & 3) * 8; *(LAS u32x4*)(sB + rr * 40 + kc) = *(const u32x4*)(Bt + (size_t)(col0 + rr) * K + k0 + kc); }
            __syncthreads();
#pragma unroll 1
            for (int kc = 0; kc < 32; kc += 8) {
                const u32x4 av = *(const LAS u32x4*)(sA + r * 40 + kc);
                const float a0 = bflo(av.x), a1 = bfhi(av.x), a2 = bflo(av.y), a3 = bfhi(av.y), a4 = bflo(av.z), a5 = bfhi(av.z), a6 = bflo(av.w), a7 = bfhi(av.w);
#pragma unroll
                for (int i = 0; i < 8; ++i) {
                    const u32x4 b = *(const LAS u32x4*)(sB + (c0 + i) * 40 + kc);
                    lo[i] += a0 * bflo(b.x) + a1 * bfhi(b.x) + a2 * bflo(b.y) + a3 * bfhi(b.y) + a4 * bflo(b.z) + a5 * bfhi(b.z) + a6 * bflo(b.w) + a7 * bfhi(b.w);
                    const u32x4 c = *(const LAS u32x4*)(sB + (128 + c0 + i) * 40 + kc);
                    hi[i] += a0 * bflo(c.x) + a1 * bfhi(c.x) + a2 * bflo(c.y) + a3 * bfhi(c.y) + a4 * bflo(c.z) + a5 * bfhi(c.z) + a6 * bflo(c.w) + a7 * bfhi(c.w);
                }
            }
        }
        const int row = row0 + r; const float rsc = E.rowscale(row);
        E.template tile8<1, 2>(row, pn, c0, lo, hi, rsc);
    }
}

namespace pg8 {
#define PG8_LAS __attribute__((address_space(3)))
constexpr int BM = 256, BK = 64, HALF = 128, HTB = HALF * BK * 2  , STAGE_BYTES = 8 * HTB, NXCD = 8, WGM = 8;

__host__ __device__ __forceinline__ int lds_byte(int r, int c) { const int st = (r >> 4) * 2 + (c >> 5), rr = r & 15, cc = c & 31, ob = rr * 64 + cc * 2; return st * 1024 + (ob ^ (((ob >> 9) & 1) << 5)); }
__host__ __device__ __forceinline__ void stage_rc(int b, int& R, int& C) { const int st = b / 1024, sb = b % 1024, swz = sb ^ (((sb >> 9) & 1) << 5); R = (st >> 1) * 16 + swz / 64; C = (st & 1) * 32 + (swz % 64) / 2; }
__host__ __device__ __forceinline__ int perm32(int rho) { const int n = rho >> 4, i = rho & 15; return 8 * (i >> 2) + 4 * n + (i & 3); }

struct Unit { int pm, pn; };
struct Gemm { const bf16_t* A; const bf16_t* Bt; int M, N, K; };

struct StaticOrder {
    int nM, nN, nwg, G, c;
    __host__ __device__ void init(int M, int N, int G_, int c_) { nM = M / BM; nN = N / BM; nwg = nM * nN; G = G_; c = c_; }
    __host__ __device__ bool next(int i, Unit& u) const {
        const long L = (long)i * G + c; if (L >= nwg) return false;
        int wgid = (int)L; { const int q = nwg / NXCD, r = nwg % NXCD, xcd = wgid % NXCD, off = wgid / NXCD; wgid = (xcd < r ? xcd * (q + 1) : r * (q + 1) + (xcd - r) * q) + off; }
        const int nig = WGM * nN, gid = wgid / nig, fm = gid * WGM, gsz = (nM - fm) < WGM ? (nM - fm) : WGM;
        u.pm = fm + ((wgid % nig) % gsz); u.pn = (wgid % nig) / gsz; return true;
    }
    __device__ __forceinline__ void a_ready(const Unit&) const {}
    __device__ __forceinline__ void done(const Unit&) const {}
};
template <class Epi, class Sched, bool ALIGN_EPI = false, bool SP2 = false>
__device__ __forceinline__ void gemm_phase(PG8_LAS unsigned char* lds, const Gemm g, const Sched& S, const Epi& E) {
    const int tid = opaque((int)threadIdx.x), wid = __builtin_amdgcn_readfirstlane(tid >> 6), lane = tid & 63, wr = wid >> 2, wc = wid & 3, fr = lane & 15, fq = lane >> 4;
    const int K = g.K, nt = K / BK;
    unsigned voffA[2], voffB[2];
#pragma unroll
    for (int i = 0; i < 2; ++i) { int R, C; stage_rc(tid * 16 + i * 8192, R, C); const int Rb = Epi::PERM ? ((R & ~31) + perm32(R & 31)) : R;
        voffA[i] = (unsigned)(R * K + C) * 2u; voffB[i] = (unsigned)(Rb * K + C) * 2u; }
    const size_t kstep = (size_t)(BK * 2);
    const size_t hstep = (size_t)HALF * K * 2;
    const size_t tstep = 2 * hstep;
    const unsigned ldsw = (unsigned)wid * 1024u;
    const int aoff = lds_byte(wr * 64 + fr, fq * 8), boff = lds_byte(wc * 32 + fr, fq * 8);
#define PG8_SA(b, h) (((b) * 2 + (h)) * HTB)
#define PG8_SB(b, h) ((4 + (b) * 2 + (h)) * HTB)
#define PG8_STAGE(bufoff, gbase, voff) do { _Pragma("unroll") for (int _i = 0; _i < 2; ++_i) \
        __builtin_amdgcn_global_load_lds((const unsigned*)((const char*)(gbase) + (voff)[_i]), (PG8_LAS unsigned*)(lds + (bufoff) + ldsw + _i * 8192), 16, 0, 0); } while (0)
#define PG8_LDA(dst, b, h) do { _Pragma("unroll") for (int m = 0; m < 4; ++m) _Pragma("unroll") for (int k = 0; k < 2; ++k) dst[m][k] = *(const PG8_LAS bf16x8*)(lds + PG8_SA(b, h) + aoff + m * 2048 + k * 1024); } while (0)
#define PG8_LDB(dst, b, h) do { _Pragma("unroll") for (int n = 0; n < 2; ++n) _Pragma("unroll") for (int k = 0; k < 2; ++k) dst[n][k] = *(const PG8_LAS bf16x8*)(lds + PG8_SB(b, h) + boff + n * 2048 + k * 1024); } while (0)
#define PG8_MMA(ai, bj, At, Bt) do { __builtin_amdgcn_s_setprio(1); _Pragma("unroll") for (int m = 0; m < 4; ++m) _Pragma("unroll") for (int n = 0; n < 2; ++n) _Pragma("unroll") for (int k = 0; k < 2; ++k) \
        acc[ai][bj][m][n] = __builtin_amdgcn_mfma_f32_16x16x32_bf16(Bt[n][k], At[m][k], acc[ai][bj][m][n], 0, 0, 0); __builtin_amdgcn_s_setprio(0); } while (0)
#define PG8_WAIT_V(n) asm volatile("s_waitcnt vmcnt(" #n ")" ::: "memory")
#define PG8_WAIT_L(n) asm volatile("s_waitcnt lgkmcnt(" #n ")" ::: "memory")
#define PG8_BAR __builtin_amdgcn_s_barrier()
#define PG8_SCHED __builtin_amdgcn_sched_barrier(0)
    Unit cur, nxt; int ui = 0;
    if (!S.next(0, cur)) return;
    f32x4 acc[2][2][4][2];
#pragma unroll
    for (int a = 0; a < 2; ++a)
#pragma unroll
        for (int b = 0; b < 2; ++b)
#pragma unroll
            for (int m = 0; m < 4; ++m)
#pragma unroll
                for (int n = 0; n < 2; ++n) acc[a][b][m][n] = (f32x4){0.f, 0.f, 0.f, 0.f};
    bf16x8 At[4][2], B0[2][2], B1[2][2];
    const char* cA = (const char*)g.A + (size_t)cur.pm * tstep; const char* cB = (const char*)g.Bt + (size_t)cur.pn * tstep;
    S.a_ready(cur);
    if constexpr (SP2) {
        PG8_STAGE(PG8_SB(0, 0), cB, voffB); PG8_STAGE(PG8_SB(0, 1), cB + hstep, voffB); PG8_STAGE(PG8_SA(0, 0), cA, voffA); PG8_STAGE(PG8_SA(0, 1), cA + hstep, voffA);
        if (wr == 1) PG8_BAR;
        PG8_WAIT_V(2); PG8_BAR;
        PG8_STAGE(PG8_SB(1, 0), cB + kstep, voffB); PG8_STAGE(PG8_SA(1, 0), cA + kstep, voffA); PG8_STAGE(PG8_SB(1, 1), cB + hstep + kstep, voffB);
        PG8_WAIT_V(6); PG8_BAR;
    } else {
        PG8_STAGE(PG8_SB(0, 0), cB, voffB); PG8_STAGE(PG8_SA(0, 0), cA, voffA); PG8_STAGE(PG8_SB(0, 1), cB + hstep, voffB); PG8_STAGE(PG8_SA(0, 1), cA + hstep, voffA);
        if (wr == 1) PG8_BAR;
        PG8_WAIT_V(4); PG8_BAR;
        PG8_STAGE(PG8_SB(1, 0), cB + kstep, voffB); PG8_STAGE(PG8_SA(1, 0), cA + kstep, voffA); PG8_STAGE(PG8_SB(1, 1), cB + hstep + kstep, voffB);
        PG8_WAIT_V(6); PG8_BAR;
    }
    for (;;) {
        const bool has_next = S.next(ui + 1, nxt);
        const char* nA = has_next ? (const char*)g.A + (size_t)nxt.pm * tstep : cA; const char* nB = has_next ? (const char*)g.Bt + (size_t)nxt.pn * tstep : cB;
        for (int t = 0; t < nt; t += 2) {
            const bool last = (t == nt - 2);
            const char* a1 = cA + (size_t)(t + 1) * kstep;
            const char* a2 = last ? nA : cA + (size_t)(t + 2) * kstep; const char* b2 = last ? nB : cB + (size_t)(t + 2) * kstep;
            const char* a3 = a2 + kstep; const char* b3 = b2 + kstep;
            if (last && has_next) S.a_ready(nxt);
            if constexpr (SP2) {
            PG8_LDB(B0, 0, 0); PG8_LDB(B1, 0, 1); PG8_SCHED; PG8_LDA(At, 0, 0); PG8_STAGE(PG8_SA(1, 1), a1 + hstep, voffA);
            PG8_WAIT_V(8); PG8_WAIT_L(0); PG8_BAR; PG8_MMA(0, 0, At, B0); PG8_MMA(0, 1, At, B1); PG8_BAR; PG8_SCHED;
            PG8_LDA(At, 0, 1); PG8_STAGE(PG8_SB(0, 0), b2, voffB); PG8_STAGE(PG8_SB(0, 1), b2 + hstep, voffB); PG8_STAGE(PG8_SA(0, 0), a2, voffA);
            PG8_WAIT_V(8); PG8_WAIT_L(0); PG8_BAR; PG8_MMA(1, 0, At, B0); PG8_MMA(1, 1, At, B1); PG8_BAR; PG8_SCHED;
            PG8_LDB(B0, 1, 0); PG8_LDB(B1, 1, 1); PG8_SCHED; PG8_LDA(At, 1, 0); PG8_STAGE(PG8_SA(0, 1), a2 + hstep, voffA);
            PG8_WAIT_V(8); PG8_WAIT_L(0); PG8_BAR; PG8_MMA(0, 0, At, B0); PG8_MMA(0, 1, At, B1); PG8_BAR; PG8_SCHED;
            PG8_LDA(At, 1, 1); PG8_STAGE(PG8_SB(1, 0), b3, voffB); PG8_STAGE(PG8_SB(1, 1), b3 + hstep, voffB); PG8_STAGE(PG8_SA(1, 0), a3, voffA);
            PG8_WAIT_V(8); PG8_WAIT_L(0); PG8_BAR; PG8_MMA(1, 0, At, B0); PG8_MMA(1, 1, At, B1); PG8_BAR; PG8_SCHED;
            } else {
            PG8_LDB(B0, 0, 0); PG8_SCHED; PG8_LDA(At, 0, 0); PG8_STAGE(PG8_SA(1, 1), a1 + hstep, voffA);
            PG8_WAIT_L(8); PG8_BAR; PG8_WAIT_L(0); PG8_MMA(0, 0, At, B0); PG8_BAR; PG8_SCHED;
            PG8_LDB(B1, 0, 1); PG8_STAGE(PG8_SB(0, 0), b2, voffB);
            PG8_BAR; PG8_WAIT_L(0); PG8_MMA(0, 1, At, B1); PG8_BAR;
            PG8_LDA(At, 0, 1); PG8_STAGE(PG8_SA(0, 0), a2, voffA);
            PG8_BAR; PG8_WAIT_L(0); PG8_MMA(1, 0, At, B0); PG8_BAR; PG8_SCHED;
            PG8_STAGE(PG8_SB(0, 1), b2 + hstep, voffB);
            PG8_WAIT_V(6); PG8_BAR; PG8_MMA(1, 1, At, B1); PG8_BAR;
            PG8_LDB(B0, 1, 0); PG8_SCHED; PG8_LDA(At, 1, 0); PG8_STAGE(PG8_SA(0, 1), a2 + hstep, voffA);
            PG8_WAIT_L(8); PG8_BAR; PG8_WAIT_L(0); PG8_MMA(0, 0, At, B0); PG8_BAR; PG8_SCHED;
            PG8_LDB(B1, 1, 1); PG8_STAGE(PG8_SB(1, 0), b3, voffB);
            PG8_BAR; PG8_WAIT_L(0); PG8_MMA(0, 1, At, B1); PG8_BAR;
            PG8_LDA(At, 1, 1); PG8_STAGE(PG8_SA(1, 0), a3, voffA);
            PG8_BAR; PG8_WAIT_L(0); PG8_MMA(1, 0, At, B0); PG8_BAR; PG8_SCHED;
            PG8_STAGE(PG8_SB(1, 1), b3 + hstep, voffB);
            PG8_WAIT_V(6); PG8_BAR; PG8_MMA(1, 1, At, B1); PG8_BAR;
            }
        }
        if constexpr (ALIGN_EPI) { if (wr == 0) PG8_BAR; }
        if constexpr (!Epi::AFTER_DRAIN) { E(acc, cur, wr, wc, fr, fq); S.done(cur); }
        if (!has_next) break;
#pragma unroll
        for (int a = 0; a < 2; ++a)
#pragma unroll
            for (int b = 0; b < 2; ++b)
#pragma unroll
                for (int m = 0; m < 4; ++m)
#pragma unroll
                    for (int n = 0; n < 2; ++n) acc[a][b][m][n] = (f32x4){0.f, 0.f, 0.f, 0.f};
        cur = nxt; cA = nA; cB = nB; ++ui;
        if constexpr (ALIGN_EPI) { if (wr == 1) PG8_BAR; }
    }
    PG8_WAIT_V(0);
    if constexpr (!ALIGN_EPI) { if (wr == 0) PG8_BAR; }
    PG8_BAR;
    if constexpr (Epi::AFTER_DRAIN) { E.fused(acc, cur, wr, wc, fr, fq, lds, wid, lane); S.done(cur); }
#undef PG8_SA
#undef PG8_SB
#undef PG8_STAGE
#undef PG8_LDA
#undef PG8_LDB
#undef PG8_MMA
#undef PG8_WAIT_V
#undef PG8_WAIT_L
#undef PG8_BAR
#undef PG8_SCHED
}
}

template <class E> struct EpiAd {
    static constexpr bool PERM = true, AFTER_DRAIN = false; E e;
    __device__ __forceinline__ void operator()(const f32x4 (&acc)[2][2][4][2], const pg8::Unit& u, int wr, int wc, int fr, int fq) const {
#pragma unroll
        for (int ai = 0; ai < 2; ++ai)
#pragma unroll
            for (int m = 0; m < 4; ++m) {
                const int row = u.pm * 256 + ai * 128 + wr * 64 + m * 16 + fr;
                const float rsc = e.rowscale(row);
                float lo[8], hi[8];
#pragma unroll
                for (int j = 0; j < 4; ++j) { lo[j] = acc[ai][0][m][0][j]; lo[4 + j] = acc[ai][0][m][1][j]; hi[j] = acc[ai][1][m][0][j]; hi[4 + j] = acc[ai][1][m][1][j]; }
                e.template tile8<16, 32>(row, u.pn, wc * 32 + 8 * fq, lo, hi, rsc);
            }
    }
};
template <class E> __device__ __forceinline__ void gemm_fast(LAS unsigned char* lds, const bf16_t* A, const bf16_t* Bt, int M, int N, int K, const E& e, int vb, int G) {
    pg8::Gemm g{A, Bt, M, N, K}; pg8::StaticOrder S; S.init(M, N, G, vb);
    EpiAd<E> Ea{e};
    pg8::gemm_phase<EpiAd<E>, pg8::StaticOrder, true, true>(lds, g, S, Ea);
}

template <class E, int KS>
__device__ __forceinline__ void gemm_small(LAS unsigned char* lds, const bf16_t* A, const bf16_t* Bt, int N, int K, const E& e, int row_base, int vb, int G) {
    const int tid = opaque((int)threadIdx.x), lane = tid & 63, wave = __builtin_amdgcn_readfirstlane(tid >> 6), fr = lane & 15, fq = lane >> 4;
    const int nwork = 16 * (N / 64) * KS;
    for (int wbase = vb * NWAVES; wbase < nwork; wbase += G * NWAVES) {
        const int wk = wbase + wave; const bool act = wk < nwork;
        const int tile = act ? wk / KS : 0, ks = wk % KS;
        const int ct = tile >> 4, rt = tile & 15, pn = ct >> 2, cg = ct & 3;
        const int klen = K / KS, kb = ks * klen;
        f32x4 acc[4][4];
#pragma unroll
        for (int m = 0; m < 4; ++m)
#pragma unroll
            for (int n = 0; n < 4; ++n) acc[m][n] = (f32x4){0.f, 0.f, 0.f, 0.f};
        if (act) {
            const bf16_t* ap = A + (size_t)(rt * 64 + fr) * K + kb + 8 * fq;
            const bf16_t* bp[4];
#pragma unroll
            for (int n = 0; n < 4; ++n) { const int vcol = 256 * pn + (n >> 1) * 128 + 32 * cg + pg8::perm32(16 * (n & 1) + fr); bp[n] = Bt + (size_t)vcol * K + kb + 8 * fq; }
            bf16x8 a0[4], b0[4], a1[4], b1[4];
#define GS_LD(aa, bb, koff) do { _Pragma("unroll") for (int m = 0; m < 4; ++m) aa[m] = *(const bf16x8*)(ap + (size_t)m * 16 * K + (koff)); \
                                 _Pragma("unroll") for (int n = 0; n < 4; ++n) bb[n] = *(const bf16x8*)(bp[n] + (koff)); } while (0)
#define GS_MMA(aa, bb) do { _Pragma("unroll") for (int m = 0; m < 4; ++m) _Pragma("unroll") for (int n = 0; n < 4; ++n) \
                                 acc[m][n] = __builtin_amdgcn_mfma_f32_16x16x32_bf16(bb[n], aa[m], acc[m][n], 0, 0, 0); } while (0)
            GS_LD(a0, b0, 0);
            for (int k = 0; k < klen; k += 64) {
                GS_LD(a1, b1, k + 32);
                GS_MMA(a0, b0);
                if (k + 64 < klen) GS_LD(a0, b0, k + 64);
                GS_MMA(a1, b1);
            }
#undef GS_LD
#undef GS_MMA
        }
        if (KS == 1) {
            if (act) {
#pragma unroll
                for (int m = 0; m < 4; ++m) { const int row = row_base + rt * 64 + 16 * m + fr; const float rsc = e.rowscale(row); float lo[8], hi[8];
#pragma unroll
                    for (int j = 0; j < 4; ++j) { lo[j] = acc[m][0][j]; lo[4 + j] = acc[m][1][j]; hi[j] = acc[m][2][j]; hi[4 + j] = acc[m][3][j]; }
                    e.template tile8<16, 32>(row, pn, 32 * cg + 8 * fq, lo, hi, rsc); }
            }
        } else {
            LAS float* P = (LAS float*)lds;
            __syncthreads();
#pragma unroll
            for (int m = 0; m < 4; ++m)
#pragma unroll
                for (int n = 0; n < 4; ++n)
#pragma unroll
                    for (int j = 0; j < 4; ++j) P[((wave * 16 + m * 4 + n) * 4 + j) * 64 + lane] = acc[m][n][j];
            __syncthreads();
            if (wave < 4 && act) {
                const int m = wave; float lo[8], hi[8];
#pragma unroll
                for (int n = 0; n < 4; ++n)
#pragma unroll
                    for (int j = 0; j < 4; ++j) { float sum = 0.f;
#pragma unroll
                        for (int sl = 0; sl < KS; ++sl) sum += P[((sl * 16 + m * 4 + n) * 4 + j) * 64 + lane];
                        if (n < 2) lo[(n & 1) * 4 + j] = sum; else hi[(n & 1) * 4 + j] = sum; }
                const int row = row_base + rt * 64 + 16 * m + fr; const float rsc = e.rowscale(row);
                e.template tile8<16, 32>(row, pn, 32 * cg + 8 * fq, lo, hi, rsc);
            }
        }
    }
}
#if FAST_GEMM
#define GEMM gemm_fast
#else
#define GEMM gemm_simple
#endif

__device__ __forceinline__ void conv_simple(const Params& p, LAS unsigned char* lds, int vb, int G) {
    LAS float* red = (LAS float*)lds;
    const bf16_t* A = (const bf16_t*)(p.ws + WS_R1); const bf16_t* SGA = A + (size_t)T * 1024; bf16_t* H0 = (bf16_t*)p.out;
    const float *cw = p.in[6], *cb = p.in[7], *lg = p.in[8], *lbeta = p.in[9], *sc = p.in[2];
    const int tid = opaque((int)threadIdx.x), c = tid * 2;
    for (int r = vb; r < T; r += G) {
        int t, rowbase; const float* hist;
        if (r < TP) { t = r & 2047; rowbase = r - t; hist = nullptr; } else { const int b = (r - TP) >> 3; t = (r - TP) & 7; rowbase = r - t; hist = sc + (size_t)b * 30 * 1024; }
        float y0 = cb[c], y1 = cb[c + 1];
        for (int j = 0; j < 31; ++j) { const int i = t + j - 30; float a0 = 0.f, a1 = 0.f;
            if (i >= 0) { const unsigned w = *(const unsigned*)(A + (size_t)(rowbase + i) * 1024 + c); a0 = bflo(w); a1 = bfhi(w); }
            else if (hist) { a0 = hist[(30 + i) * 1024 + c]; a1 = hist[(30 + i) * 1024 + c + 1]; }
            y0 += cw[j * 1024 + c] * a0; y1 += cw[j * 1024 + c + 1] * a1; }
        const float mean = block_sum(y0 + y1, red) * (1.f / 1024.f);
        const float d0 = y0 - mean, d1 = y1 - mean;
        const float rstd = rsqrtf(block_sum(d0 * d0 + d1 * d1, red) * (1.f / 1024.f) + EPS);
        const float n0 = d0 * rstd * lg[c] + lbeta[c], n1 = d1 * rstd * lg[c + 1] + lbeta[c + 1];
        const unsigned gw = *(const unsigned*)(SGA + (size_t)r * 1024 + c);
        *(unsigned*)(H0 + (size_t)r * 2048 + c) = pk2(silu(n0) * bflo(gw), silu(n1) * bfhi(gw));
    }
    for (int idx = vb * NTHR + tid; idx < 8 * 30 * 1024; idx += G * NTHR) { const int b = idx / 30720, rem = idx % 30720, i = rem >> 10, cc = rem & 1023;
        p.out[O_CP + idx] = bf2f(A[(size_t)(b * 2048 + 2018 + i) * 1024 + cc]); }
    for (int idx = vb * NTHR + tid; idx < 128 * 30 * 1024; idx += G * NTHR) { const int b = idx / 30720, rem = idx % 30720, i = rem >> 10, cc = rem & 1023;
        p.out[O_CS + idx] = (i < 22) ? sc[(size_t)(b * 30 + 8 + i) * 1024 + cc] : bf2f(A[(size_t)(TP + b * 8 + i - 22) * 1024 + cc]); }
}


typedef float f32x16 __attribute__((ext_vector_type(16)));
__device__ __forceinline__ bf16x8 ldfrag(const LAS unsigned char* img, int pitchB, int row0, int k0, int lane) {
    return *(const LAS bf16x8*)(img + (row0 + (lane & 31)) * pitchB + (k0 + 8 * (lane >> 5)) * 2);
}
__device__ __forceinline__ unsigned ld_u16(const void* base, unsigned boff) { return *(const unsigned short*)((const char*)base + boff); }
__device__ __forceinline__ void st_u16(void* base, unsigned boff, unsigned v) { *(unsigned short*)((char*)base + boff) = (unsigned short)v; }
#define MFMA32(a, b, c) __builtin_amdgcn_mfma_f32_32x32x16_bf16((a), (b), (c), 0, 0, 0)
__device__ __forceinline__ int accrow(int r, int lane) { return (r & 3) + 8 * (r >> 2) + 4 * (lane >> 5); }

__device__ __forceinline__ void conv_fast(const Params& p, LAS unsigned char* lds, int vb, int G) {
    LAS float* red = (LAS float*)lds;
    const bf16_t* A = (const bf16_t*)(p.ws + WS_R1); const bf16_t* SGA = A + (size_t)T * 1024; bf16_t* H0 = (bf16_t*)p.out;
    const float *cw = p.in[6], *cb = p.in[7], *lg = p.in[8], *lbeta = p.in[9], *sc = p.in[2];
    const int tid = opaque((int)threadIdx.x), lane = tid & 63, wave = tid >> 6, c = tid * 2;
    LAS float* cwl = (LAS float*)(lds + 1024);
    __syncthreads();
    for (int q = tid; q < 31 * 256; q += NTHR) *(LAS f32x4*)(cwl + q * 4) = *(const f32x4*)(cw + q * 4);
    __syncthreads();
    const float cb0 = cb[c], cb1 = cb[c + 1], g0 = lg[c], g1 = lg[c + 1], be0 = lbeta[c], be1 = lbeta[c + 1];
    const f32x2 cbv = (f32x2){cb0, cb1}, gv2 = (f32x2){g0, g1}, bev = (f32x2){be0, be1};
    for (int item = vb; item < 384; item += G) {
        int L, rowfirst; f32x2 w[38];
        if (item < 256) { const int b = item >> 5, t0 = (item & 31) * 64; L = 64; rowfirst = b * 2048 + t0;
#pragma unroll
            for (int i = 0; i < 30; ++i) { unsigned u = 0u; if (t0 > 0) u = *(const unsigned*)(A + (size_t)(rowfirst - 30 + i) * 1024 + c); w[i] = (f32x2){bflo(u), bfhi(u)}; }
        } else { const int sb = item - 256; L = 8; rowfirst = TP + sb * 8; const float* hist = sc + (size_t)sb * 30 * 1024;
#pragma unroll
            for (int i = 0; i < 30; ++i) w[i] = *(const f32x2*)(hist + i * 1024 + c);
        }
        unsigned an[8], gn[8];
#pragma unroll
        for (int k = 0; k < 8; ++k) { an[k] = *(const unsigned*)(A + (size_t)(rowfirst + k) * 1024 + c); gn[k] = *(const unsigned*)(SGA + (size_t)(rowfirst + k) * 1024 + c); }
        for (int g = 0; g < L; g += 8) {
            unsigned gc[8];
#pragma unroll
            for (int k = 0; k < 8; ++k) { w[30 + k] = (f32x2){bflo(an[k]), bfhi(an[k])}; gc[k] = gn[k]; }
            if (g + 8 < L) {
#pragma unroll
                for (int k = 0; k < 8; ++k) { an[k] = *(const unsigned*)(A + (size_t)(rowfirst + g + 8 + k) * 1024 + c); gn[k] = *(const unsigned*)(SGA + (size_t)(rowfirst + g + 8 + k) * 1024 + c); } }
            f32x2 y[8]; float st[16];
#pragma unroll
            for (int k = 0; k < 8; ++k) y[k] = cbv;
#pragma unroll
            for (int j = 0; j < 31; ++j) { const f32x2 wj = *(const LAS f32x2*)(cwl + j * 1024 + c);
#pragma unroll
                for (int k = 0; k < 8; ++k) y[k] += wj * w[k + j]; }
#pragma unroll
            for (int k = 0; k < 8; ++k) { const f32x2 sq = y[k] * y[k]; st[k] = y[k].x + y[k].y; st[8 + k] = sq.x + sq.y; }
#pragma unroll
            for (int k = 0; k < 16; ++k) st[k] = wave_sum(st[k]);
            if (lane == 0) {
#pragma unroll
                for (int k = 0; k < 16; ++k) red[wave * 16 + k] = st[k]; }
            __syncthreads();
            if (tid < 16) { float sacc = 0.f;
#pragma unroll
                for (int ww = 0; ww < 8; ++ww) sacc += red[ww * 16 + tid];
                red[128 + tid] = sacc; }
            __syncthreads();
#pragma unroll
            for (int k = 0; k < 8; ++k) { const float mean = red[128 + k] * (1.f / 1024.f); const float var = red[136 + k] * (1.f / 1024.f) - mean * mean; const float rstd = rsqrtf(var + EPS);
                const f32x2 n = (y[k] - mean) * rstd * gv2 + bev;
                *(unsigned*)(H0 + (size_t)(rowfirst + g + k) * 2048 + c) = pk2(silu(n.x) * bflo(gc[k]), silu(n.y) * bfhi(gc[k])); }
#pragma unroll
            for (int i = 0; i < 30; ++i) w[i] = w[i + 8];
        }
        if (item >= 256) { float* o = p.out + O_CS + (size_t)(item - 256) * 30 * 1024 + c;
#pragma unroll
            for (int i = 0; i < 30; ++i) *(f32x2*)(o + i * 1024) = w[i]; }
        else if ((item & 31) == 31) { float* o = p.out + O_CP + (size_t)(item >> 5) * 30 * 1024 + c;
#pragma unroll
            for (int i = 0; i < 30; ++i) *(f32x2*)(o + i * 1024) = w[i]; }
    }
}

__device__ __forceinline__ void hgrn_simple(const Params& p, LAS unsigned char* lds, int vb, int G, int item_lo, int item_hi) {
    LAS float* sf = (LAS float*)lds; LAS float* sk = sf + 1024; LAS float* sq = sk + 1024; LAS float* si = sq + 1024; LAS float* so = si + 1024; LAS float* so2 = so + 4096;
    const int tid = opaque((int)threadIdx.x), v = tid & 127, dq = tid >> 7, lane = tid & 63, wave = tid >> 6;
    const bf16_t* Z = (const bf16_t*)(p.ws + WS_R1);
    const bf16_t *Q = Z + (size_t)2 * T * 1024, *LOGF = Z + (size_t)3 * T * 1024, *I = Z + (size_t)4 * T * 1024, *SGB = Z + (size_t)5 * T * 1024;
    const float* og = p.in[11]; bf16_t* H0 = (bf16_t*)p.out;
    for (int item = item_lo + vb; item < item_hi; item += G) {
        int h, L, rowbase; const float* s0; float* sout;
        if (item < 64) { const int b = item >> 3; h = item & 7; L = 2048; rowbase = b * 2048; s0 = nullptr; sout = p.out + O_HP + (size_t)item * 16384; }
        else { const int it = item - 64, b = it >> 3; h = it & 7; L = 8; rowbase = TP + b * 8; s0 = p.in[3] + (size_t)it * 16384; sout = p.out + O_HS + (size_t)it * 16384; }
        float S[32];
#pragma unroll
        for (int j = 0; j < 32; ++j) S[j] = s0 ? s0[(dq * 32 + j) * 128 + v] : 0.f;
        for (int t0 = 0; t0 < L; t0 += 8) {
            __syncthreads();
            for (int e = tid; e < 1024; e += NTHR) { const int tt = e >> 7, d = e & 127; const size_t off = (size_t)(rowbase + t0 + tt) * 1024 + h * 128 + d;
                const float f = __expf(bf2f(LOGF[off])); sf[e] = f; sk[e] = 1.f - f; sq[e] = bf2f(Q[off]); si[e] = bf2f(I[off]); }
            __syncthreads();
#pragma unroll 1
            for (int tt = 0; tt < 8; ++tt) { const float iv = si[tt * 128 + v]; float op = 0.f;
#pragma unroll
                for (int j = 0; j < 32; ++j) { const int d = dq * 32 + j; S[j] = sf[tt * 128 + d] * S[j] + sk[tt * 128 + d] * iv; op += S[j] * sq[tt * 128 + d]; }
                so[(tt * 4 + dq) * 128 + v] = op; }
            __syncthreads();
            for (int e = tid; e < 1024; e += NTHR) { const int tt = e >> 7, vv = e & 127; so2[e] = (so[(tt * 4 + 0) * 128 + vv] + so[(tt * 4 + 1) * 128 + vv]) + (so[(tt * 4 + 2) * 128 + vv] + so[(tt * 4 + 3) * 128 + vv]); }
            __syncthreads();
            { const int tt = wave; const size_t row = (size_t)(rowbase + t0 + tt);
              const float o0 = so2[tt * 128 + lane], o1 = so2[tt * 128 + 64 + lane];
              const float rs = rsqrtf(wave_sum(o0 * o0 + o1 * o1) * (1.f / 128.f) + EPS);
              const float r0 = o0 * rs * og[h * 128 + lane] * bf2f(SGB[row * 1024 + h * 128 + lane]);
              const float r1 = o1 * rs * og[h * 128 + 64 + lane] * bf2f(SGB[row * 1024 + h * 128 + 64 + lane]);
              H0[row * 2048 + 1024 + h * 128 + lane] = (bf16_t)f2bf(r0); H0[row * 2048 + 1024 + h * 128 + 64 + lane] = (bf16_t)f2bf(r1); }
        }
#pragma unroll
        for (int j = 0; j < 32; ++j) sout[(dq * 32 + j) * 128 + v] = S[j];
    }
}


__device__ __forceinline__ void hgrn_sample(const Params& p, LAS unsigned char* lds, int vb, int G) {
    LAS float* sf = (LAS float*)lds; LAS float* sk = sf + 1024; LAS float* sq = sk + 1024; LAS float* si = sq + 1024; LAS float* so = si + 1024; LAS float* so2 = so + 4096;
    const int tid = opaque((int)threadIdx.x), v = tid & 127, dq = tid >> 7, lane = tid & 63, wave = tid >> 6;
    const bf16_t* Z = (const bf16_t*)(p.ws + WS_R1);
    const bf16_t *Q = Z + (size_t)2 * T * 1024, *LOGF = Z + (size_t)3 * T * 1024, *I = Z + (size_t)4 * T * 1024, *SGB = Z + (size_t)5 * T * 1024;
    const float* og = p.in[11]; bf16_t* H0 = (bf16_t*)p.out;
    float S[32], Sn[32]; unsigned rl[2], rq2[2], ri2[2];
#define HS_LOAD(it_, SS) do { const float* s0_ = p.in[3] + (size_t)(it_) * 16384 + (dq * 32) * 128 + v; \
        _Pragma("unroll") for (int j = 0; j < 32; ++j) SS[j] = s0_[j * 128]; \
        _Pragma("unroll") for (int u = 0; u < 2; ++u) { const int e = tid + u * NTHR; const size_t off = (size_t)(TP + ((it_) >> 3) * 8 + (e >> 7)) * 1024 + ((it_) & 7) * 128 + (e & 127); \
            rl[u] = LOGF[off]; rq2[u] = Q[off]; ri2[u] = I[off]; } } while (0)
    int it = vb;
    if (it < 1024) HS_LOAD(it, S);
    for (; it < 1024; it += G) {
        const int b = it >> 3, h = it & 7, rowbase = TP + b * 8;
        __syncthreads();
#pragma unroll
        for (int u = 0; u < 2; ++u) { const int e = tid + u * NTHR; const float f = __expf(bf2f(rl[u])); sf[e] = f; sk[e] = 1.f - f; sq[e] = bf2f(rq2[u]); si[e] = bf2f(ri2[u]); }
        if (it + G < 1024) HS_LOAD(it + G, Sn);
        __syncthreads();
#pragma unroll 1
        for (int tt = 0; tt < 8; ++tt) { const float iv = si[tt * 128 + v]; float op = 0.f;
            const LAS f32x4* f4 = (const LAS f32x4*)(sf + tt * 128 + dq * 32); const LAS f32x4* k4 = (const LAS f32x4*)(sk + tt * 128 + dq * 32); const LAS f32x4* q4 = (const LAS f32x4*)(sq + tt * 128 + dq * 32);
#pragma unroll
            for (int jj = 0; jj < 8; ++jj) { const f32x4 fv = f4[jj], kv = k4[jj], qv = q4[jj];
                S[4 * jj] = fv.x * S[4 * jj] + kv.x * iv; op += S[4 * jj] * qv.x; S[4 * jj + 1] = fv.y * S[4 * jj + 1] + kv.y * iv; op += S[4 * jj + 1] * qv.y;
                S[4 * jj + 2] = fv.z * S[4 * jj + 2] + kv.z * iv; op += S[4 * jj + 2] * qv.z; S[4 * jj + 3] = fv.w * S[4 * jj + 3] + kv.w * iv; op += S[4 * jj + 3] * qv.w; }
            so[(tt * 4 + dq) * 128 + v] = op; }
        __syncthreads();
#pragma unroll
        for (int u = 0; u < 2; ++u) { const int e = tid + u * NTHR; const int tt = e >> 7, vv = e & 127; so2[e] = (so[(tt * 4 + 0) * 128 + vv] + so[(tt * 4 + 1) * 128 + vv]) + (so[(tt * 4 + 2) * 128 + vv] + so[(tt * 4 + 3) * 128 + vv]); }
        __syncthreads();
        { const int tt = wave; const size_t row = (size_t)(rowbase + tt);
          const float o0 = so2[tt * 128 + lane], o1 = so2[tt * 128 + 64 + lane];
          const float rs = rsqrtf(wave_sum(o0 * o0 + o1 * o1) * (1.f / 128.f) + EPS);
          const float r0 = o0 * rs * og[h * 128 + lane] * bf2f(SGB[row * 1024 + h * 128 + lane]);
          const float r1 = o1 * rs * og[h * 128 + 64 + lane] * bf2f(SGB[row * 1024 + h * 128 + 64 + lane]);
          H0[row * 2048 + 1024 + h * 128 + lane] = (bf16_t)f2bf(r0); H0[row * 2048 + 1024 + h * 128 + 64 + lane] = (bf16_t)f2bf(r1); }
        { float* sout = p.out + O_HS + (size_t)it * 16384 + (dq * 32) * 128 + v;
#pragma unroll
          for (int j = 0; j < 32; ++j) { sout[j * 128] = S[j]; S[j] = Sn[j]; } }
    }
#undef HS_LOAD
}

constexpr size_t WS_BSUM = 131072;
constexpr int HA_QM = 0, HA_KM = 17408, HA_KMT = 34816, HA_VT = 53248, HA_P = 71680, HA_ST = 80896, HA_TOT = 115712, HA_DEC = 117760;
constexpr int PQ = 272, PS = 144;
__device__ __forceinline__ void hgrn_phaseA(const Params& p, LAS unsigned char* lds, int vb, int G) {
    const int tid = opaque((int)threadIdx.x), lane = tid & 63, wid = __builtin_amdgcn_readfirstlane(tid >> 6);
    const int d = tid & 127, tq = tid >> 7;
    bf16_t* Zb = (bf16_t*)(p.ws + WS_R1);
    bf16_t* Qg = Zb + (size_t)2 * T * 1024; bf16_t* LFg = Zb + (size_t)3 * T * 1024; const bf16_t* Ig = Zb + (size_t)4 * T * 1024;
    float* SEG = (float*)(p.ws + WS_SEG); float* BSUM = (float*)(p.ws + WS_BSUM);
    LAS float* TOT = (LAS float*)(lds + HA_TOT); LAS float* DEC = (LAS float*)(lds + HA_DEC);
    for (int item = vb; item < 256; item += G) {
        const int bh = item >> 2, seg = item & 3, b = bh >> 3, h = bh & 7;
        const size_t row0 = (size_t)b * 2048 + seg * 512; const int cb = h * 128;
        __syncthreads();
        for (int i = tid; i < 2176; i += NTHR) *(LAS u32x4*)(lds + HA_ST + i * 16) = (u32x4){0u, 0u, 0u, 0u};
        const int dt = wid >> 1, vts = (wid & 1) * 2;
        f32x16 S[2];
#pragma unroll
        for (int j2 = 0; j2 < 2; ++j2)
#pragma unroll
            for (int r = 0; r < 16; ++r) S[j2][r] = 0.f;
        float bsum = 0.f;
        unsigned rq[16], rf[16], ri[16];
        const unsigned toff = ((unsigned)(16 * tq) * 1024u + (unsigned)d) * 2u;
        { const bf16_t* qb = Qg + row0 * 1024 + cb; const bf16_t* fb = LFg + row0 * 1024 + cb; const bf16_t* ib = Ig + row0 * 1024 + cb;
#pragma unroll
          for (int j = 0; j < 16; ++j) { rq[j] = ld_u16(qb, toff + j * 2048u); rf[j] = ld_u16(fb, toff + j * 2048u); ri[j] = ld_u16(ib, toff + j * 2048u); } }
        for (int c = 0; c < 8; ++c) {
            const size_t r0 = row0 + c * 64;
            float bc[16]; float run = 0.f;
#pragma unroll
            for (int j = 0; j < 16; ++j) { run += bf2f(rf[j]); bc[j] = run; }
            TOT[tq * 128 + d] = run;
            __syncthreads();
            float pre = 0.f, bend = 0.f;
#pragma unroll
            for (int q = 0; q < 4; ++q) { const float t = TOT[q * 128 + d]; pre += (q < tq) ? t : 0.f; bend += t; }
            if (tq == 0) DEC[d] = __expf(bend);
            const float eseg = __expf(bsum);
            unsigned kmp[8], vtp[8]; const unsigned to1 = (unsigned)opaque((int)toff);
#pragma unroll
            for (int j = 0; j < 16; j += 2) {
                float km2[2];
#pragma unroll
                for (int u = 0; u < 2; ++u) { const int jj = j + u; const float bcum = pre + bc[jj]; const float f = __expf(bf2f(rf[jj]));
                    const float qm = bf2f(rq[jj]) * __expf(bcum), km = (1.f - f) * __expf(-bcum); km2[u] = km;
                    const int t = 16 * tq + jj;
                    *(LAS bf16_t*)(lds + HA_QM + t * PQ + d * 2) = (bf16_t)f2bf(qm); *(LAS bf16_t*)(lds + HA_KM + t * PQ + d * 2) = (bf16_t)f2bf(km);
                    st_u16(LFg + r0 * 1024 + cb, to1 + jj * 2048u, f2bf(qm * eseg)); }
                kmp[j >> 1] = pk2(km2[0], km2[1]); vtp[j >> 1] = ri[j] | (ri[j + 1] << 16);
            }
            *(LAS u32x4*)(lds + HA_KMT + d * PS + tq * 32) = (u32x4){kmp[0], kmp[1], kmp[2], kmp[3]}; *(LAS u32x4*)(lds + HA_KMT + d * PS + tq * 32 + 16) = (u32x4){kmp[4], kmp[5], kmp[6], kmp[7]};
            *(LAS u32x4*)(lds + HA_VT + d * PS + tq * 32) = (u32x4){vtp[0], vtp[1], vtp[2], vtp[3]}; *(LAS u32x4*)(lds + HA_VT + d * PS + tq * 32 + 16) = (u32x4){vtp[4], vtp[5], vtp[6], vtp[7]};
            bsum += bend;
            __syncthreads();
            f32x16 dS[2];
#pragma unroll
            for (int j2 = 0; j2 < 2; ++j2)
#pragma unroll
                for (int r = 0; r < 16; ++r) dS[j2][r] = 0.f;
            { bf16x8 af[4];
#pragma unroll
              for (int ks = 0; ks < 4; ++ks) af[ks] = ldfrag(lds + HA_KMT, PS, 32 * dt, 16 * ks, lane);
#pragma unroll
              for (int j2 = 0; j2 < 2; ++j2)
#pragma unroll
                  for (int ks = 0; ks < 4; ++ks) { const bf16x8 bb = ldfrag(lds + HA_VT, PS, 32 * (vts + j2), 16 * ks, lane); dS[j2] = MFMA32(af[ks], bb, dS[j2]); } }
            if (wid < 4) {
                const int mt = (wid + 1) >> 1, nt = (wid == 2 || wid == 3) ? 1 : 0;
                const int mtt = (wid == 3) ? 0 : mt;
                f32x16 acc;
#pragma unroll
                for (int r = 0; r < 16; ++r) acc[r] = 0.f;
                if (wid < 3) {
#pragma unroll
                    for (int ks = 0; ks < 8; ++ks) { const bf16x8 a = ldfrag(lds + HA_QM, PQ, 32 * mtt, 16 * ks, lane), bb = ldfrag(lds + HA_KM, PQ, 32 * nt, 16 * ks, lane); acc = MFMA32(a, bb, acc); }
                }
                const int lnx = opaque(lane); const int sx = 32 * nt + (lnx & 31), tb = 32 * mtt + 4 * (lnx >> 5);
                LAS unsigned char* pp = lds + HA_P + tb * PS + sx * 2;
#pragma unroll
                for (int r = 0; r < 16; ++r) { const int tr = (r & 3) + 8 * (r >> 2);
                    *(LAS bf16_t*)(pp + tr * PS) = (bf16_t)f2bf((sx <= tb + tr) ? acc[r] : 0.f); }
            }
            __syncthreads();
            if (c + 1 < 8) { const bf16_t* qb = Qg + (r0 + 64) * 1024 + cb; const bf16_t* fb = LFg + (r0 + 64) * 1024 + cb; const bf16_t* ib = Ig + (r0 + 64) * 1024 + cb;
                const unsigned to2 = (unsigned)opaque((int)toff);
#pragma unroll
                for (int j = 0; j < 16; ++j) { rq[j] = ld_u16(qb, to2 + j * 2048u); rf[j] = ld_u16(fb, to2 + j * 2048u); ri[j] = ld_u16(ib, to2 + j * 2048u); } }
            { const int mt = wid >> 2, vt = wid & 3; f32x16 o;
#pragma unroll
              for (int r = 0; r < 16; ++r) o[r] = 0.f;
#pragma unroll
              for (int ks = 0; ks < 4; ++ks) { const bf16x8 a = ldfrag(lds + HA_P, PS, 32 * mt, 16 * ks, lane), bb = ldfrag(lds + HA_VT, PS, 32 * vt, 16 * ks, lane); o = MFMA32(a, bb, o); }
#pragma unroll
              for (int ks = 0; ks < 8; ++ks) { const bf16x8 a = ldfrag(lds + HA_QM, PQ, 32 * mt, 16 * ks, lane), bb = ldfrag(lds + HA_ST, PQ, 32 * vt, 16 * ks, lane); o = MFMA32(a, bb, o); }
              const int lny = opaque(lane); const unsigned ob = ((unsigned)(32 * mt + 4 * (lny >> 5)) * 1024u + 32 * vt + (lny & 31)) * 2u;
#pragma unroll
              for (int r = 0; r < 16; ++r) st_u16(Qg + r0 * 1024 + cb, ob + ((r & 3) + 8 * (r >> 2)) * 2048u, f2bf(o[r])); }
            __syncthreads();
            { float dec[16]; const int lnu = opaque(lane); const LAS float* dp = DEC + 32 * dt + 4 * (lnu >> 5);
#pragma unroll
              for (int r = 0; r < 16; ++r) dec[r] = dp[(r & 3) + 8 * (r >> 2)];
#pragma unroll
              for (int j2 = 0; j2 < 2; ++j2) {
#pragma unroll
                  for (int r = 0; r < 16; ++r) S[j2][r] = dec[r] * (S[j2][r] + dS[j2][r]);
                  LAS unsigned char* sp2 = lds + HA_ST + (32 * (vts + j2) + (lnu & 31)) * PQ + (32 * dt + 4 * (lnu >> 5)) * 2;
#pragma unroll
                  for (int g = 0; g < 4; ++g)
                      *(LAS u32x2*)(sp2 + 16 * g) = (u32x2){pk2(S[j2][4 * g], S[j2][4 * g + 1]), pk2(S[j2][4 * g + 2], S[j2][4 * g + 3])};
              } }
        }
        { const int lns = opaque(lane); float* sp = SEG + (size_t)item * 16384 + (32 * dt + 4 * (lns >> 5)) * 128 + 32 * vts + (lns & 31);
#pragma unroll
            for (int j2 = 0; j2 < 2; ++j2)
#pragma unroll
                for (int r = 0; r < 16; ++r) sp[((r & 3) + 8 * (r >> 2)) * 128 + 32 * j2] = S[j2][r]; }
        if (tq == 0) BSUM[item * 128 + d] = bsum;
    }
}
constexpr int HB_AQ = 0, HB_SIN = 34816, HB_OT = 69632;
__device__ __forceinline__ void hgrn_phaseB(const Params& p, LAS unsigned char* lds, int vb, int G) {
    const int tid = opaque((int)threadIdx.x), lane = tid & 63, wid = __builtin_amdgcn_readfirstlane(tid >> 6);
    const int v = tid & 127, dg = tid >> 7;
    const bf16_t* Zb = (const bf16_t*)(p.ws + WS_R1);
    const bf16_t* OLg = Zb + (size_t)2 * T * 1024; const bf16_t* QSg = Zb + (size_t)3 * T * 1024; const bf16_t* SGB = Zb + (size_t)5 * T * 1024;
    const float* SEG = (const float*)(p.ws + WS_SEG); const float* BSUM = (const float*)(p.ws + WS_BSUM);
    const float* og = p.in[11]; bf16_t* H0 = (bf16_t*)p.out;
    LAS float* OT = (LAS float*)(lds + HB_OT);
    for (int item = vb; item < 256; item += G) {
        const int bh = item >> 2, seg = item & 3, b = bh >> 3, h = bh & 7;
        const size_t row0 = (size_t)b * 2048 + seg * 512; const int cb = h * 128;
        __syncthreads();
        if (seg > 0) {
            const float* S0 = SEG + (size_t)(bh * 4 + 0) * 16384; const float* S1 = S0 + 16384; const float* S2 = S1 + 16384; const float* S3 = S2 + 16384;
            const float* B1 = BSUM + (bh * 4 + 1) * 128; const float* B2 = B1 + 128; const float* B3 = B2 + 128;
#pragma unroll 2
            for (int d0 = dg * 32; d0 < dg * 32 + 32; d0 += 4) { float sv[4];
#pragma unroll
                for (int i = 0; i < 4; ++i) { const int dd = d0 + i; float s = S0[dd * 128 + v];
                    if (seg >= 2) s = __expf(B1[dd]) * s + S1[dd * 128 + v];
                    if (seg >= 3) s = __expf(B2[dd]) * s + S2[dd * 128 + v];
                    sv[i] = s;
                    if (seg == 3) p.out[O_HP + (size_t)bh * 16384 + dd * 128 + v] = __expf(B3[dd]) * s + S3[dd * 128 + v]; }
                *(LAS u32x2*)(lds + HB_SIN + v * PQ + d0 * 2) = (u32x2){pk2(sv[0], sv[1]), pk2(sv[2], sv[3])}; }
        }
        const int prow = tid >> 2, ppart = tid & 3; const int pc0 = cb + 32 * ppart;
        u32x4 aq[4], ol[4], gt[4];
#define HB_LOAD(rt_) do { const size_t rr = row0 + (rt_) * 128; \
            _Pragma("unroll") for (int i = 0; i < 4; ++i) { const int q = tid + i * NTHR; aq[i] = *(const u32x4*)(QSg + (rr + (q >> 4)) * 1024 + cb + (q & 15) * 8); \
                ol[i] = *(const u32x4*)(OLg + (rr + prow) * 1024 + pc0 + 8 * i); gt[i] = *(const u32x4*)(SGB + (rr + prow) * 1024 + pc0 + 8 * i); } } while (0)
        HB_LOAD(0);
        for (int rt = 0; rt < 4; ++rt) {
            const size_t r0 = row0 + rt * 128;
            u32x4 olc[4], gtc[4];
#pragma unroll
            for (int i = 0; i < 4; ++i) { olc[i] = ol[i]; gtc[i] = gt[i]; }
            if (seg > 0) {
#pragma unroll
                for (int i = 0; i < 4; ++i) { const int q = tid + i * NTHR; *(LAS u32x4*)(lds + HB_AQ + (q >> 4) * PQ + (q & 15) * 16) = aq[i]; }
            }
            if (rt < 3) HB_LOAD(rt + 1);
            if (seg > 0) {
                __syncthreads();
                const int mt = wid >> 1, vt0 = (wid & 1) * 2; f32x16 acc0, acc1;
#pragma unroll
                for (int r = 0; r < 16; ++r) { acc0[r] = 0.f; acc1[r] = 0.f; }
#pragma unroll
                for (int ks = 0; ks < 8; ++ks) { const bf16x8 a = ldfrag(lds + HB_AQ, PQ, 32 * mt, 16 * ks, lane), b0 = ldfrag(lds + HB_SIN, PQ, 32 * vt0, 16 * ks, lane), b1 = ldfrag(lds + HB_SIN, PQ, 32 * (vt0 + 1), 16 * ks, lane);
                    acc0 = MFMA32(a, b0, acc0); acc1 = MFMA32(a, b1, acc1); }
                { const int lno = opaque(lane); LAS float* op = OT + (32 * mt + 4 * (lno >> 5)) * 132 + 32 * vt0 + (lno & 31);
#pragma unroll
                  for (int r = 0; r < 16; ++r) { const int tr = (r & 3) + 8 * (r >> 2); op[tr * 132] = acc0[r]; op[tr * 132 + 32] = acc1[r]; } }
                __syncthreads();
            }
            { const size_t grow = r0 + prow;
              float o[32];
#pragma unroll
              for (int i = 0; i < 4; ++i) { const u32x4 w = olc[i];
                  o[8 * i] = bflo(w.x); o[8 * i + 1] = bfhi(w.x); o[8 * i + 2] = bflo(w.y); o[8 * i + 3] = bfhi(w.y); o[8 * i + 4] = bflo(w.z); o[8 * i + 5] = bfhi(w.z); o[8 * i + 6] = bflo(w.w); o[8 * i + 7] = bfhi(w.w); }
              if (seg > 0) {
#pragma unroll
                  for (int i = 0; i < 8; ++i) { const f32x4 x = *(const LAS f32x4*)(OT + prow * 132 + 32 * ppart + 4 * i); o[4 * i] += x.x; o[4 * i + 1] += x.y; o[4 * i + 2] += x.z; o[4 * i + 3] += x.w; } }
              float ss = 0.f;
#pragma unroll
              for (int i = 0; i < 32; ++i) ss += o[i] * o[i];
              ss += __shfl_xor(ss, 1); ss += __shfl_xor(ss, 2);
              const float rs = rsqrtf(ss * (1.f / 128.f) + EPS);
#pragma unroll
              for (int i = 0; i < 4; ++i) { const u32x4 gw = gtc[i];
                  const f32x4 g0 = *(const f32x4*)(og + h * 128 + 32 * ppart + 8 * i), g1 = *(const f32x4*)(og + h * 128 + 32 * ppart + 8 * i + 4);
                  float e[8];
                  e[0] = o[8 * i] * rs * g0.x * bflo(gw.x); e[1] = o[8 * i + 1] * rs * g0.y * bfhi(gw.x); e[2] = o[8 * i + 2] * rs * g0.z * bflo(gw.y); e[3] = o[8 * i + 3] * rs * g0.w * bfhi(gw.y);
                  e[4] = o[8 * i + 4] * rs * g1.x * bflo(gw.z); e[5] = o[8 * i + 5] * rs * g1.y * bfhi(gw.z); e[6] = o[8 * i + 6] * rs * g1.z * bflo(gw.w); e[7] = o[8 * i + 7] * rs * g1.w * bfhi(gw.w);
                  st8(H0 + grow * 2048 + 1024 + pc0 + 8 * i, e); }
            }
        }
#undef HB_LOAD
    }
}

__device__ __forceinline__ void gmlp_simple(const Params& p, LAS unsigned char* lds, int vb, int G, int row_lo) {
    LAS float* smean = (LAS float*)lds; LAS float* srstd = smean + 128;
    const f32x2* VST = (const f32x2*)(p.ws + WS_VST); const bf16_t* GV = (const bf16_t*)p.out; bf16_t* UG = (bf16_t*)(p.ws + WS_UG);
    const float *lg = p.in[15], *lb_ = p.in[16], *wsp = p.in[17], *bs = p.in[18];
    const int tid = opaque((int)threadIdx.x), ch = tid * 4, h = tid >> 6;
    const f32x4 g4 = *(const f32x4*)(lg + ch), b4 = *(const f32x4*)(lb_ + ch);
    for (int r = row_lo + vb; r < T; r += G) {
        int t, cstart;
        if (r < TP) { t = r & 127; cstart = r - t; } else { t = (r - TP) & 7; cstart = r - t; }
        __syncthreads();
        if (tid <= t) { const size_t row = (size_t)(cstart + tid); float s = 0.f, q = 0.f;
            for (int j = 0; j < 32; ++j) { const f32x2 st = VST[row * 32 + j]; s += st.x; q += st.y; }
            const float mean = s * (1.f / 2048.f); const float var = q * (1.f / 2048.f) - mean * mean; smean[tid] = mean; srstd[tid] = rsqrtf(var + EPS); }
        __syncthreads();
        float a0 = 0.f, a1 = 0.f, a2 = 0.f, a3 = 0.f, v0 = 0.f, v1 = 0.f, v2 = 0.f, v3 = 0.f;
        for (int s = 0; s <= t; ++s) {
            const float w = wsp[(size_t)(h * 128 + t) * 128 + s], m = smean[s], rs = srstd[s];
            const u32x2 gvw = *(const u32x2*)(GV + (size_t)(cstart + s) * DC + ch);
            v0 = (bflo(gvw.x) - m) * rs * g4.x + b4.x; v1 = (bfhi(gvw.x) - m) * rs * g4.y + b4.y; v2 = (bflo(gvw.y) - m) * rs * g4.z + b4.z; v3 = (bfhi(gvw.y) - m) * rs * g4.w + b4.w;
            a0 += w * v0; a1 += w * v1; a2 += w * v2; a3 += w * v3;
        }
        const float bias = bs[h * 128 + t];
        const u32x2 ugw = *(const u32x2*)(UG + (size_t)r * DC + ch);
        u32x2 o; o.x = pk2(bflo(ugw.x) * (a0 + bias), bfhi(ugw.x) * (a1 + bias)); o.y = pk2(bflo(ugw.y) * (a2 + bias), bfhi(ugw.y) * (a3 + bias));
        *(u32x2*)(UG + (size_t)r * DC + ch) = o;
        if (r < TP) { const int tt = (r & 2047) - 1920; if (tt >= 0) *(f32x4*)(p.out + O_GP + ((size_t)(r >> 11) * 128 + tt) * DC + ch) = (f32x4){v0, v1, v2, v3}; }
        else *(f32x4*)(p.out + O_GS + (size_t)(r - TP) * DC + ch) = (f32x4){v0, v1, v2, v3};
    }
}


constexpr int GM_W = 0, GM_VT = 34816, GM_MR = 34816 + 69632, GM_PITCH = 272;
__device__ __forceinline__ void gmlp_fast(const Params& p, LAS unsigned char* lds, int vb, int G) {
    LAS float* smean = (LAS float*)(lds + GM_MR); LAS float* srstd = smean + 128;
    const f32x2* VST = (const f32x2*)(p.ws + WS_VST); const bf16_t* GV = (const bf16_t*)p.out; bf16_t* UG = (bf16_t*)(p.ws + WS_UG);
    const float *lg = p.in[15], *lb_ = p.in[16], *wsp = p.in[17], *bs = p.in[18];
    const int tid = opaque((int)threadIdx.x), lane = tid & 63, wid = __builtin_amdgcn_readfirstlane(tid >> 6);
    for (int sitem = vb; sitem < 256; sitem += G) {
        const int chunk = sitem >> 1, hh = (sitem & 1) * 4; const size_t cstart = (size_t)chunk * 128;
        const bool lastchunk = (chunk & 15) == 15; const int bseq = chunk >> 4;
        __syncthreads();
        if (tid < 128) { const f32x4* sp = (const f32x4*)(VST + (cstart + tid) * 32); float s = 0.f, q = 0.f;
#pragma unroll
            for (int j = 0; j < 16; ++j) { const f32x4 a = sp[j]; s += a.x + a.z; q += a.y + a.w; }
            const float mean = s * (1.f / 2048.f); const float var = q * (1.f / 2048.f) - mean * mean; smean[tid] = mean; srstd[tid] = rsqrtf(var + EPS); }
        for (int h = hh; h < hh + 4; ++h) {
            __syncthreads();
            for (int q = tid; q < 4096; q += NTHR) { const int t = q >> 5, s0 = (q & 31) * 4; const f32x4 w = *(const f32x4*)(wsp + (size_t)(h * 128 + t) * 128 + s0);
                u32x2 o; o.x = pk2(s0 <= t ? w.x : 0.f, s0 + 1 <= t ? w.y : 0.f); o.y = pk2(s0 + 2 <= t ? w.z : 0.f, s0 + 3 <= t ? w.w : 0.f);
                *(LAS u32x2*)(lds + GM_W + t * GM_PITCH + s0 * 2) = o; }
            { u32x4 ra[4], rb[4];
#pragma unroll
              for (int it = 0; it < 4; ++it) { const int q = tid + it * NTHR, l = q & 63, wq = q >> 6; const int sp = 16 * (wq & 3) + (l & 15), oc = 4 * (wq >> 2) + (l >> 4);
                  const bf16_t* src = GV + (cstart + 2 * sp) * DC + h * 256 + 8 * oc; ra[it] = *(const u32x4*)src; rb[it] = *(const u32x4*)(src + DC); }
#pragma unroll
              for (int it = 0; it < 4; ++it) { const int q = tid + it * NTHR, l = q & 63, wq = q >> 6; const int sp = 16 * (wq & 3) + (l & 15), oc = 4 * (wq >> 2) + (l >> 4);
                  const int col = h * 256 + 8 * oc; const f32x4 ga = *(const f32x4*)(lg + col), gb = *(const f32x4*)(lg + col + 4), ba = *(const f32x4*)(lb_ + col), bb = *(const f32x4*)(lb_ + col + 4);
                  const float m0 = smean[2 * sp], r0s = srstd[2 * sp], m1 = smean[2 * sp + 1], r1s = srstd[2 * sp + 1];
                  float x[8], y[8];
                  x[0] = (bflo(ra[it].x) - m0) * r0s * ga.x + ba.x; x[1] = (bfhi(ra[it].x) - m0) * r0s * ga.y + ba.y; x[2] = (bflo(ra[it].y) - m0) * r0s * ga.z + ba.z; x[3] = (bfhi(ra[it].y) - m0) * r0s * ga.w + ba.w;
                  x[4] = (bflo(ra[it].z) - m0) * r0s * gb.x + bb.x; x[5] = (bfhi(ra[it].z) - m0) * r0s * gb.y + bb.y; x[6] = (bflo(ra[it].w) - m0) * r0s * gb.z + bb.z; x[7] = (bfhi(ra[it].w) - m0) * r0s * gb.w + bb.w;
                  y[0] = (bflo(rb[it].x) - m1) * r1s * ga.x + ba.x; y[1] = (bfhi(rb[it].x) - m1) * r1s * ga.y + ba.y; y[2] = (bflo(rb[it].y) - m1) * r1s * ga.z + ba.z; y[3] = (bfhi(rb[it].y) - m1) * r1s * ga.w + ba.w;
                  y[4] = (bflo(rb[it].z) - m1) * r1s * gb.x + bb.x; y[5] = (bfhi(rb[it].z) - m1) * r1s * gb.y + bb.y; y[6] = (bflo(rb[it].w) - m1) * r1s * gb.z + bb.z; y[7] = (bfhi(rb[it].w) - m1) * r1s * gb.w + bb.w;
                  LAS unsigned char* vp = lds + GM_VT + (8 * oc) * GM_PITCH + sp * 4;
#pragma unroll
                  for (int e = 0; e < 8; ++e) *(LAS unsigned*)(vp + e * GM_PITCH) = pk2(x[e], y[e]);
                  if (lastchunk) { float* o = p.out + O_GP + ((size_t)bseq * 128 + 2 * sp) * DC + col;
                      *(f32x4*)o = (f32x4){x[0], x[1], x[2], x[3]}; *(f32x4*)(o + 4) = (f32x4){x[4], x[5], x[6], x[7]};
                      *(f32x4*)(o + DC) = (f32x4){y[0], y[1], y[2], y[3]}; *(f32x4*)(o + DC + 4) = (f32x4){y[4], y[5], y[6], y[7]}; }
              } }
            __syncthreads();
            f32x16 acc[4];
#pragma unroll
            for (int mt = 0; mt < 4; ++mt)
#pragma unroll
                for (int r = 0; r < 16; ++r) acc[mt][r] = 0.f;
#pragma unroll
            for (int ks = 0; ks < 8; ++ks) { const bf16x8 b = ldfrag(lds + GM_VT, GM_PITCH, 32 * wid, 16 * ks, lane);
#pragma unroll
                for (int mt = 0; mt < 4; ++mt) if (ks < 2 * (mt + 1)) { const bf16x8 a = ldfrag(lds + GM_W, GM_PITCH, 32 * mt, 16 * ks, lane); acc[mt] = MFMA32(a, b, acc[mt]); } }
            u32x4 ugv[8];
#pragma unroll
            for (int it = 0; it < 8; ++it) { const int q = tid + it * NTHR; ugv[it] = *(const u32x4*)(UG + (cstart + (q >> 5)) * DC + h * 256 + 8 * (q & 31)); }
            __syncthreads();
            { const int lnm = opaque(lane); LAS unsigned char* mp = lds + GM_VT + (4 * (lnm >> 5)) * 528 + (32 * wid + (lnm & 31)) * 2; const float* bp = bs + h * 128 + 4 * (lnm >> 5);
#pragma unroll
              for (int mt = 0; mt < 4; ++mt)
#pragma unroll
                  for (int r = 0; r < 16; ++r) { const int tr = 32 * mt + (r & 3) + 8 * (r >> 2); *(LAS bf16_t*)(mp + tr * 528) = (bf16_t)f2bf(acc[mt][r] + bp[tr]); } }
            __syncthreads();
#pragma unroll
            for (int it = 0; it < 8; ++it) { const int q = tid + it * NTHR; const int t = q >> 5, oc = q & 31;
                const u32x4 m = *(const LAS u32x4*)(lds + GM_VT + t * 528 + oc * 16); const u32x4 u = ugv[it]; u32x4 o;
                o.x = pk2(bflo(u.x) * bflo(m.x), bfhi(u.x) * bfhi(m.x)); o.y = pk2(bflo(u.y) * bflo(m.y), bfhi(u.y) * bfhi(m.y));
                o.z = pk2(bflo(u.z) * bflo(m.z), bfhi(u.z) * bfhi(m.z)); o.w = pk2(bflo(u.w) * bflo(m.w), bfhi(u.w) * bfhi(m.w));
                *(u32x4*)(UG + (cstart + t) * DC + h * 256 + 8 * oc) = o; }
        }
    }
}


__device__ __forceinline__ void gmlp_sample(const Params& p, LAS unsigned char* lds, int vb, int G) {
    LAS float* smean = (LAS float*)(lds + GM_MR); LAS float* srstd = smean + 128;
    const f32x2* VST = (const f32x2*)(p.ws + WS_VST); const bf16_t* GV = (const bf16_t*)p.out; bf16_t* UG = (bf16_t*)(p.ws + WS_UG);
    const float *lg = p.in[15], *lb_ = p.in[16], *wsp = p.in[17], *bs = p.in[18];
    const int tid = opaque((int)threadIdx.x), ch = tid * 4; const int h = __builtin_amdgcn_readfirstlane(tid >> 6);
    const f32x4 g4 = *(const f32x4*)(lg + ch), b4 = *(const f32x4*)(lb_ + ch);
    for (int sb = vb; sb < 128; sb += G) {
        const size_t r0 = (size_t)TP + sb * 8;
        __syncthreads();
        if (tid < 64) { const int t = tid >> 3, q = tid & 7; const f32x4* sp = (const f32x4*)(VST + (r0 + t) * 32 + q * 4); const f32x4 a = sp[0], b = sp[1];
            float s_ = (a.x + a.z) + (b.x + b.z), q_ = (a.y + a.w) + (b.y + b.w);
            s_ += __shfl_xor(s_, 1); q_ += __shfl_xor(q_, 1); s_ += __shfl_xor(s_, 2); q_ += __shfl_xor(q_, 2); s_ += __shfl_xor(s_, 4); q_ += __shfl_xor(q_, 4);
            const float mean = s_ * (1.f / 2048.f); const float var = q_ * (1.f / 2048.f) - mean * mean;
            if (q == 0) { smean[t] = mean; srstd[t] = rsqrtf(var + EPS); } }
        u32x2 gvw[8], ugw[8];
#pragma unroll
        for (int t = 0; t < 8; ++t) { gvw[t] = *(const u32x2*)(GV + (r0 + t) * DC + ch); ugw[t] = *(const u32x2*)(UG + (r0 + t) * DC + ch); }
        __syncthreads();
        float vn[8][4];
#pragma unroll
        for (int sx = 0; sx < 8; ++sx) { const float m = smean[sx], rs = srstd[sx];
            vn[sx][0] = (bflo(gvw[sx].x) - m) * rs * g4.x + b4.x; vn[sx][1] = (bfhi(gvw[sx].x) - m) * rs * g4.y + b4.y; vn[sx][2] = (bflo(gvw[sx].y) - m) * rs * g4.z + b4.z; vn[sx][3] = (bfhi(gvw[sx].y) - m) * rs * g4.w + b4.w; }
#pragma unroll
        for (int t = 0; t < 8; ++t) { const float bias = bs[h * 128 + t]; float a0 = bias, a1 = bias, a2 = bias, a3 = bias;
#pragma unroll
            for (int sx = 0; sx <= t; ++sx) { const float w = wsp[(size_t)(h * 128 + t) * 128 + sx]; a0 += w * vn[sx][0]; a1 += w * vn[sx][1]; a2 += w * vn[sx][2]; a3 += w * vn[sx][3]; }
            u32x2 o; o.x = pk2(bflo(ugw[t].x) * a0, bfhi(ugw[t].x) * a1); o.y = pk2(bflo(ugw[t].y) * a2, bfhi(ugw[t].y) * a3);
            *(u32x2*)(UG + (r0 + t) * DC + ch) = o;
            *(f32x4*)(p.out + O_GS + ((size_t)sb * 8 + t) * DC + ch) = (f32x4){vn[t][0], vn[t][1], vn[t][2], vn[t][3]}; }
    }
}

__device__ __forceinline__ void final_norm(const Params& p, int vb, int G) {
    const int tid = opaque((int)threadIdx.x), lane = tid & 63, wave = tid >> 6;
    const int gw = vb * NWAVES + wave, NGW = G * NWAVES;
    const float* SSP = (const float*)(p.ws + WS_SSP2); const float* g = p.in[20];
    f32x4 gg[4];
#pragma unroll
    for (int j = 0; j < 4; ++j) gg[j] = ((const f32x4*)g)[lane + 64 * j];
    for (int r = gw; r < T; r += 2 * NGW) {
        const int r2 = (r + NGW < T) ? r + NGW : r;
        f32x4* y = (f32x4*)(p.out + (size_t)r * D) + lane; f32x4* y2 = (f32x4*)(p.out + (size_t)r2 * D) + lane;
        f32x4 v[4], w[4];
#pragma unroll
        for (int j = 0; j < 4; ++j) { v[j] = y[64 * j]; w[j] = y2[64 * j]; }
        float rs, rs2;
        { const f32x4* s = (const f32x4*)(SSP + (size_t)r * 16); const f32x4 a = s[0], b = s[1], c = s[2], d = s[3];
          rs = rsqrtf((((a.x + a.y) + (a.z + a.w)) + ((b.x + b.y) + (b.z + b.w)) + ((c.x + c.y) + (c.z + c.w)) + ((d.x + d.y) + (d.z + d.w))) * (1.f / 1024.f) + EPS); }
        { const f32x4* s = (const f32x4*)(SSP + (size_t)r2 * 16); const f32x4 a = s[0], b = s[1], c = s[2], d = s[3];
          rs2 = rsqrtf((((a.x + a.y) + (a.z + a.w)) + ((b.x + b.y) + (b.z + b.w)) + ((c.x + c.y) + (c.z + c.w)) + ((d.x + d.y) + (d.z + d.w))) * (1.f / 1024.f) + EPS); }
#pragma unroll
        for (int j = 0; j < 4; ++j) { f32x4 o = v[j]; o.x *= rs * gg[j].x; o.y *= rs * gg[j].y; o.z *= rs * gg[j].z; o.w *= rs * gg[j].w; y[64 * j] = o; }
        if (r2 != r) {
#pragma unroll
            for (int j = 0; j < 4; ++j) { f32x4 o = w[j]; o.x *= rs2 * gg[j].x; o.y *= rs2 * gg[j].y; o.z *= rs2 * gg[j].z; o.w *= rs2 * gg[j].w; y2[64 * j] = o; } }
    }
}

__global__ void __launch_bounds__(NTHR, 2) fwd_kernel(Params p) {
    extern __shared__ __attribute__((aligned(16))) unsigned char lds_raw[];
    LAS unsigned char* lds = (LAS unsigned char*)lds_raw;
    { volatile LAS unsigned* st0 = (volatile LAS unsigned*)(lds + LDS_BYTES - 64); if (threadIdx.x < 16) st0[threadIdx.x] = 0u; }
    __syncthreads();
    const XcdBarrier bar = xcd_barrier_post((unsigned*)p.ws, (volatile LAS unsigned*)(lds + LDS_BYTES - 64));
    const int G = gridDim.x, vb = blockIdx.x;
    unsigned long long stamps[16];
#define STAMP(k) do { if (PROBE_A >= 0) stamps[k] = __builtin_amdgcn_s_memrealtime(); } while (0)
    STAMP(0);
    bf16_t* WT1 = (bf16_t*)(p.ws + WS_WT1); bf16_t* WT2 = (bf16_t*)(p.ws + WS_WT2); bf16_t* WT3 = (bf16_t*)(p.ws + WS_WT3); bf16_t* WT4 = (bf16_t*)(p.ws + WS_WT4);
    bf16_t* ZR = (bf16_t*)(p.ws + WS_R1);

    phase0(p, lds, vb, G);
    xcd_barrier(bar); STAMP(1);
    { Epi1 E{ZR, (const float*)(p.ws + WS_LB)}; GEMM(lds, (const bf16_t*)p.out, WT1, TP, N1, D, E, vb, G); gemm_small<Epi1, 1>(lds, (const bf16_t*)p.out + (size_t)TP * D, WT1, N1, D, E, TP, vb, G); }
    xcd_barrier(bar); STAMP(2);
    hgrn_phaseA(p, lds, vb, G); STAMP(10);
    hgrn_sample(p, lds, vb, G); STAMP(11);
    conv_fast(p, lds, vb, G); STAMP(12);
    xcd_barrier(bar); STAMP(3);
    hgrn_phaseB(p, lds, vb, G);
    xcd_barrier(bar); STAMP(4);
    { Epi2 E{p.in[0], p.in[1], (float*)(p.ws + WS_X1), (bf16_t*)(p.ws + WS_X1B), (float*)(p.ws + WS_SSP1)}; GEMM(lds, (const bf16_t*)p.out, WT2, TP, D, 2048, E, vb, G); gemm_small<Epi2, 8>(lds, (const bf16_t*)p.out + (size_t)TP * 2048, WT2, D, 2048, E, TP, vb, G); }
    xcd_barrier(bar); STAMP(5);
    { Epi3 E{(const float*)(p.ws + WS_SSP1), (bf16_t*)(p.ws + WS_UG), (bf16_t*)p.out, (f32x2*)(p.ws + WS_VST)}; GEMM(lds, (const bf16_t*)(p.ws + WS_X1B), WT3, TP, N3, D, E, vb, G); gemm_small<Epi3, 1>(lds, (const bf16_t*)(p.ws + WS_X1B) + (size_t)TP * D, WT3, N3, D, E, TP, vb, G); }
    xcd_barrier(bar); STAMP(6);
    gmlp_fast(p, lds, vb, G); STAMP(13);
    gmlp_sample(p, lds, vb, G);
    xcd_barrier(bar); STAMP(7);
    { Epi4 E{(const float*)(p.ws + WS_X1), p.out, (float*)(p.ws + WS_SSP2)}; GEMM(lds, (const bf16_t*)(p.ws + WS_UG), WT4, TP, D, 2048, E, vb, G); gemm_small<Epi4, 8>(lds, (const bf16_t*)(p.ws + WS_UG) + (size_t)TP * 2048, WT4, D, 2048, E, TP, vb, G); }
    xcd_barrier(bar); STAMP(8);
    final_norm(p, vb, G);
    STAMP(9);
    if (PROBE_A >= 0 && blockIdx.x == 0 && threadIdx.x == 0) {
#ifdef PROBE_EXPR
        const unsigned long long da = PROBE_EXPR;
#else
        const unsigned long long da = stamps[PROBE_B] - stamps[PROBE_A];
#endif
        const unsigned long long wait = 8ull * da, t0 = __builtin_amdgcn_s_memrealtime();
        while (__builtin_amdgcn_s_memrealtime() - t0 < wait) __builtin_amdgcn_s_sleep(32);
    }
}

extern "C" void kernel_launch(void* const* d_in, const int* in_sizes, int n_in, void* d_out, int out_size, void* d_ws, size_t ws_size, hipStream_t stream) {
    static int grid = 0;
    if (grid == 0) {
        if (n_in != 21 || (size_t)out_size != O_END || ws_size < WS_END) { fprintf(stderr, "kernel_launch: unexpected shapes: n_in %d out %d ws %zu\n", n_in, out_size, ws_size); grid = -1; return; }
        int dev = 0, cus = 0, per_cu = 0;
        if (hipGetDevice(&dev) != hipSuccess || hipDeviceGetAttribute(&cus, hipDeviceAttributeMultiprocessorCount, dev) != hipSuccess) { grid = -1; return; }
        if (hipFuncSetAttribute((const void*)fwd_kernel, hipFuncAttributeMaxDynamicSharedMemorySize, LDS_BYTES) != hipSuccess) { fprintf(stderr, "kernel_launch: hipFuncSetAttribute failed\n"); grid = -1; return; }
        if (hipOccupancyMaxActiveBlocksPerMultiprocessor(&per_cu, (const void*)fwd_kernel, NTHR, LDS_BYTES) != hipSuccess || per_cu < 1) { fprintf(stderr, "kernel_launch: occupancy query says %d\n", per_cu); grid = -1; return; }
        grid = cus;
    }
    if (grid < 0) return;
    if (hipMemsetAsync(d_ws, 0, 16384, stream) != hipSuccess) { fprintf(stderr, "kernel_launch: memset failed\n"); return; }
    Params p{};
    for (int i = 0; i < 21; ++i) p.in[i] = (const float*)d_in[i];
    p.out = (float*)d_out; p.ws = (unsigned char*)d_ws;
    void* args[] = {&p};
    hipError_t e = hipLaunchCooperativeKernel((const void*)fwd_kernel, dim3(grid), dim3(NTHR), args, LDS_BYTES, stream);
    if (e != hipSuccess) fprintf(stderr, "kernel_launch: cooperative launch failed: %s (grid %d)\n", hipGetErrorString(e), grid);
}
```

```cpp
#include <hip/hip_runtime.h>
#include <cstdio>
#include <cstdint>

#ifndef PROBE_A
#define PROBE_A -1
#define PROBE_B -1
#endif
#ifndef FAST_GEMM
#define FAST_GEMM 1
#endif

#define LAS __attribute__((address_space(3)))
typedef unsigned short bf16_t;
typedef short bf16x8 __attribute__((ext_vector_type(8)));
typedef float f32x4 __attribute__((ext_vector_type(4)));
typedef float f32x2 __attribute__((ext_vector_type(2)));
typedef unsigned u32x4 __attribute__((ext_vector_type(4)));
typedef unsigned u32x2 __attribute__((ext_vector_type(2)));

constexpr int D = 1024, TP = 16384, TS = 1024, T = TP + TS;
constexpr int N1 = 7168, N3 = 6144, DC = 2048;
constexpr float EPS = 1e-6f;
constexpr int NWAVES = 8, NTHR = 512;
constexpr int LDS_BYTES = 147456;
constexpr size_t MiB = (size_t)1 << 20;
constexpr size_t WS_LB = 65536;
constexpr size_t WS_WT1 = 1 * MiB, WS_WT2 = 15 * MiB, WS_WT3 = 19 * MiB, WS_WT4 = 31 * MiB;
constexpr size_t WS_R1 = 35 * MiB;
constexpr size_t WS_X1 = WS_R1, WS_X1B = WS_R1 + 68 * MiB, WS_UG = WS_R1 + 102 * MiB;
constexpr size_t WS_SSP1 = WS_R1 + 170 * MiB, WS_VST = WS_R1 + 172 * MiB, WS_SSP2 = WS_R1 + 178 * MiB;
constexpr size_t WS_SEG = 239 * MiB;
constexpr size_t WS_END = 255 * MiB;
constexpr size_t O_YP = 0, O_YS = 16777216, O_CP = 17825792, O_HP = 18071552, O_GP = 19120128, O_CS = 21217280, O_HS = 25149440, O_GS = 41926656, O_END = 44023808;

struct Params { const float* in[21]; float* out; unsigned char* ws; };

__device__ __forceinline__ int opaque(int x) { asm volatile("" : "+v"(x)); return x; }
__device__ __forceinline__ float bf2f(unsigned b) { return __uint_as_float(b << 16); }
__device__ __forceinline__ float bflo(unsigned w) { return __uint_as_float(w << 16); }
__device__ __forceinline__ float bfhi(unsigned w) { return __uint_as_float(w & 0xffff0000u); }
__device__ __forceinline__ unsigned f2bf(float f) { unsigned u = __float_as_uint(f); return (u + 0x7fffu + ((u >> 16) & 1u)) >> 16; }
__device__ __forceinline__ unsigned pk2(float lo, float hi) { return f2bf(lo) | (f2bf(hi) << 16); }
__device__ __forceinline__ float sigm(float x) { return 1.0f / (1.0f + __expf(-x)); }
__device__ __forceinline__ float silu(float x) { return x * sigm(x); }
__device__ __forceinline__ float gelu_t(float x) { return x * sigm(1.5957691216057308f * (x + 0.044715f * x * x * x)); }
__device__ __forceinline__ float wave_sum(float v) {
#pragma unroll
    for (int o = 1; o < 64; o <<= 1) v += __shfl_xor(v, o);
    return v;
}
__device__ __forceinline__ void st8(bf16_t* p, const float (&v)[8]) {
    u32x4 w; w.x = pk2(v[0], v[1]); w.y = pk2(v[2], v[3]); w.z = pk2(v[4], v[5]); w.w = pk2(v[6], v[7]); *(u32x4*)p = w;
}
__device__ __forceinline__ float block_sum(float v, LAS float* red) {
    v = wave_sum(v);
    __syncthreads();
    if ((threadIdx.x & 63) == 0) red[threadIdx.x >> 6] = v;
    __syncthreads();
    float s = 0.f;
#pragma unroll
    for (int i = 0; i < 8; ++i) s += red[i];
    return s;
}


typedef __attribute__((address_space(1))) unsigned gu32;
#define XB_TMO      128
#define XB_XCNT(j)  (256  + 64 * (j))
#define XB_XSUB(j)  (1280 + 64 * (j))
#define XB_XGEN(j)  (2304 + 64 * (j))
#define XB_TOP      3328
#define XB_TOPGEN   3392
#define XCD_BAR_WORDS 3456
#define XB_SPIN_CAP (1u << 20)

__device__ __forceinline__ unsigned xb_ld(unsigned* p)              { return __hip_atomic_load(p, __ATOMIC_RELAXED, __HIP_MEMORY_SCOPE_AGENT); }
__device__ __forceinline__ unsigned xb_add(unsigned* p, unsigned v) { return __hip_atomic_fetch_add(p, v, __ATOMIC_RELAXED, __HIP_MEMORY_SCOPE_AGENT); }
__device__ __forceinline__ unsigned xb_xcc_id() { return (unsigned)__builtin_amdgcn_s_getreg((3 << 11) | 20) & 0xFu; }
#define XB_SPIN(cond, bar) do { unsigned _sp = 0; while (cond) { __builtin_amdgcn_s_sleep(1); \
    if ((++_sp & 255u) == 0u) { if (xb_ld(&(bar)[XB_TMO])) break; if (_sp > XB_SPIN_CAP) { atomicAdd(&(bar)[XB_TMO], 1u); break; } } } } while (0)

struct XcdBarrier {
    unsigned* bar; unsigned x;
    volatile LAS unsigned* st;
};

__device__ __forceinline__ XcdBarrier xcd_barrier_post(unsigned* bar, volatile LAS unsigned* st) {
    XcdBarrier b; b.bar = bar; b.x = xb_xcc_id(); b.st = st;
    if (threadIdx.x == 0) (void)xb_add(&bar[XB_XCNT(b.x)], 1u);
    return b;
}
__device__ __forceinline__ void xcd_barrier_complete(unsigned* bar, unsigned x, unsigned& nloc, unsigned& nx) {
    const unsigned G = gridDim.x * gridDim.y * gridDim.z;
    unsigned sum, cnt, mine, sp = 0u;
    for (;;) {
        sum = 0u; cnt = 0u; mine = 0u;
#pragma unroll
        for (unsigned j = 0; j < 16; ++j) { const unsigned c = xb_ld(&bar[XB_XCNT(j)]); sum += c; cnt += (c > 0u) ? 1u : 0u; mine = (j == x) ? c : mine; }
        if (sum == G) break;
        __builtin_amdgcn_s_sleep(1);
        if ((++sp & 255u) == 0u) { if (xb_ld(&bar[XB_TMO])) break; if (sp > XB_SPIN_CAP) { atomicAdd(&bar[XB_TMO], 1u); break; } }
    }
    nloc = mine > 0u ? mine : 1u; nx = cnt > 0u ? cnt : 1u;
}

__device__ __forceinline__ void xcd_barrier(const XcdBarrier& b) {
    asm volatile("s_waitcnt vmcnt(0)" ::: "memory");
    __syncthreads();
    if (threadIdx.x == 0) {
        unsigned* bar = b.bar;
        __builtin_amdgcn_s_waitcnt(0);
        unsigned nloc = b.st[0], nx = b.st[1];
        if (nloc == 0u) { xcd_barrier_complete(bar, b.x, nloc, nx); b.st[0] = nloc; b.st[1] = nx; }
        const unsigned old = xb_add(&bar[XB_XSUB(b.x)], 1u);
        const unsigned gen = old / nloc;
        if (old + 1u == (gen + 1u) * nloc) {
            __builtin_amdgcn_fence(__ATOMIC_RELEASE, "agent");
            asm volatile("s_waitcnt vmcnt(0)" ::: "memory");
            const unsigned og = xb_add(&bar[XB_TOP], 1u);
            const unsigned tg = og / nx;
            if (og + 1u == (tg + 1u) * nx) xb_add(&bar[XB_TOPGEN], 1u);
            else XB_SPIN(xb_ld(&bar[XB_TOPGEN]) == tg, bar);
            __builtin_amdgcn_fence(__ATOMIC_ACQUIRE, "agent");
            xb_add(&bar[XB_XGEN(b.x)], 1u);
            asm volatile("s_waitcnt vmcnt(0)" ::: "memory");
        } else {
            XB_SPIN(xb_ld(&bar[XB_XGEN(b.x)]) == gen, bar);
            __builtin_amdgcn_fence(__ATOMIC_ACQUIRE, "agent");
            asm volatile("s_waitcnt vmcnt(0)" ::: "memory");
        }
    }
    __syncthreads();
}

template <int MAP> __device__ __forceinline__ int vmap(int vc) {
    const int vt = vc >> 8, c = vc & 255;
    if (MAP == 1) return vt < 8 ? (c < 128 ? 128 * vt + c : 1024 + 128 * vt + (c - 128)) : vc;
    if (MAP == 3) return vt < 16 ? (c < 128 ? 128 * vt + c : 4096 + 128 * vt + (c - 128)) : vc - 2048;
    return vc;
}

template <int MAP> __device__ __forceinline__ void transpose_item(const float* W, int K, int N, bf16_t* WT, const float* kscale, LAS float* scr, int item, int lane) {
    const int nblk = N / 32, kb = item / nblk, nb = item % nblk, k0 = 64 * kb, n0 = 32 * nb;
    const int on0 = vmap<MAP>(n0);
#pragma unroll 8
    for (int i = 0; i < 32; ++i) { const int kk = 2 * i + (lane >> 5); float w = W[(size_t)(k0 + kk) * N + on0 + (lane & 31)]; if (kscale) w *= kscale[k0 + kk]; scr[kk * 33 + (lane & 31)] = w; }
    asm volatile("s_waitcnt lgkmcnt(0)" ::: "memory");
    const int c = lane & 7;
#pragma unroll
    for (int j = 0; j < 4; ++j) { const int n = (lane >> 3) + 8 * j; const LAS float* s = scr + (8 * c) * 33 + n;
        u32x4 o; o.x = pk2(s[0 * 33], s[1 * 33]); o.y = pk2(s[2 * 33], s[3 * 33]); o.z = pk2(s[4 * 33], s[5 * 33]); o.w = pk2(s[6 * 33], s[7 * 33]);
        *(u32x4*)(WT + (size_t)(n0 + n) * K + k0 + 8 * c) = o; }
    asm volatile("s_waitcnt lgkmcnt(0)" ::: "memory");
}
__device__ __forceinline__ void rms_row_to_bf16(const float* xrow, const float* g, bf16_t* orow, int lane) {
    const f32x4* xr = (const f32x4*)xrow + lane; f32x4 v[4]; float s = 0.f;
#pragma unroll
    for (int j = 0; j < 4; ++j) { v[j] = xr[64 * j]; s += (v[j].x * v[j].x + v[j].y * v[j].y) + (v[j].z * v[j].z + v[j].w * v[j].w); }
    const float rs = rsqrtf(wave_sum(s) * (1.f / 1024.f) + EPS);
    u32x2* o8 = (u32x2*)orow + lane;
#pragma unroll
    for (int j = 0; j < 4; ++j) { const f32x4 gg = ((const f32x4*)g)[lane + 64 * j]; u32x2 w; w.x = pk2(v[j].x * rs * gg.x, v[j].y * rs * gg.y); w.y = pk2(v[j].z * rs * gg.z, v[j].w * rs * gg.w); o8[64 * j] = w; }
}
__device__ __forceinline__ void phase0(const Params& p, LAS unsigned char* lds, int vb, int G) {
    const int tid = opaque((int)threadIdx.x), lane = tid & 63, wave = tid >> 6;
    const int gw = vb * NWAVES + wave, NGW = G * NWAVES;
    float* LB = (float*)(p.ws + WS_LB);
    for (int i = vb * NTHR + tid; i < 1024; i += G * NTHR) { const float l0 = p.in[10][i], l1 = p.in[10][1024 + i]; LB[i] = 1.0f / (1.0f + __expf(l1 - l0)); }
    LAS float* scr = (LAS float*)(lds + wave * 16384);
    constexpr int I1 = (D / 64) * (N1 / 32), I2 = (2048 / 64) * (D / 32), I3 = (D / 64) * (N3 / 32), I4 = I2;
    for (int it = gw; it < I1 + I2 + I3 + I4; it += NGW) {
        int r = it;
        if (r < I1) { transpose_item<1>(p.in[5], D, N1, (bf16_t*)(p.ws + WS_WT1), nullptr, scr, r, lane); continue; } r -= I1;
        if (r < I2) { transpose_item<0>(p.in[12], 2048, D, (bf16_t*)(p.ws + WS_WT2), nullptr, scr, r, lane); continue; } r -= I2;
        if (r < I3) { transpose_item<3>(p.in[14], D, N3, (bf16_t*)(p.ws + WS_WT3), p.in[13], scr, r, lane); continue; } r -= I3;
        transpose_item<0>(p.in[19], 2048, D, (bf16_t*)(p.ws + WS_WT4), nullptr, scr, r, lane);
    }
    bf16_t* XN0 = (bf16_t*)p.out;
    for (int r = gw; r < T; r += NGW) { const float* xr = r < TP ? p.in[0] + (size_t)r * D : p.in[1] + (size_t)(r - TP) * D; rms_row_to_bf16(xr, p.in[4], XN0 + (size_t)r * D, lane); }
}

struct Epi1 {
    bf16_t* Z; const float* LB;
    __device__ __forceinline__ float rowscale(int) const { return 1.f; }
    template <int X1M, int X2M> __device__ __forceinline__ void tile8(int row, int pn, int c0, const float (&lo)[8], const float (&hi)[8], float) const {
        if (pn < 8) { float a[8];
#pragma unroll
            for (int i = 0; i < 8; ++i) a[i] = lo[i] * sigm(hi[i]);
            st8(Z + (size_t)row * 1024 + 128 * pn + c0, a);
        } else {
            const int g = (pn - 8) >> 2, col = ((pn - 8) & 3) * 256 + c0;
            bf16_t* base = Z + (size_t)(g + 1) * T * 1024 + (size_t)row * 1024 + col;
            float x[8], y[8];
            if (g == 1) {
#pragma unroll
                for (int i = 0; i < 8; ++i) { x[i] = lo[i]; y[i] = hi[i]; }
            } else if (g == 2) {
#pragma unroll
                for (int i = 0; i < 8; ++i) { const float l0 = LB[col + i], l1 = LB[col + 128 + i]; x[i] = __logf(l0 + (1.f - l0) * sigm(lo[i])); y[i] = __logf(l1 + (1.f - l1) * sigm(hi[i])); }
            } else {
#pragma unroll
                for (int i = 0; i < 8; ++i) { x[i] = silu(lo[i]); y[i] = silu(hi[i]); }
            }
            st8(base, x); st8(base + 128, y);
        }
    }
};
struct Epi2 {
    const float* xp; const float* xs; float* X1; bf16_t* X1B; float* SSP;
    __device__ __forceinline__ float rowscale(int) const { return 1.f; }
    template <int X1M, int X2M> __device__ __forceinline__ void tile8(int row, int pn, int c0, const float (&lo)[8], const float (&hi)[8], float) const {
        const int col = 256 * pn + c0;
        const float* xr = (row < TP ? xp + (size_t)row * D : xs + (size_t)(row - TP) * D) + col;
        const f32x4 a0 = *(const f32x4*)xr, a1 = *(const f32x4*)(xr + 4), b0 = *(const f32x4*)(xr + 128), b1 = *(const f32x4*)(xr + 132);
        float v[8], w[8];
        v[0] = a0.x + lo[0]; v[1] = a0.y + lo[1]; v[2] = a0.z + lo[2]; v[3] = a0.w + lo[3]; v[4] = a1.x + lo[4]; v[5] = a1.y + lo[5]; v[6] = a1.z + lo[6]; v[7] = a1.w + lo[7];
        w[0] = b0.x + hi[0]; w[1] = b0.y + hi[1]; w[2] = b0.z + hi[2]; w[3] = b0.w + hi[3]; w[4] = b1.x + hi[4]; w[5] = b1.y + hi[5]; w[6] = b1.z + hi[6]; w[7] = b1.w + hi[7];
        float* o = X1 + (size_t)row * D + col;
        *(f32x4*)o = (f32x4){v[0], v[1], v[2], v[3]}; *(f32x4*)(o + 4) = (f32x4){v[4], v[5], v[6], v[7]};
        *(f32x4*)(o + 128) = (f32x4){w[0], w[1], w[2], w[3]}; *(f32x4*)(o + 132) = (f32x4){w[4], w[5], w[6], w[7]};
        bf16_t* ob = X1B + (size_t)row * D + col; st8(ob, v); st8(ob + 128, w);
        float ss = 0.f;
#pragma unroll
        for (int i = 0; i < 8; ++i) ss += v[i] * v[i] + w[i] * w[i];
        ss += __shfl_xor(ss, X1M); ss += __shfl_xor(ss, X2M);
        if ((c0 & 31) == 0) SSP[(size_t)row * 16 + pn * 4 + (c0 >> 5)] = ss;
    }
};
struct Epi3 {
    const float* SSP1; bf16_t* UG; bf16_t* GV; f32x2* VST;
    __device__ __forceinline__ float rowscale(int row) const {
        const f32x4* s = (const f32x4*)(SSP1 + (size_t)row * 16); const f32x4 a = s[0], b = s[1], c = s[2], d = s[3];
        const float t = ((a.x + a.y) + (a.z + a.w)) + ((b.x + b.y) + (b.z + b.w)) + ((c.x + c.y) + (c.z + c.w)) + ((d.x + d.y) + (d.z + d.w));
        return rsqrtf(t * (1.f / 1024.f) + EPS);
    }
    template <int X1M, int X2M> __device__ __forceinline__ void tile8(int row, int pn, int c0, const float (&lo)[8], const float (&hi)[8], float rs) const {
        if (pn < 16) { float a[8];
#pragma unroll
            for (int i = 0; i < 8; ++i) a[i] = gelu_t(lo[i] * rs) * silu(hi[i] * rs);
            st8(UG + (size_t)row * DC + 128 * pn + c0, a);
        } else {
            const int col = 256 * (pn - 16) + c0; float x[8], y[8], s = 0.f, q = 0.f;
#pragma unroll
            for (int i = 0; i < 8; ++i) { x[i] = gelu_t(lo[i] * rs); y[i] = gelu_t(hi[i] * rs); s += x[i] + y[i]; q += x[i] * x[i] + y[i] * y[i]; }
            bf16_t* o = GV + (size_t)row * DC + col; st8(o, x); st8(o + 128, y);
            s += __shfl_xor(s, X1M); q += __shfl_xor(q, X1M); s += __shfl_xor(s, X2M); q += __shfl_xor(q, X2M);
            if ((c0 & 31) == 0) VST[(size_t)row * 32 + (pn - 16) * 4 + (c0 >> 5)] = (f32x2){s, q};
        }
    }
};
struct Epi4 {
    const float* X1; float* Y; float* SSP;
    __device__ __forceinline__ float rowscale(int) const { return 1.f; }
    template <int X1M, int X2M> __device__ __forceinline__ void tile8(int row, int pn, int c0, const float (&lo)[8], const float (&hi)[8], float) const {
        const int col = 256 * pn + c0;
        const float* xr = X1 + (size_t)row * D + col;
        const f32x4 a0 = *(const f32x4*)xr, a1 = *(const f32x4*)(xr + 4), b0 = *(const f32x4*)(xr + 128), b1 = *(const f32x4*)(xr + 132);
        float v[8], w[8];
        v[0] = a0.x + lo[0]; v[1] = a0.y + lo[1]; v[2] = a0.z + lo[2]; v[3] = a0.w + lo[3]; v[4] = a1.x + lo[4]; v[5] = a1.y + lo[5]; v[6] = a1.z + lo[6]; v[7] = a1.w + lo[7];
        w[0] = b0.x + hi[0]; w[1] = b0.y + hi[1]; w[2] = b0.z + hi[2]; w[3] = b0.w + hi[3]; w[4] = b1.x + hi[4]; w[5] = b1.y + hi[5]; w[6] = b1.z + hi[6]; w[7] = b1.w + hi[7];
        float* o = Y + (size_t)row * D + col;
        *(f32x4*)o = (f32x4){v[0], v[1], v[2], v[3]}; *(f32x4*)(o + 4) = (f32x4){v[4], v[5], v[6], v[7]};
        *(f32x4*)(o + 128) = (f32x4){w[0], w[1], w[2], w[3]}; *(f32x4*)(o + 132) = (f32x4){w[4], w[5], w[6], w[7]};
        float ss = 0.f;
#pragma unroll
        for (int i = 0; i < 8; ++i) ss += v[i] * v[i] + w[i] * w[i];
        ss += __shfl_xor(ss, X1M); ss += __shfl_xor(ss, X2M);
        if ((c0 & 31) == 0) SSP[(size_t)row * 16 + pn * 4 + (c0 >> 5)] = ss;
    }
};

template <class Epi> __device__ __forceinline__ void gemm_simple(LAS unsigned char* lds, const bf16_t* A, const bf16_t* Bt, int M, int N, int K, const Epi& E, int vb, int G) {
    LAS bf16_t* sA = (LAS bf16_t*)lds;
    LAS bf16_t* sB = (LAS bf16_t*)(lds + 4096);
    const int tid = opaque((int)threadIdx.x), r = tid >> 4, c0 = (tid & 15) * 8;
    const int nN = N / 256, nunits = (M / 32) * nN;
    for (int u = vb; u < nunits; u += G) {
        const int ms = u / nN, pn = u % nN, row0 = ms * 32, col0 = pn * 256;
        float lo[8], hi[8];
#pragma unroll
        for (int i = 0; i < 8; ++i) { lo[i] = 0.f; hi[i] = 0.f; }
        for (int k0 = 0; k0 < K; k0 += 32) {
            __syncthreads();
            if (tid < 128) { const int rr = tid >> 2, kc = (tid & 3) * 8; *(LAS u32x4*)(sA + rr * 40 + kc) = *(const u32x4*)(A + (size_t)(row0 + rr) * K + k0 + kc); }
            for (int q = tid; q < 1024; q += NTHR) { const int rr = q >> 2, kc = (q & 3) * 8; *(LAS u32x4*)(sB + rr * 40 + kc) = *(const u32x4*)(Bt + (size_t)(col0 + rr) * K + k0 + kc); }
            __syncthreads();
#pragma unroll 1
            for (int kc = 0; kc < 32; kc += 8) {
                const u32x4 av = *(const LAS u32x4*)(sA + r * 40 + kc);
                const float a0 = bflo(av.x), a1 = bfhi(av.x), a2 = bflo(av.y), a3 = bfhi(av.y), a4 = bflo(av.z), a5 = bfhi(av.z), a6 = bflo(av.w), a7 = bfhi(av.w);
#pragma unroll
                for (int i = 0; i < 8; ++i) {
                    const u32x4 b = *(const LAS u32x4*)(sB + (c0 + i) * 40 + kc);
                    lo[i] += a0 * bflo(b.x) + a1 * bfhi(b.x) + a2 * bflo(b.y) + a3 * bfhi(b.y) + a4 * bflo(b.z) + a5 * bfhi(b.z) + a6 * bflo(b.w) + a7 * bfhi(b.w);
                    const u32x4 c = *(const LAS u32x4*)(sB + (128 + c0 + i) * 40 + kc);
                    hi[i] += a0 * bflo(c.x) + a1 * bfhi(c.x) + a2 * bflo(c.y) + a3 * bfhi(c.y) + a4 * bflo(c.z) + a5 * bfhi(c.z) + a6 * bflo(c.w) + a7 * bfhi(c.w);
                }
            }
        }
        const int row = row0 + r; const float rsc = E.rowscale(row);
        E.template tile8<1, 2>(row, pn, c0, lo, hi, rsc);
    }
}

namespace pg8 {
#define PG8_LAS __attribute__((address_space(3)))
constexpr int BM = 256, BK = 64, HALF = 128, HTB = HALF * BK * 2  , STAGE_BYTES = 8 * HTB, NXCD = 8, WGM = 8;

__host__ __device__ __forceinline__ int lds_byte(int r, int c) { const int st = (r >> 4) * 2 + (c >> 5), rr = r & 15, cc = c & 31, ob = rr * 64 + cc * 2; return st * 1024 + (ob ^ (((ob >> 9) & 1) << 5)); }
__host__ __device__ __forceinline__ void stage_rc(int b, int& R, int& C) { const int st = b / 1024, sb = b % 1024, swz = sb ^ (((sb >> 9) & 1) << 5); R = (st >> 1) * 16 + swz / 64; C = (st & 1) * 32 + (swz % 64) / 2; }
__host__ __device__ __forceinline__ int perm32(int rho) { const int n = rho >> 4, i = rho & 15; return 8 * (i >> 2) + 4 * n + (i & 3); }

struct Unit { int pm, pn; };
struct Gemm { const bf16_t* A; const bf16_t* Bt; int M, N, K; };

struct StaticOrder {
    int nM, nN, nwg, G, c;
    __host__ __device__ void init(int M, int N, int G_, int c_) { nM = M / BM; nN = N / BM; nwg = nM * nN; G = G_; c = c_; }
    __host__ __device__ bool next(int i, Unit& u) const {
        const long L = (long)i * G + c; if (L >= nwg) return false;
        int wgid = (int)L; { const int q = nwg / NXCD, r = nwg % NXCD, xcd = wgid % NXCD, off = wgid / NXCD; wgid = (xcd < r ? xcd * (q + 1) : r * (q + 1) + (xcd - r) * q) + off; }
        const int nig = WGM * nN, gid = wgid / nig, fm = gid * WGM, gsz = (nM - fm) < WGM ? (nM - fm) : WGM;
        u.pm = fm + ((wgid % nig) % gsz); u.pn = (wgid % nig) / gsz; return true;
    }
    __device__ __forceinline__ void a_ready(const Unit&) const {}
    __device__ __forceinline__ void done(const Unit&) const {}
};
template <class Epi, class Sched, bool ALIGN_EPI = false, bool SP2 = false>
__device__ __forceinline__ void gemm_phase(PG8_LAS unsigned char* lds, const Gemm g, const Sched& S, const Epi& E) {
    const int tid = opaque((int)threadIdx.x), wid = __builtin_amdgcn_readfirstlane(tid >> 6), lane = tid & 63, wr = wid >> 2, wc = wid & 3, fr = lane & 15, fq = lane >> 4;
    const int K = g.K, nt = K / BK;
    unsigned voffA[2], voffB[2];
#pragma unroll
    for (int i = 0; i < 2; ++i) { int R, C; stage_rc(tid * 16 + i * 8192, R, C); const int Rb = Epi::PERM ? ((R & ~31) + perm32(R & 31)) : R;
        voffA[i] = (unsigned)(R * K + C) * 2u; voffB[i] = (unsigned)(Rb * K + C) * 2u; }
    const size_t kstep = (size_t)(BK * 2);
    const size_t hstep = (size_t)HALF * K * 2;
    const size_t tstep = 2 * hstep;
    const unsigned ldsw = (unsigned)wid * 1024u;
    const int aoff = lds_byte(wr * 64 + fr, fq * 8), boff = lds_byte(wc * 32 + fr, fq * 8);
#define PG8_SA(b, h) (((b) * 2 + (h)) * HTB)
#define PG8_SB(b, h) ((4 + (b) * 2 + (h)) * HTB)
#define PG8_STAGE(bufoff, gbase, voff) do { _Pragma("unroll") for (int _i = 0; _i < 2; ++_i) \
        __builtin_amdgcn_global_load_lds((const unsigned*)((const char*)(gbase) + (voff)[_i]), (PG8_LAS unsigned*)(lds + (bufoff) + ldsw + _i * 8192), 16, 0, 0); } while (0)
#define PG8_LDA(dst, b, h) do { _Pragma("unroll") for (int m = 0; m < 4; ++m) _Pragma("unroll") for (int k = 0; k < 2; ++k) dst[m][k] = *(const PG8_LAS bf16x8*)(lds + PG8_SA(b, h) + aoff + m * 2048 + k * 1024); } while (0)
#define PG8_LDB(dst, b, h) do { _Pragma("unroll") for (int n = 0; n < 2; ++n) _Pragma("unroll") for (int k = 0; k < 2; ++k) dst[n][k] = *(const PG8_LAS bf16x8*)(lds + PG8_SB(b, h) + boff + n * 2048 + k * 1024); } while (0)
#define PG8_MMA(ai, bj, At, Bt) do { __builtin_amdgcn_s_setprio(1); _Pragma("unroll") for (int m = 0; m < 4; ++m) _Pragma("unroll") for (int n = 0; n < 2; ++n) _Pragma("unroll") for (int k = 0; k < 2; ++k) \
        acc[ai][bj][m][n] = __builtin_amdgcn_mfma_f32_16x16x32_bf16(Bt[n][k], At[m][k], acc[ai][bj][m][n], 0, 0, 0); __builtin_amdgcn_s_setprio(0); } while (0)
#define PG8_WAIT_V(n) asm volatile("s_waitcnt vmcnt(" #n ")" ::: "memory")
#define PG8_WAIT_L(n) asm volatile("s_waitcnt lgkmcnt(" #n ")" ::: "memory")
#define PG8_BAR __builtin_amdgcn_s_barrier()
#define PG8_SCHED __builtin_amdgcn_sched_barrier(0)
    Unit cur, nxt; int ui = 0;
    if (!S.next(0, cur)) return;
    f32x4 acc[2][2][4][2];
#pragma unroll
    for (int a = 0; a < 2; ++a)
#pragma unroll
        for (int b = 0; b < 2; ++b)
#pragma unroll
            for (int m = 0; m < 4; ++m)
#pragma unroll
                for (int n = 0; n < 2; ++n) acc[a][b][m][n] = (f32x4){0.f, 0.f, 0.f, 0.f};
    bf16x8 At[4][2], B0[2][2], B1[2][2];
    const char* cA = (const char*)g.A + (size_t)cur.pm * tstep; const char* cB = (const char*)g.Bt + (size_t)cur.pn * tstep;
    S.a_ready(cur);
    if constexpr (SP2) {
        PG8_STAGE(PG8_SB(0, 0), cB, voffB); PG8_STAGE(PG8_SB(0, 1), cB + hstep, voffB); PG8_STAGE(PG8_SA(0, 0), cA, voffA); PG8_STAGE(PG8_SA(0, 1), cA + hstep, voffA);
        if (wr == 1) PG8_BAR;
        PG8_WAIT_V(2); PG8_BAR;
        PG8_STAGE(PG8_SB(1, 0), cB + kstep, voffB); PG8_STAGE(PG8_SA(1, 0), cA + kstep, voffA); PG8_STAGE(PG8_SB(1, 1), cB + hstep + kstep, voffB);
        PG8_WAIT_V(6); PG8_BAR;
    } else {
        PG8_STAGE(PG8_SB(0, 0), cB, voffB); PG8_STAGE(PG8_SA(0, 0), cA, voffA); PG8_STAGE(PG8_SB(0, 1), cB + hstep, voffB); PG8_STAGE(PG8_SA(0, 1), cA + hstep, voffA);
        if (wr == 1) PG8_BAR;
        PG8_WAIT_V(4); PG8_BAR;
        PG8_STAGE(PG8_SB(1, 0), cB + kstep, voffB); PG8_STAGE(PG8_SA(1, 0), cA + kstep, voffA); PG8_STAGE(PG8_SB(1, 1), cB + hstep + kstep, voffB);
        PG8_WAIT_V(6); PG8_BAR;
    }
    for (;;) {
        const bool has_next = S.next(ui + 1, nxt);
        const char* nA = has_next ? (const char*)g.A + (size_t)nxt.pm * tstep : cA; const char* nB = has_next ? (const char*)g.Bt + (size_t)nxt.pn * tstep : cB;
        for (int t = 0; t < nt; t += 2) {
            const bool last = (t == nt - 2);
            const char* a1 = cA + (size_t)(t + 1) * kstep;
            const char* a2 = last ? nA : cA + (size_t)(t + 2) * kstep; const char* b2 = last ? nB : cB + (size_t)(t + 2) * kstep;
            const char* a3 = a2 + kstep; const char* b3 = b2 + kstep;
            if (last && has_next) S.a_ready(nxt);
            if constexpr (SP2) {
            PG8_LDB(B0, 0, 0); PG8_LDB(B1, 0, 1); PG8_SCHED; PG8_LDA(At, 0, 0); PG8_STAGE(PG8_SA(1, 1), a1 + hstep, voffA);
            PG8_WAIT_V(8); PG8_WAIT_L(0); PG8_BAR; PG8_MMA(0, 0, At, B0); PG8_MMA(0, 1, At, B1); PG8_BAR; PG8_SCHED;
            PG8_LDA(At, 0, 1); PG8_STAGE(PG8_SB(0, 0), b2, voffB); PG8_STAGE(PG8_SB(0, 1), b2 + hstep, voffB); PG8_STAGE(PG8_SA(0, 0), a2, voffA);
            PG8_WAIT_V(8); PG8_WAIT_L(0); PG8_BAR; PG8_MMA(1, 0, At, B0); PG8_MMA(1, 1, At, B1); PG8_BAR; PG8_SCHED;
            PG8_LDB(B0, 1, 0); PG8_LDB(B1, 1, 1); PG8_SCHED; PG8_LDA(At, 1, 0); PG8_STAGE(PG8_SA(0, 1), a2 + hstep, voffA);
            PG8_WAIT_V(8); PG8_WAIT_L(0); PG8_BAR; PG8_MMA(0, 0, At, B0); PG8_MMA(0, 1, At, B1); PG8_BAR; PG8_SCHED;
            PG8_LDA(At, 1, 1); PG8_STAGE(PG8_SB(1, 0), b3, voffB); PG8_STAGE(PG8_SB(1, 1), b3 + hstep, voffB); PG8_STAGE(PG8_SA(1, 0), a3, voffA);
            PG8_WAIT_V(8); PG8_WAIT_L(0); PG8_BAR; PG8_MMA(1, 0, At, B0); PG8_MMA(1, 1, At, B1); PG8_BAR; PG8_SCHED;
            } else {
            PG8_LDB(B0, 0, 0); PG8_SCHED; PG8_LDA(At, 0, 0); PG8_STAGE(PG8_SA(1, 1), a1 + hstep, voffA);
            PG8_WAIT_L(8); PG8_BAR; PG8_WAIT_L(0); PG8_MMA(0, 0, At, B0); PG8_BAR; PG8_SCHED;
            PG8_LDB(B1, 0, 1); PG8_STAGE(PG8_SB(0, 0), b2, voffB);
            PG8_BAR; PG8_WAIT_L(0); PG8_MMA(0, 1, At, B1); PG8_BAR;
            PG8_LDA(At, 0, 1); PG8_STAGE(PG8_SA(0, 0), a2, voffA);
            PG8_BAR; PG8_WAIT_L(0); PG8_MMA(1, 0, At, B0); PG8_BAR; PG8_SCHED;
            PG8_STAGE(PG8_SB(0, 1), b2 + hstep, voffB);
            PG8_WAIT_V(6); PG8_BAR; PG8_MMA(1, 1, At, B1); PG8_BAR;
            PG8_LDB(B0, 1, 0); PG8_SCHED; PG8_LDA(At, 1, 0); PG8_STAGE(PG8_SA(0, 1), a2 + hstep, voffA);
            PG8_WAIT_L(8); PG8_BAR; PG8_WAIT_L(0); PG8_MMA(0, 0, At, B0); PG8_BAR; PG8_SCHED;
            PG8_LDB(B1, 1, 1); PG8_STAGE(PG8_SB(1, 0), b3, voffB);
            PG8_BAR; PG8_WAIT_L(0); PG8_MMA(0, 1, At, B1); PG8_BAR;
            PG8_LDA(At, 1, 1); PG8_STAGE(PG8_SA(1, 0), a3, voffA);
            PG8_BAR; PG8_WAIT_L(0); PG8_MMA(1, 0, At, B0); PG8_BAR; PG8_SCHED;
            PG8_STAGE(PG8_SB(1, 1), b3 + hstep, voffB);
            PG8_WAIT_V(6); PG8_BAR; PG8_MMA(1, 1, At, B1); PG8_BAR;
            }
        }
        if constexpr (ALIGN_EPI) { if (wr == 0) PG8_BAR; }
        if constexpr (!Epi::AFTER_DRAIN) { E(acc, cur, wr, wc, fr, fq); S.done(cur); }
        if (!has_next) break;
#pragma unroll
        for (int a = 0; a < 2; ++a)
#pragma unroll
            for (int b = 0; b < 2; ++b)
#pragma unroll
                for (int m = 0; m < 4; ++m)
#pragma unroll
                    for (int n = 0; n < 2; ++n) acc[a][b][m][n] = (f32x4){0.f, 0.f, 0.f, 0.f};
        cur = nxt; cA = nA; cB = nB; ++ui;
        if constexpr (ALIGN_EPI) { if (wr == 1) PG8_BAR; }
    }
    PG8_WAIT_V(0);
    if constexpr (!ALIGN_EPI) { if (wr == 0) PG8_BAR; }
    PG8_BAR;
    if constexpr (Epi::AFTER_DRAIN) { E.fused(acc, cur, wr, wc, fr, fq, lds, wid, lane); S.done(cur); }
#undef PG8_SA
#undef PG8_SB
#undef PG8_STAGE
#undef PG8_LDA
#undef PG8_LDB
#undef PG8_MMA
#undef PG8_WAIT_V
#undef PG8_WAIT_L
#undef PG8_BAR
#undef PG8_SCHED
}
}

template <class E> struct EpiAd {
    static constexpr bool PERM = true, AFTER_DRAIN = false; E e;
    __device__ __forceinline__ void operator()(const f32x4 (&acc)[2][2][4][2], const pg8::Unit& u, int wr, int wc, int fr, int fq) const {
#pragma unroll
        for (int ai = 0; ai < 2; ++ai)
#pragma unroll
            for (int m = 0; m < 4; ++m) {
                const int row = u.pm * 256 + ai * 128 + wr * 64 + m * 16 + fr;
                const float rsc = e.rowscale(row);
                float lo[8], hi[8];
#pragma unroll
                for (int j = 0; j < 4; ++j) { lo[j] = acc[ai][0][m][0][j]; lo[4 + j] = acc[ai][0][m][1][j]; hi[j] = acc[ai][1][m][0][j]; hi[4 + j] = acc[ai][1][m][1][j]; }
                e.template tile8<16, 32>(row, u.pn, wc * 32 + 8 * fq, lo, hi, rsc);
            }
    }
};
template <class E> __device__ __forceinline__ void gemm_fast(LAS unsigned char* lds, const bf16_t* A, const bf16_t* Bt, int M, int N, int K, const E& e, int vb, int G) {
    pg8::Gemm g{A, Bt, M, N, K}; pg8::StaticOrder S; S.init(M, N, G, vb);
    EpiAd<E> Ea{e};
    pg8::gemm_phase<EpiAd<E>, pg8::StaticOrder, true, true>(lds, g, S, Ea);
}

template <class E, int KS>
__device__ __forceinline__ void gemm_small(LAS unsigned char* lds, const bf16_t* A, const bf16_t* Bt, int N, int K, const E& e, int row_base, int vb, int G) {
    const int tid = opaque((int)threadIdx.x), lane = tid & 63, wave = __builtin_amdgcn_readfirstlane(tid >> 6), fr = lane & 15, fq = lane >> 4;
    const int nwork = 16 * (N / 64) * KS;
    for (int wbase = vb * NWAVES; wbase < nwork; wbase += G * NWAVES) {
        const int wk = wbase + wave; const bool act = wk < nwork;
        const int tile = act ? wk / KS : 0, ks = wk % KS;
        const int ct = tile >> 4, rt = tile & 15, pn = ct >> 2, cg = ct & 3;
        const int klen = K / KS, kb = ks * klen;
        f32x4 acc[4][4];
#pragma unroll
        for (int m = 0; m < 4; ++m)
#pragma unroll
            for (int n = 0; n < 4; ++n) acc[m][n] = (f32x4){0.f, 0.f, 0.f, 0.f};
        if (act) {
            const bf16_t* ap = A + (size_t)(rt * 64 + fr) * K + kb + 8 * fq;
            const bf16_t* bp[4];
#pragma unroll
            for (int n = 0; n < 4; ++n) { const int vcol = 256 * pn + (n >> 1) * 128 + 32 * cg + pg8::perm32(16 * (n & 1) + fr); bp[n] = Bt + (size_t)vcol * K + kb + 8 * fq; }
            bf16x8 a0[4], b0[4], a1[4], b1[4];
#define GS_LD(aa, bb, koff) do { _Pragma("unroll") for (int m = 0; m < 4; ++m) aa[m] = *(const bf16x8*)(ap + (size_t)m * 16 * K + (koff)); \
                                 _Pragma("unroll") for (int n = 0; n < 4; ++n) bb[n] = *(const bf16x8*)(bp[n] + (koff)); } while (0)
#define GS_MMA(aa, bb) do { _Pragma("unroll") for (int m = 0; m < 4; ++m) _Pragma("unroll") for (int n = 0; n < 4; ++n) \
                                 acc[m][n] = __builtin_amdgcn_mfma_f32_16x16x32_bf16(bb[n], aa[m], acc[m][n], 0, 0, 0); } while (0)
            GS_LD(a0, b0, 0);
            for (int k = 0; k < klen; k += 64) {
                GS_LD(a1, b1, k + 32);
                GS_MMA(a0, b0);
                if (k + 64 < klen) GS_LD(a0, b0, k + 64);
                GS_MMA(a1, b1);
            }
#undef GS_LD
#undef GS_MMA
        }
        if (KS == 1) {
            if (act) {
#pragma unroll
                for (int m = 0; m < 4; ++m) { const int row = row_base + rt * 64 + 16 * m + fr; const float rsc = e.rowscale(row); float lo[8], hi[8];
#pragma unroll
                    for (int j = 0; j < 4; ++j) { lo[j] = acc[m][0][j]; lo[4 + j] = acc[m][1][j]; hi[j] = acc[m][2][j]; hi[4 + j] = acc[m][3][j]; }
                    e.template tile8<16, 32>(row, pn, 32 * cg + 8 * fq, lo, hi, rsc); }
            }
        } else {
            LAS float* P = (LAS float*)lds;
            __syncthreads();
#pragma unroll
            for (int m = 0; m < 4; ++m)
#pragma unroll
                for (int n = 0; n < 4; ++n)
#pragma unroll
                    for (int j = 0; j < 4; ++j) P[((wave * 16 + m * 4 + n) * 4 + j) * 64 + lane] = acc[m][n][j];
            __syncthreads();
            if (wave < 4 && act) {
                const int m = wave; float lo[8], hi[8];
#pragma unroll
                for (int n = 0; n < 4; ++n)
#pragma unroll
                    for (int j = 0; j < 4; ++j) { float sum = 0.f;
#pragma unroll
                        for (int sl = 0; sl < KS; ++sl) sum += P[((sl * 16 + m * 4 + n) * 4 + j) * 64 + lane];
                        if (n < 2) lo[(n & 1) * 4 + j] = sum; else hi[(n & 1) * 4 + j] = sum; }
                const int row = row_base + rt * 64 + 16 * m + fr; const float rsc = e.rowscale(row);
                e.template tile8<16, 32>(row, pn, 32 * cg + 8 * fq, lo, hi, rsc);
            }
        }
    }
}
#if FAST_GEMM
#define GEMM gemm_fast
#else
#define GEMM gemm_simple
#endif

__device__ __forceinline__ void conv_simple(const Params& p, LAS unsigned char* lds, int vb, int G) {
    LAS float* red = (LAS float*)lds;
    const bf16_t* A = (const bf16_t*)(p.ws + WS_R1); const bf16_t* SGA = A + (size_t)T * 1024; bf16_t* H0 = (bf16_t*)p.out;
    const float *cw = p.in[6], *cb = p.in[7], *lg = p.in[8], *lbeta = p.in[9], *sc = p.in[2];
    const int tid = opaque((int)threadIdx.x), c = tid * 2;
    for (int r = vb; r < T; r += G) {
        int t, rowbase; const float* hist;
        if (r < TP) { t = r & 2047; rowbase = r - t; hist = nullptr; } else { const int b = (r - TP) >> 3; t = (r - TP) & 7; rowbase = r - t; hist = sc + (size_t)b * 30 * 1024; }
        float y0 = cb[c], y1 = cb[c + 1];
        for (int j = 0; j < 31; ++j) { const int i = t + j - 30; float a0 = 0.f, a1 = 0.f;
            if (i >= 0) { const unsigned w = *(const unsigned*)(A + (size_t)(rowbase + i) * 1024 + c); a0 = bflo(w); a1 = bfhi(w); }
            else if (hist) { a0 = hist[(30 + i) * 1024 + c]; a1 = hist[(30 + i) * 1024 + c + 1]; }
            y0 += cw[j * 1024 + c] * a0; y1 += cw[j * 1024 + c + 1] * a1; }
        const float mean = block_sum(y0 + y1, red) * (1.f / 1024.f);
        const float d0 = y0 - mean, d1 = y1 - mean;
        const float rstd = rsqrtf(block_sum(d0 * d0 + d1 * d1, red) * (1.f / 1024.f) + EPS);
        const float n0 = d0 * rstd * lg[c] + lbeta[c], n1 = d1 * rstd * lg[c + 1] + lbeta[c + 1];
        const unsigned gw = *(const unsigned*)(SGA + (size_t)r * 1024 + c);
        *(unsigned*)(H0 + (size_t)r * 2048 + c) = pk2(silu(n0) * bflo(gw), silu(n1) * bfhi(gw));
    }
    for (int idx = vb * NTHR + tid; idx < 8 * 30 * 1024; idx += G * NTHR) { const int b = idx / 30720, rem = idx % 30720, i = rem >> 10, cc = rem & 1023;
        p.out[O_CP + idx] = bf2f(A[(size_t)(b * 2048 + 2018 + i) * 1024 + cc]); }
    for (int idx = vb * NTHR + tid; idx < 128 * 30 * 1024; idx += G * NTHR) { const int b = idx / 30720, rem = idx % 30720, i = rem >> 10, cc = rem & 1023;
        p.out[O_CS + idx] = (i < 22) ? sc[(size_t)(b * 30 + 8 + i) * 1024 + cc] : bf2f(A[(size_t)(TP + b * 8 + i - 22) * 1024 + cc]); }
}


typedef float f32x16 __attribute__((ext_vector_type(16)));
__device__ __forceinline__ bf16x8 ldfrag(const LAS unsigned char* img, int pitchB, int row0, int k0, int lane) {
    return *(const LAS bf16x8*)(img + (row0 + (lane & 31)) * pitchB + (k0 + 8 * (lane >> 5)) * 2);
}
__device__ __forceinline__ unsigned ld_u16(const void* base, unsigned boff) { return *(const unsigned short*)((const char*)base + boff); }
__device__ __forceinline__ void st_u16(void* base, unsigned boff, unsigned v) { *(unsigned short*)((char*)base + boff) = (unsigned short)v; }
#define MFMA32(a, b, c) __builtin_amdgcn_mfma_f32_32x32x16_bf16((a), (b), (c), 0, 0, 0)
__device__ __forceinline__ int accrow(int r, int lane) { return (r & 3) + 8 * (r >> 2) + 4 * (lane >> 5); }

__device__ __forceinline__ void conv_fast(const Params& p, LAS unsigned char* lds, int vb, int G) {
    LAS float* red = (LAS float*)lds;
    const bf16_t* A = (const bf16_t*)(p.ws + WS_R1); const bf16_t* SGA = A + (size_t)T * 1024; bf16_t* H0 = (bf16_t*)p.out;
    const float *cw = p.in[6], *cb = p.in[7], *lg = p.in[8], *lbeta = p.in[9], *sc = p.in[2];
    const int tid = opaque((int)threadIdx.x), lane = tid & 63, wave = tid >> 6, c = tid * 2;
    LAS float* cwl = (LAS float*)(lds + 1024);
    __syncthreads();
    for (int q = tid; q < 31 * 256; q += NTHR) *(LAS f32x4*)(cwl + q * 4) = *(const f32x4*)(cw + q * 4);
    __syncthreads();
    const float cb0 = cb[c], cb1 = cb[c + 1], g0 = lg[c], g1 = lg[c + 1], be0 = lbeta[c], be1 = lbeta[c + 1];
    const f32x2 cbv = (f32x2){cb0, cb1}, gv2 = (f32x2){g0, g1}, bev = (f32x2){be0, be1};
    for (int item = vb; item < 384; item += G) {
        int L, rowfirst; f32x2 w[38];
        if (item < 256) { const int b = item >> 5, t0 = (item & 31) * 64; L = 64; rowfirst = b * 2048 + t0;
#pragma unroll
            for (int i = 0; i < 30; ++i) { unsigned u = 0u; if (t0 > 0) u = *(const unsigned*)(A + (size_t)(rowfirst - 30 + i) * 1024 + c); w[i] = (f32x2){bflo(u), bfhi(u)}; }
        } else { const int sb = item - 256; L = 8; rowfirst = TP + sb * 8; const float* hist = sc + (size_t)sb * 30 * 1024;
#pragma unroll
            for (int i = 0; i < 30; ++i) w[i] = *(const f32x2*)(hist + i * 1024 + c);
        }
        unsigned an[8], gn[8];
#pragma unroll
        for (int k = 0; k < 8; ++k) { an[k] = *(const unsigned*)(A + (size_t)(rowfirst + k) * 1024 + c); gn[k] = *(const unsigned*)(SGA + (size_t)(rowfirst + k) * 1024 + c); }
        for (int g = 0; g < L; g += 8) {
            unsigned gc[8];
#pragma unroll
            for (int k = 0; k < 8; ++k) { w[30 + k] = (f32x2){bflo(an[k]), bfhi(an[k])}; gc[k] = gn[k]; }
            if (g + 8 < L) {
#pragma unroll
                for (int k = 0; k < 8; ++k) { an[k] = *(const unsigned*)(A + (size_t)(rowfirst + g + 8 + k) * 1024 + c); gn[k] = *(const unsigned*)(SGA + (size_t)(rowfirst + g + 8 + k) * 1024 + c); } }
            f32x2 y[8]; float st[16];
#pragma unroll
            for (int k = 0; k < 8; ++k) y[k] = cbv;
#pragma unroll
            for (int j = 0; j < 31; ++j) { const f32x2 wj = *(const LAS f32x2*)(cwl + j * 1024 + c);
#pragma unroll
                for (int k = 0; k < 8; ++k) y[k] += wj * w[k + j]; }
#pragma unroll
            for (int k = 0; k < 8; ++k) { const f32x2 sq = y[k] * y[k]; st[k] = y[k].x + y[k].y; st[8 + k] = sq.x + sq.y; }
#pragma unroll
            for (int k = 0; k < 16; ++k) st[k] = wave_sum(st[k]);
            if (lane == 0) {
#pragma unroll
                for (int k = 0; k < 16; ++k) red[wave * 16 + k] = st[k]; }
            __syncthreads();
            if (tid < 16) { float sacc = 0.f;
#pragma unroll
                for (int ww = 0; ww < 8; ++ww) sacc += red[ww * 16 + tid];
                red[128 + tid] = sacc; }
            __syncthreads();
#pragma unroll
            for (int k = 0; k < 8; ++k) { const float mean = red[128 + k] * (1.f / 1024.f); const float var = red[136 + k] * (1.f / 1024.f) - mean * mean; const float rstd = rsqrtf(var + EPS);
                const f32x2 n = (y[k] - mean) * rstd * gv2 + bev;
                *(unsigned*)(H0 + (size_t)(rowfirst + g + k) * 2048 + c) = pk2(silu(n.x) * bflo(gc[k]), silu(n.y) * bfhi(gc[k])); }
#pragma unroll
            for (int i = 0; i < 30; ++i) w[i] = w[i + 8];
        }
        if (item >= 256) { float* o = p.out + O_CS + (size_t)(item - 256) * 30 * 1024 + c;
#pragma unroll
            for (int i = 0; i < 30; ++i) *(f32x2*)(o + i * 1024) = w[i]; }
        else if ((item & 31) == 31) { float* o = p.out + O_CP + (size_t)(item >> 5) * 30 * 1024 + c;
#pragma unroll
            for (int i = 0; i < 30; ++i) *(f32x2*)(o + i * 1024) = w[i]; }
    }
}

__device__ __forceinline__ void hgrn_simple(const Params& p, LAS unsigned char* lds, int vb, int G, int item_lo, int item_hi) {
    LAS float* sf = (LAS float*)lds; LAS float* sk = sf + 1024; LAS float* sq = sk + 1024; LAS float* si = sq + 1024; LAS float* so = si + 1024; LAS float* so2 = so + 4096;
    const int tid = opaque((int)threadIdx.x), v = tid & 127, dq = tid >> 7, lane = tid & 63, wave = tid >> 6;
    const bf16_t* Z = (const bf16_t*)(p.ws + WS_R1);
    const bf16_t *Q = Z + (size_t)2 * T * 1024, *LOGF = Z + (size_t)3 * T * 1024, *I = Z + (size_t)4 * T * 1024, *SGB = Z + (size_t)5 * T * 1024;
    const float* og = p.in[11]; bf16_t* H0 = (bf16_t*)p.out;
    for (int item = item_lo + vb; item < item_hi; item += G) {
        int h, L, rowbase; const float* s0; float* sout;
        if (item < 64) { const int b = item >> 3; h = item & 7; L = 2048; rowbase = b * 2048; s0 = nullptr; sout = p.out + O_HP + (size_t)item * 16384; }
        else { const int it = item - 64, b = it >> 3; h = it & 7; L = 8; rowbase = TP + b * 8; s0 = p.in[3] + (size_t)it * 16384; sout = p.out + O_HS + (size_t)it * 16384; }
        float S[32];
#pragma unroll
        for (int j = 0; j < 32; ++j) S[j] = s0 ? s0[(dq * 32 + j) * 128 + v] : 0.f;
        for (int t0 = 0; t0 < L; t0 += 8) {
            __syncthreads();
            for (int e = tid; e < 1024; e += NTHR) { const int tt = e >> 7, d = e & 127; const size_t off = (size_t)(rowbase + t0 + tt) * 1024 + h * 128 + d;
                const float f = __expf(bf2f(LOGF[off])); sf[e] = f; sk[e] = 1.f - f; sq[e] = bf2f(Q[off]); si[e] = bf2f(I[off]); }
            __syncthreads();
#pragma unroll 1
            for (int tt = 0; tt < 8; ++tt) { const float iv = si[tt * 128 + v]; float op = 0.f;
#pragma unroll
                for (int j = 0; j < 32; ++j) { const int d = dq * 32 + j; S[j] = sf[tt * 128 + d] * S[j] + sk[tt * 128 + d] * iv; op += S[j] * sq[tt * 128 + d]; }
                so[(tt * 4 + dq) * 128 + v] = op; }
            __syncthreads();
            for (int e = tid; e < 1024; e += NTHR) { const int tt = e >> 7, vv = e & 127; so2[e] = (so[(tt * 4 + 0) * 128 + vv] + so[(tt * 4 + 1) * 128 + vv]) + (so[(tt * 4 + 2) * 128 + vv] + so[(tt * 4 + 3) * 128 + vv]); }
            __syncthreads();
            { const int tt = wave; const size_t row = (size_t)(rowbase + t0 + tt);
              const float o0 = so2[tt * 128 + lane], o1 = so2[tt * 128 + 64 + lane];
              const float rs = rsqrtf(wave_sum(o0 * o0 + o1 * o1) * (1.f / 128.f) + EPS);
              const float r0 = o0 * rs * og[h * 128 + lane] * bf2f(SGB[row * 1024 + h * 128 + lane]);
              const float r1 = o1 * rs * og[h * 128 + 64 + lane] * bf2f(SGB[row * 1024 + h * 128 + 64 + lane]);
              H0[row * 2048 + 1024 + h * 128 + lane] = (bf16_t)f2bf(r0); H0[row * 2048 + 1024 + h * 128 + 64 + lane] = (bf16_t)f2bf(r1); }
        }
#pragma unroll
        for (int j = 0; j < 32; ++j) sout[(dq * 32 + j) * 128 + v] = S[j];
    }
}


__device__ __forceinline__ void hgrn_sample(const Params& p, LAS unsigned char* lds, int vb, int G) {
    LAS float* sf = (LAS float*)lds; LAS float* sk = sf + 1024; LAS float* sq = sk + 1024; LAS float* si = sq + 1024; LAS float* so = si + 1024; LAS float* so2 = so + 4096;
    const int tid = opaque((int)threadIdx.x), v = tid & 127, dq = tid >> 7, lane = tid & 63, wave = tid >> 6;
    const bf16_t* Z = (const bf16_t*)(p.ws + WS_R1);
    const bf16_t *Q = Z + (size_t)2 * T * 1024, *LOGF = Z + (size_t)3 * T * 1024, *I = Z + (size_t)4 * T * 1024, *SGB = Z + (size_t)5 * T * 1024;
    const float* og = p.in[11]; bf16_t* H0 = (bf16_t*)p.out;
    float S[32], Sn[32]; unsigned rl[2], rq2[2], ri2[2];
#define HS_LOAD(it_, SS) do { const float* s0_ = p.in[3] + (size_t)(it_) * 16384 + (dq * 32) * 128 + v; \
        _Pragma("unroll") for (int j = 0; j < 32; ++j) SS[j] = s0_[j * 128]; \
        _Pragma("unroll") for (int u = 0; u < 2; ++u) { const int e = tid + u * NTHR; const size_t off = (size_t)(TP + ((it_) >> 3) * 8 + (e >> 7)) * 1024 + ((it_) & 7) * 128 + (e & 127); \
            rl[u] = LOGF[off]; rq2[u] = Q[off]; ri2[u] = I[off]; } } while (0)
    int it = vb;
    if (it < 1024) HS_LOAD(it, S);
    for (; it < 1024; it += G) {
        const int b = it >> 3, h = it & 7, rowbase = TP + b * 8;
        __syncthreads();
#pragma unroll
        for (int u = 0; u < 2; ++u) { const int e = tid + u * NTHR; const float f = __expf(bf2f(rl[u])); sf[e] = f; sk[e] = 1.f - f; sq[e] = bf2f(rq2[u]); si[e] = bf2f(ri2[u]); }
        if (it + G < 1024) HS_LOAD(it + G, Sn);
        __syncthreads();
#pragma unroll 1
        for (int tt = 0; tt < 8; ++tt) { const float iv = si[tt * 128 + v]; float op = 0.f;
            const LAS f32x4* f4 = (const LAS f32x4*)(sf + tt * 128 + dq * 32); const LAS f32x4* k4 = (const LAS f32x4*)(sk + tt * 128 + dq * 32); const LAS f32x4* q4 = (const LAS f32x4*)(sq + tt * 128 + dq * 32);
#pragma unroll
            for (int jj = 0; jj < 8; ++jj) { const f32x4 fv = f4[jj], kv = k4[jj], qv = q4[jj];
                S[4 * jj] = fv.x * S[4 * jj] + kv.x * iv; op += S[4 * jj] * qv.x; S[4 * jj + 1] = fv.y * S[4 * jj + 1] + kv.y * iv; op += S[4 * jj + 1] * qv.y;
                S[4 * jj + 2] = fv.z * S[4 * jj + 2] + kv.z * iv; op += S[4 * jj + 2] * qv.z; S[4 * jj + 3] = fv.w * S[4 * jj + 3] + kv.w * iv; op += S[4 * jj + 3] * qv.w; }
            so[(tt * 4 + dq) * 128 + v] = op; }
        __syncthreads();
#pragma unroll
        for (int u = 0; u < 2; ++u) { const int e = tid + u * NTHR; const int tt = e >> 7, vv = e & 127; so2[e] = (so[(tt * 4 + 0) * 128 + vv] + so[(tt * 4 + 1) * 128 + vv]) + (so[(tt * 4 + 2) * 128 + vv] + so[(tt * 4 + 3) * 128 + vv]); }
        __syncthreads();
        { const int tt = wave; const size_t row = (size_t)(rowbase + tt);
          const float o0 = so2[tt * 128 + lane], o1 = so2[tt * 128 + 64 + lane];
          const float rs = rsqrtf(wave_sum(o0 * o0 + o1 * o1) * (1.f / 128.f) + EPS);
          const float r0 = o0 * rs * og[h * 128 + lane] * bf2f(SGB[row * 1024 + h * 128 + lane]);
          const float r1 = o1 * rs * og[h * 128 + 64 + lane] * bf2f(SGB[row * 1024 + h * 128 + 64 + lane]);
          H0[row * 2048 + 1024 + h * 128 + lane] = (bf16_t)f2bf(r0); H0[row * 2048 + 1024 + h * 128 + 64 + lane] = (bf16_t)f2bf(r1); }
        { float* sout = p.out + O_HS + (size_t)it * 16384 + (dq * 32) * 128 + v;
#pragma unroll
          for (int j = 0; j < 32; ++j) { sout[j * 128] = S[j]; S[j] = Sn[j]; } }
    }
#undef HS_LOAD
}

constexpr size_t WS_BSUM = 131072;
constexpr int HA_QM = 0, HA_KM = 17408, HA_KMT = 34816, HA_VT = 53248, HA_P = 71680, HA_ST = 80896, HA_TOT = 115712, HA_DEC = 117760;
constexpr int PQ = 272, PS = 144;
__device__ __forceinline__ void hgrn_phaseA(const Params& p, LAS unsigned char* lds, int vb, int G) {
    const int tid = opaque((int)threadIdx.x), lane = tid & 63, wid = __builtin_amdgcn_readfirstlane(tid >> 6);
    const int d = tid & 127, tq = tid >> 7;
    bf16_t* Zb = (bf16_t*)(p.ws + WS_R1);
    bf16_t* Qg = Zb + (size_t)2 * T * 1024; bf16_t* LFg = Zb + (size_t)3 * T * 1024; const bf16_t* Ig = Zb + (size_t)4 * T * 1024;
    float* SEG = (float*)(p.ws + WS_SEG); float* BSUM = (float*)(p.ws + WS_BSUM);
    LAS float* TOT = (LAS float*)(lds + HA_TOT); LAS float* DEC = (LAS float*)(lds + HA_DEC);
    for (int item = vb; item < 256; item += G) {
        const int bh = item >> 2, seg = item & 3, b = bh >> 3, h = bh & 7;
        const size_t row0 = (size_t)b * 2048 + seg * 512; const int cb = h * 128;
        __syncthreads();
        for (int i = tid; i < 2176; i += NTHR) *(LAS u32x4*)(lds + HA_ST + i * 16) = (u32x4){0u, 0u, 0u, 0u};
        const int dt = wid >> 1, vts = (wid & 1) * 2;
        f32x16 S[2];
#pragma unroll
        for (int j2 = 0; j2 < 2; ++j2)
#pragma unroll
            for (int r = 0; r < 16; ++r) S[j2][r] = 0.f;
        float bsum = 0.f;
        unsigned rq[16], rf[16], ri[16];
        const unsigned toff = ((unsigned)(16 * tq) * 1024u + (unsigned)d) * 2u;
        { const bf16_t* qb = Qg + row0 * 1024 + cb; const bf16_t* fb = LFg + row0 * 1024 + cb; const bf16_t* ib = Ig + row0 * 1024 + cb;
#pragma unroll
          for (int j = 0; j < 16; ++j) { rq[j] = ld_u16(qb, toff + j * 2048u); rf[j] = ld_u16(fb, toff + j * 2048u); ri[j] = ld_u16(ib, toff + j * 2048u); } }
        for (int c = 0; c < 8; ++c) {
            const size_t r0 = row0 + c * 64;
            float bc[16]; float run = 0.f;
#pragma unroll
            for (int j = 0; j < 16; ++j) { run += bf2f(rf[j]); bc[j] = run; }
            TOT[tq * 128 + d] = run;
            __syncthreads();
            float pre = 0.f, bend = 0.f;
#pragma unroll
            for (int q = 0; q < 4; ++q) { const float t = TOT[q * 128 + d]; pre += (q < tq) ? t : 0.f; bend += t; }
            if (tq == 0) DEC[d] = __expf(bend);
            const float eseg = __expf(bsum);
            unsigned kmp[8], vtp[8]; const unsigned to1 = (unsigned)opaque((int)toff);
#pragma unroll
            for (int j = 0; j < 16; j += 2) {
                float km2[2];
#pragma unroll
                for (int u = 0; u < 2; ++u) { const int jj = j + u; const float bcum = pre + bc[jj]; const float f = __expf(bf2f(rf[jj]));
                    const float qm = bf2f(rq[jj]) * __expf(bcum), km = (1.f - f) * __expf(-bcum); km2[u] = km;
                    const int t = 16 * tq + jj;
                    *(LAS bf16_t*)(lds + HA_QM + t * PQ + d * 2) = (bf16_t)f2bf(qm); *(LAS bf16_t*)(lds + HA_KM + t * PQ + d * 2) = (bf16_t)f2bf(km);
                    st_u16(LFg + r0 * 1024 + cb, to1 + jj * 2048u, f2bf(qm * eseg)); }
                kmp[j >> 1] = pk2(km2[0], km2[1]); vtp[j >> 1] = ri[j] | (ri[j + 1] << 16);
            }
            *(LAS u32x4*)(lds + HA_KMT + d * PS + tq * 32) = (u32x4){kmp[0], kmp[1], kmp[2], kmp[3]}; *(LAS u32x4*)(lds + HA_KMT + d * PS + tq * 32 + 16) = (u32x4){kmp[4], kmp[5], kmp[6], kmp[7]};
            *(LAS u32x4*)(lds + HA_VT + d * PS + tq * 32) = (u32x4){vtp[0], vtp[1], vtp[2], vtp[3]}; *(LAS u32x4*)(lds + HA_VT + d * PS + tq * 32 + 16) = (u32x4){vtp[4], vtp[5], vtp[6], vtp[7]};
            bsum += bend;
            __syncthreads();
            f32x16 dS[2];
#pragma unroll
            for (int j2 = 0; j2 < 2; ++j2)
#pragma unroll
                for (int r = 0; r < 16; ++r) dS[j2][r] = 0.f;
            { bf16x8 af[4];
#pragma unroll
              for (int ks = 0; ks < 4; ++ks) af[ks] = ldfrag(lds + HA_KMT, PS, 32 * dt, 16 * ks, lane);
#pragma unroll
              for (int j2 = 0; j2 < 2; ++j2)
#pragma unroll
                  for (int ks = 0; ks < 4; ++ks) { const bf16x8 bb = ldfrag(lds + HA_VT, PS, 32 * (vts + j2), 16 * ks, lane); dS[j2] = MFMA32(af[ks], bb, dS[j2]); } }
            if (wid < 4) {
                const int mt = (wid + 1) >> 1, nt = (wid == 2 || wid == 3) ? 1 : 0;
                const int mtt = (wid == 3) ? 0 : mt;
                f32x16 acc;
#pragma unroll
                for (int r = 0; r < 16; ++r) acc[r] = 0.f;
                if (wid < 3) {
#pragma unroll
                    for (int ks = 0; ks < 8; ++ks) { const bf16x8 a = ldfrag(lds + HA_QM, PQ, 32 * mtt, 16 * ks, lane), bb = ldfrag(lds + HA_KM, PQ, 32 * nt, 16 * ks, lane); acc = MFMA32(a, bb, acc); }
                }
                const int lnx = opaque(lane); const int sx = 32 * nt + (lnx & 31), tb = 32 * mtt + 4 * (lnx >> 5);
                LAS unsigned char* pp = lds + HA_P + tb * PS + sx * 2;
#pragma unroll
                for (int r = 0; r < 16; ++r) { const int tr = (r & 3) + 8 * (r >> 2);
                    *(LAS bf16_t*)(pp + tr * PS) = (bf16_t)f2bf((sx <= tb + tr) ? acc[r] : 0.f); }
            }
            __syncthreads();
            if (c + 1 < 8) { const bf16_t* qb = Qg + (r0 + 64) * 1024 + cb; const bf16_t* fb = LFg + (r0 + 64) * 1024 + cb; const bf16_t* ib = Ig + (r0 + 64) * 1024 + cb;
                const unsigned to2 = (unsigned)opaque((int)toff);
#pragma unroll
                for (int j = 0; j < 16; ++j) { rq[j] = ld_u16(qb, to2 + j * 2048u); rf[j] = ld_u16(fb, to2 + j * 2048u); ri[j] = ld_u16(ib, to2 + j * 2048u); } }
            { const int mt = wid >> 2, vt = wid & 3; f32x16 o;
#pragma unroll
              for (int r = 0; r < 16; ++r) o[r] = 0.f;
#pragma unroll
              for (int ks = 0; ks < 4; ++ks) { const bf16x8 a = ldfrag(lds + HA_P, PS, 32 * mt, 16 * ks, lane), bb = ldfrag(lds + HA_VT, PS, 32 * vt, 16 * ks, lane); o = MFMA32(a, bb, o); }
#pragma unroll
              for (int ks = 0; ks < 8; ++ks) { const bf16x8 a = ldfrag(lds + HA_QM, PQ, 32 * mt, 16 * ks, lane), bb = ldfrag(lds + HA_ST, PQ, 32 * vt, 16 * ks, lane); o = MFMA32(a, bb, o); }
              const int lny = opaque(lane); const unsigned ob = ((unsigned)(32 * mt + 4 * (lny >> 5)) * 1024u + 32 * vt + (lny & 31)) * 2u;
#pragma unroll
              for (int r = 0; r < 16; ++r) st_u16(Qg + r0 * 1024 + cb, ob + ((r & 3) + 8 * (r >> 2)) * 2048u, f2bf(o[r])); }
            __syncthreads();
            { float dec[16]; const int lnu = opaque(lane); const LAS float* dp = DEC + 32 * dt + 4 * (lnu >> 5);
#pragma unroll
              for (int r = 0; r < 16; ++r) dec[r] = dp[(r & 3) + 8 * (r >> 2)];
#pragma unroll
              for (int j2 = 0; j2 < 2; ++j2) {
#pragma unroll
                  for (int r = 0; r < 16; ++r) S[j2][r] = dec[r] * (S[j2][r] + dS[j2][r]);
                  LAS unsigned char* sp2 = lds + HA_ST + (32 * (vts + j2) + (lnu & 31)) * PQ + (32 * dt + 4 * (lnu >> 5)) * 2;
#pragma unroll
                  for (int g = 0; g < 4; ++g)
                      *(LAS u32x2*)(sp2 + 16 * g) = (u32x2){pk2(S[j2][4 * g], S[j2][4 * g + 1]), pk2(S[j2][4 * g + 2], S[j2][4 * g + 3])};
              } }
        }
        { const int lns = opaque(lane); float* sp = SEG + (size_t)item * 16384 + (32 * dt + 4 * (lns >> 5)) * 128 + 32 * vts + (lns & 31);
#pragma unroll
            for (int j2 = 0; j2 < 2; ++j2)
#pragma unroll
                for (int r = 0; r < 16; ++r) sp[((r & 3) + 8 * (r >> 2)) * 128 + 32 * j2] = S[j2][r]; }
        if (tq == 0) BSUM[item * 128 + d] = bsum;
    }
}
constexpr int HB_AQ = 0, HB_SIN = 34816, HB_OT = 69632;
__device__ __forceinline__ void hgrn_phaseB(const Params& p, LAS unsigned char* lds, int vb, int G) {
    const int tid = opaque((int)threadIdx.x), lane = tid & 63, wid = __builtin_amdgcn_readfirstlane(tid >> 6);
    const int v = tid & 127, dg = tid >> 7;
    const bf16_t* Zb = (const bf16_t*)(p.ws + WS_R1);
    const bf16_t* OLg = Zb + (size_t)2 * T * 1024; const bf16_t* QSg = Zb + (size_t)3 * T * 1024; const bf16_t* SGB = Zb + (size_t)5 * T * 1024;
    const float* SEG = (const float*)(p.ws + WS_SEG); const float* BSUM = (const float*)(p.ws + WS_BSUM);
    const float* og = p.in[11]; bf16_t* H0 = (bf16_t*)p.out;
    LAS float* OT = (LAS float*)(lds + HB_OT);
    for (int item = vb; item < 256; item += G) {
        const int bh = item >> 2, seg = item & 3, b = bh >> 3, h = bh & 7;
        const size_t row0 = (size_t)b * 2048 + seg * 512; const int cb = h * 128;
        __syncthreads();
        if (seg > 0) {
            const float* S0 = SEG + (size_t)(bh * 4 + 0) * 16384; const float* S1 = S0 + 16384; const float* S2 = S1 + 16384; const float* S3 = S2 + 16384;
            const float* B1 = BSUM + (bh * 4 + 1) * 128; const float* B2 = B1 + 128; const float* B3 = B2 + 128;
#pragma unroll 2
            for (int d0 = dg * 32; d0 < dg * 32 + 32; d0 += 4) { float sv[4];
#pragma unroll
                for (int i = 0; i < 4; ++i) { const int dd = d0 + i; float s = S0[dd * 128 + v];
                    if (seg >= 2) s = __expf(B1[dd]) * s + S1[dd * 128 + v];
                    if (seg >= 3) s = __expf(B2[dd]) * s + S2[dd * 128 + v];
                    sv[i] = s;
                    if (seg == 3) p.out[O_HP + (size_t)bh * 16384 + dd * 128 + v] = __expf(B3[dd]) * s + S3[dd * 128 + v]; }
                *(LAS u32x2*)(lds + HB_SIN + v * PQ + d0 * 2) = (u32x2){pk2(sv[0], sv[1]), pk2(sv[2], sv[3])}; }
        }
        const int prow = tid >> 2, ppart = tid & 3; const int pc0 = cb + 32 * ppart;
        u32x4 aq[4], ol[4], gt[4];
#define HB_LOAD(rt_) do { const size_t rr = row0 + (rt_) * 128; \
            _Pragma("unroll") for (int i = 0; i < 4; ++i) { const int q = tid + i * NTHR; aq[i] = *(const u32x4*)(QSg + (rr + (q >> 4)) * 1024 + cb + (q & 15) * 8); \
                ol[i] = *(const u32x4*)(OLg + (rr + prow) * 1024 + pc0 + 8 * i); gt[i] = *(const u32x4*)(SGB + (rr + prow) * 1024 + pc0 + 8 * i); } } while (0)
        HB_LOAD(0);
        for (int rt = 0; rt < 4; ++rt) {
            const size_t r0 = row0 + rt * 128;
            u32x4 olc[4], gtc[4];
#pragma unroll
            for (int i = 0; i < 4; ++i) { olc[i] = ol[i]; gtc[i] = gt[i]; }
            if (seg > 0) {
#pragma unroll
                for (int i = 0; i < 4; ++i) { const int q = tid + i * NTHR; *(LAS u32x4*)(lds + HB_AQ + (q >> 4) * PQ + (q & 15) * 16) = aq[i]; }
            }
            if (rt < 3) HB_LOAD(rt + 1);
            if (seg > 0) {
                __syncthreads();
                const int mt = wid >> 1, vt0 = (wid & 1) * 2; f32x16 acc0, acc1;
#pragma unroll
                for (int r = 0; r < 16; ++r) { acc0[r] = 0.f; acc1[r] = 0.f; }
#pragma unroll
                for (int ks = 0; ks < 8; ++ks) { const bf16x8 a = ldfrag(lds + HB_AQ, PQ, 32 * mt, 16 * ks, lane), b0 = ldfrag(lds + HB_SIN, PQ, 32 * vt0, 16 * ks, lane), b1 = ldfrag(lds + HB_SIN, PQ, 32 * (vt0 + 1), 16 * ks, lane);
                    acc0 = MFMA32(a, b0, acc0); acc1 = MFMA32(a, b1, acc1); }
                { const int lno = opaque(lane); LAS float* op = OT + (32 * mt + 4 * (lno >> 5)) * 132 + 32 * vt0 + (lno & 31);
#pragma unroll
                  for (int r = 0; r < 16; ++r) { const int tr = (r & 3) + 8 * (r >> 2); op[tr * 132] = acc0[r]; op[tr * 132 + 32] = acc1[r]; } }
                __syncthreads();
            }
            { const size_t grow = r0 + prow;
              float o[32];
#pragma unroll
              for (int i = 0; i < 4; ++i) { const u32x4 w = olc[i];
                  o[8 * i] = bflo(w.x); o[8 * i + 1] = bfhi(w.x); o[8 * i + 2] = bflo(w.y); o[8 * i + 3] = bfhi(w.y); o[8 * i + 4] = bflo(w.z); o[8 * i + 5] = bfhi(w.z); o[8 * i + 6] = bflo(w.w); o[8 * i + 7] = bfhi(w.w); }
              if (seg > 0) {
#pragma unroll
                  for (int i = 0; i < 8; ++i) { const f32x4 x = *(const LAS f32x4*)(OT + prow * 132 + 32 * ppart + 4 * i); o[4 * i] += x.x; o[4 * i + 1] += x.y; o[4 * i + 2] += x.z; o[4 * i + 3] += x.w; } }
              float ss = 0.f;
#pragma unroll
              for (int i = 0; i < 32; ++i) ss += o[i] * o[i];
              ss += __shfl_xor(ss, 1); ss += __shfl_xor(ss, 2);
              const float rs = rsqrtf(ss * (1.f / 128.f) + EPS);
#pragma unroll
              for (int i = 0; i < 4; ++i) { const u32x4 gw = gtc[i];
                  const f32x4 g0 = *(const f32x4*)(og + h * 128 + 32 * ppart + 8 * i), g1 = *(const f32x4*)(og + h * 128 + 32 * ppart + 8 * i + 4);
                  float e[8];
                  e[0] = o[8 * i] * rs * g0.x * bflo(gw.x); e[1] = o[8 * i + 1] * rs * g0.y * bfhi(gw.x); e[2] = o[8 * i + 2] * rs * g0.z * bflo(gw.y); e[3] = o[8 * i + 3] * rs * g0.w * bfhi(gw.y);
                  e[4] = o[8 * i + 4] * rs * g1.x * bflo(gw.z); e[5] = o[8 * i + 5] * rs * g1.y * bfhi(gw.z); e[6] = o[8 * i + 6] * rs * g1.z * bflo(gw.w); e[7] = o[8 * i + 7] * rs * g1.w * bfhi(gw.w);
                  st8(H0 + grow * 2048 + 1024 + pc0 + 8 * i, e); }
            }
        }
#undef HB_LOAD
    }
}

__device__ __forceinline__ void gmlp_simple(const Params& p, LAS unsigned char* lds, int vb, int G, int row_lo) {
    LAS float* smean = (LAS float*)lds; LAS float* srstd = smean + 128;
    const f32x2* VST = (const f32x2*)(p.ws + WS_VST); const bf16_t* GV = (const bf16_t*)p.out; bf16_t* UG = (bf16_t*)(p.ws + WS_UG);
    const float *lg = p.in[15], *lb_ = p.in[16], *wsp = p.in[17], *bs = p.in[18];
    const int tid = opaque((int)threadIdx.x), ch = tid * 4, h = tid >> 6;
    const f32x4 g4 = *(const f32x4*)(lg + ch), b4 = *(const f32x4*)(lb_ + ch);
    for (int r = row_lo + vb; r < T; r += G) {
        int t, cstart;
        if (r < TP) { t = r & 127; cstart = r - t; } else { t = (r - TP) & 7; cstart = r - t; }
        __syncthreads();
        if (tid <= t) { const size_t row = (size_t)(cstart + tid); float s = 0.f, q = 0.f;
            for (int j = 0; j < 32; ++j) { const f32x2 st = VST[row * 32 + j]; s += st.x; q += st.y; }
            const float mean = s * (1.f / 2048.f); const float var = q * (1.f / 2048.f) - mean * mean; smean[tid] = mean; srstd[tid] = rsqrtf(var + EPS); }
        __syncthreads();
        float a0 = 0.f, a1 = 0.f, a2 = 0.f, a3 = 0.f, v0 = 0.f, v1 = 0.f, v2 = 0.f, v3 = 0.f;
        for (int s = 0; s <= t; ++s) {
            const float w = wsp[(size_t)(h * 128 + t) * 128 + s], m = smean[s], rs = srstd[s];
            const u32x2 gvw = *(const u32x2*)(GV + (size_t)(cstart + s) * DC + ch);
            v0 = (bflo(gvw.x) - m) * rs * g4.x + b4.x; v1 = (bfhi(gvw.x) - m) * rs * g4.y + b4.y; v2 = (bflo(gvw.y) - m) * rs * g4.z + b4.z; v3 = (bfhi(gvw.y) - m) * rs * g4.w + b4.w;
            a0 += w * v0; a1 += w * v1; a2 += w * v2; a3 += w * v3;
        }
        const float bias = bs[h * 128 + t];
        const u32x2 ugw = *(const u32x2*)(UG + (size_t)r * DC + ch);
        u32x2 o; o.x = pk2(bflo(ugw.x) * (a0 + bias), bfhi(ugw.x) * (a1 + bias)); o.y = pk2(bflo(ugw.y) * (a2 + bias), bfhi(ugw.y) * (a3 + bias));
        *(u32x2*)(UG + (size_t)r * DC + ch) = o;
        if (r < TP) { const int tt = (r & 2047) - 1920; if (tt >= 0) *(f32x4*)(p.out + O_GP + ((size_t)(r >> 11) * 128 + tt) * DC + ch) = (f32x4){v0, v1, v2, v3}; }
        else *(f32x4*)(p.out + O_GS + (size_t)(r - TP) * DC + ch) = (f32x4){v0, v1, v2, v3};
    }
}


constexpr int GM_W = 0, GM_VT = 34816, GM_MR = 34816 + 69632, GM_PITCH = 272;
__device__ __forceinline__ void gmlp_fast(const Params& p, LAS unsigned char* lds, int vb, int G) {
    LAS float* smean = (LAS float*)(lds + GM_MR); LAS float* srstd = smean + 128;
    const f32x2* VST = (const f32x2*)(p.ws + WS_VST); const bf16_t* GV = (const bf16_t*)p.out; bf16_t* UG = (bf16_t*)(p.ws + WS_UG);
    const float *lg = p.in[15], *lb_ = p.in[16], *wsp = p.in[17], *bs = p.in[18];
    const int tid = opaque((int)threadIdx.x), lane = tid & 63, wid = __builtin_amdgcn_readfirstlane(tid >> 6);
    for (int sitem = vb; sitem < 256; sitem += G) {
        const int chunk = sitem >> 1, hh = (sitem & 1) * 4; const size_t cstart = (size_t)chunk * 128;
        const bool lastchunk = (chunk & 15) == 15; const int bseq = chunk >> 4;
        __syncthreads();
        if (tid < 128) { const f32x4* sp = (const f32x4*)(VST + (cstart + tid) * 32); float s = 0.f, q = 0.f;
#pragma unroll
            for (int j = 0; j < 16; ++j) { const f32x4 a = sp[j]; s += a.x + a.z; q += a.y + a.w; }
            const float mean = s * (1.f / 2048.f); const float var = q * (1.f / 2048.f) - mean * mean; smean[tid] = mean; srstd[tid] = rsqrtf(var + EPS); }
        for (int h = hh; h < hh + 4; ++h) {
            __syncthreads();
            for (int q = tid; q < 4096; q += NTHR) { const int t = q >> 5, s0 = (q & 31) * 4; const f32x4 w = *(const f32x4*)(wsp + (size_t)(h * 128 + t) * 128 + s0);
                u32x2 o; o.x = pk2(s0 <= t ? w.x : 0.f, s0 + 1 <= t ? w.y : 0.f); o.y = pk2(s0 + 2 <= t ? w.z : 0.f, s0 + 3 <= t ? w.w : 0.f);
                *(LAS u32x2*)(lds + GM_W + t * GM_PITCH + s0 * 2) = o; }
            { u32x4 ra[4], rb[4];
#pragma unroll
              for (int it = 0; it < 4; ++it) { const int q = tid + it * NTHR, l = q & 63, wq = q >> 6; const int sp = 16 * (wq & 3) + (l & 15), oc = 4 * (wq >> 2) + (l >> 4);
                  const bf16_t* src = GV + (cstart + 2 * sp) * DC + h * 256 + 8 * oc; ra[it] = *(const u32x4*)src; rb[it] = *(const u32x4*)(src + DC); }
#pragma unroll
              for (int it = 0; it < 4; ++it) { const int q = tid + it * NTHR, l = q & 63, wq = q >> 6; const int sp = 16 * (wq & 3) + (l & 15), oc = 4 * (wq >> 2) + (l >> 4);
                  const int col = h * 256 + 8 * oc; const f32x4 ga = *(const f32x4*)(lg + col), gb = *(const f32x4*)(lg + col + 4), ba = *(const f32x4*)(lb_ + col), bb = *(const f32x4*)(lb_ + col + 4);
                  const float m0 = smean[2 * sp], r0s = srstd[2 * sp], m1 = smean[2 * sp + 1], r1s = srstd[2 * sp + 1];
                  float x[8], y[8];
                  x[0] = (bflo(ra[it].x) - m0) * r0s * ga.x + ba.x; x[1] = (bfhi(ra[it].x) - m0) * r0s * ga.y + ba.y; x[2] = (bflo(ra[it].y) - m0) * r0s * ga.z + ba.z; x[3] = (bfhi(ra[it].y) - m0) * r0s * ga.w + ba.w;
                  x[4] = (bflo(ra[it].z) - m0) * r0s * gb.x + bb.x; x[5] = (bfhi(ra[it].z) - m0) * r0s * gb.y + bb.y; x[6] = (bflo(ra[it].w) - m0) * r0s * gb.z + bb.z; x[7] = (bfhi(ra[it].w) - m0) * r0s * gb.w + bb.w;
                  y[0] = (bflo(rb[it].x) - m1) * r1s * ga.x + ba.x; y[1] = (bfhi(rb[it].x) - m1) * r1s * ga.y + ba.y; y[2] = (bflo(rb[it].y) - m1) * r1s * ga.z + ba.z; y[3] = (bfhi(rb[it].y) - m1) * r1s * ga.w + ba.w;
                  y[4] = (bflo(rb[it].z) - m1) * r1s * gb.x + bb.x; y[5] = (bfhi(rb[it].z) - m1) * r1s * gb.y + bb.y; y[6] = (bflo(rb[it].w) - m1) * r1s * gb.z + bb.z; y[7] = (bfhi(rb[it].w) - m1) * r1s * gb.w + bb.w;
                  LAS unsigned char* vp = lds + GM_VT + (8 * oc) * GM_PITCH + sp * 4;
#pragma unroll
                  for (int e = 0; e < 8; ++e) *(LAS unsigned*)(vp + e * GM_PITCH) = pk2(x[e], y[e]);
                  if (lastchunk) { float* o = p.out + O_GP + ((size_t)bseq * 128 + 2 * sp) * DC + col;
                      *(f32x4*)o = (f32x4){x[0], x[1], x[2], x[3]}; *(f32x4*)(o + 4) = (f32x4){x[4], x[5], x[6], x[7]};
                      *(f32x4*)(o + DC) = (f32x4){y[0], y[1], y[2], y[3]}; *(f32x4*)(o + DC + 4) = (f32x4){y[4], y[5], y[6], y[7]}; }
              } }
            __syncthreads();
            f32x16 acc[4];
#pragma unroll
            for (int mt = 0; mt < 4; ++mt)
#pragma unroll
                for (int r = 0; r < 16; ++r) acc[mt][r] = 0.f;
#pragma unroll
            for (int ks = 0; ks < 8; ++ks) { const bf16x8 b = ldfrag(lds + GM_VT, GM_PITCH, 32 * wid, 16 * ks, lane);
#pragma unroll
                for (int mt = 0; mt < 4; ++mt) if (ks < 2 * (mt + 1)) { const bf16x8 a = ldfrag(lds + GM_W, GM_PITCH, 32 * mt, 16 * ks, lane); acc[mt] = MFMA32(a, b, acc[mt]); } }
            u32x4 ugv[8];
#pragma unroll
            for (int it = 0; it < 8; ++it) { const int q = tid + it * NTHR; ugv[it] = *(const u32x4*)(UG + (cstart + (q >> 5)) * DC + h * 256 + 8 * (q & 31)); }
            __syncthreads();
            { const int lnm = opaque(lane); LAS unsigned char* mp = lds + GM_VT + (4 * (lnm >> 5)) * 528 + (32 * wid + (lnm & 31)) * 2; const float* bp = bs + h * 128 + 4 * (lnm >> 5);
#pragma unroll
              for (int mt = 0; mt < 4; ++mt)
#pragma unroll
                  for (int r = 0; r < 16; ++r) { const int tr = 32 * mt + (r & 3) + 8 * (r >> 2); *(LAS bf16_t*)(mp + tr * 528) = (bf16_t)f2bf(acc[mt][r] + bp[tr]); } }
            __syncthreads();
#pragma unroll
            for (int it = 0; it < 8; ++it) { const int q = tid + it * NTHR; const int t = q >> 5, oc = q & 31;
                const u32x4 m = *(const LAS u32x4*)(lds + GM_VT + t * 528 + oc * 16); const u32x4 u = ugv[it]; u32x4 o;
                o.x = pk2(bflo(u.x) * bflo(m.x), bfhi(u.x) * bfhi(m.x)); o.y = pk2(bflo(u.y) * bflo(m.y), bfhi(u.y) * bfhi(m.y));
                o.z = pk2(bflo(u.z) * bflo(m.z), bfhi(u.z) * bfhi(m.z)); o.w = pk2(bflo(u.w) * bflo(m.w), bfhi(u.w) * bfhi(m.w));
                *(u32x4*)(UG + (cstart + t) * DC + h * 256 + 8 * oc) = o; }
        }
    }
}


__device__ __forceinline__ void gmlp_sample(const Params& p, LAS unsigned char* lds, int vb, int G) {
    LAS float* smean = (LAS float*)(lds + GM_MR); LAS float* srstd = smean + 128;
    const f32x2* VST = (const f32x2*)(p.ws + WS_VST); const bf16_t* GV = (const bf16_t*)p.out; bf16_t* UG = (bf16_t*)(p.ws + WS_UG);
    const float *lg = p.in[15], *lb_ = p.in[16], *wsp = p.in[17], *bs = p.in[18];
    const int tid = opaque((int)threadIdx.x), ch = tid * 4; const int h = __builtin_amdgcn_readfirstlane(tid >> 6);
    const f32x4 g4 = *(const f32x4*)(lg + ch), b4 = *(const f32x4*)(lb_ + ch);
    for (int sb = vb; sb < 128; sb += G) {
        const size_t r0 = (size_t)TP + sb * 8;
        __syncthreads();
        if (tid < 64) { const int t = tid >> 3, q = tid & 7; const f32x4* sp = (const f32x4*)(VST + (r0 + t) * 32 + q * 4); const f32x4 a = sp[0], b = sp[1];
            float s_ = (a.x + a.z) + (b.x + b.z), q_ = (a.y + a.w) + (b.y + b.w);
            s_ += __shfl_xor(s_, 1); q_ += __shfl_xor(q_, 1); s_ += __shfl_xor(s_, 2); q_ += __shfl_xor(q_, 2); s_ += __shfl_xor(s_, 4); q_ += __shfl_xor(q_, 4);
            const float mean = s_ * (1.f / 2048.f); const float var = q_ * (1.f / 2048.f) - mean * mean;
            if (q == 0) { smean[t] = mean; srstd[t] = rsqrtf(var + EPS); } }
        u32x2 gvw[8], ugw[8];
#pragma unroll
        for (int t = 0; t < 8; ++t) { gvw[t] = *(const u32x2*)(GV + (r0 + t) * DC + ch); ugw[t] = *(const u32x2*)(UG + (r0 + t) * DC + ch); }
        __syncthreads();
        float vn[8][4];
#pragma unroll
        for (int sx = 0; sx < 8; ++sx) { const float m = smean[sx], rs = srstd[sx];
            vn[sx][0] = (bflo(gvw[sx].x) - m) * rs * g4.x + b4.x; vn[sx][1] = (bfhi(gvw[sx].x) - m) * rs * g4.y + b4.y; vn[sx][2] = (bflo(gvw[sx].y) - m) * rs * g4.z + b4.z; vn[sx][3] = (bfhi(gvw[sx].y) - m) * rs * g4.w + b4.w; }
#pragma unroll
        for (int t = 0; t < 8; ++t) { const float bias = bs[h * 128 + t]; float a0 = bias, a1 = bias, a2 = bias, a3 = bias;
#pragma unroll
            for (int sx = 0; sx <= t; ++sx) { const float w = wsp[(size_t)(h * 128 + t) * 128 + sx]; a0 += w * vn[sx][0]; a1 += w * vn[sx][1]; a2 += w * vn[sx][2]; a3 += w * vn[sx][3]; }
            u32x2 o; o.x = pk2(bflo(ugw[t].x) * a0, bfhi(ugw[t].x) * a1); o.y = pk2(bflo(ugw[t].y) * a2, bfhi(ugw[t].y) * a3);
            *(u32x2*)(UG + (r0 + t) * DC + ch) = o;
            *(f32x4*)(p.out + O_GS + ((size_t)sb * 8 + t) * DC + ch) = (f32x4){vn[t][0], vn[t][1], vn[t][2], vn[t][3]}; }
    }
}

__device__ __forceinline__ void final_norm(const Params& p, int vb, int G) {
    const int tid = opaque((int)threadIdx.x), lane = tid & 63, wave = tid >> 6;
    const int gw = vb * NWAVES + wave, NGW = G * NWAVES;
    const float* SSP = (const float*)(p.ws + WS_SSP2); const float* g = p.in[20];
    f32x4 gg[4];
#pragma unroll
    for (int j = 0; j < 4; ++j) gg[j] = ((const f32x4*)g)[lane + 64 * j];
    for (int r = gw; r < T; r += 2 * NGW) {
        const int r2 = (r + NGW < T) ? r + NGW : r;
        f32x4* y = (f32x4*)(p.out + (size_t)r * D) + lane; f32x4* y2 = (f32x4*)(p.out + (size_t)r2 * D) + lane;
        f32x4 v[4], w[4];
#pragma unroll
        for (int j = 0; j < 4; ++j) { v[j] = y[64 * j]; w[j] = y2[64 * j]; }
        float rs, rs2;
        { const f32x4* s = (const f32x4*)(SSP + (size_t)r * 16); const f32x4 a = s[0], b = s[1], c = s[2], d = s[3];
          rs = rsqrtf((((a.x + a.y) + (a.z + a.w)) + ((b.x + b.y) + (b.z + b.w)) + ((c.x + c.y) + (c.z + c.w)) + ((d.x + d.y) + (d.z + d.w))) * (1.f / 1024.f) + EPS); }
        { const f32x4* s = (const f32x4*)(SSP + (size_t)r2 * 16); const f32x4 a = s[0], b = s[1], c = s[2], d = s[3];
          rs2 = rsqrtf((((a.x + a.y) + (a.z + a.w)) + ((b.x + b.y) + (b.z + b.w)) + ((c.x + c.y) + (c.z + c.w)) + ((d.x + d.y) + (d.z + d.w))) * (1.f / 1024.f) + EPS); }
#pragma unroll
        for (int j = 0; j < 4; ++j) { f32x4 o = v[j]; o.x *= rs * gg[j].x; o.y *= rs * gg[j].y; o.z *= rs * gg[j].z; o.w *= rs * gg[j].w; y[64 * j] = o; }
        if (r2 != r) {
#pragma unroll
            for (int j = 0; j < 4; ++j) { f32x4 o = w[j]; o.x *= rs2 * gg[j].x; o.y *= rs2 * gg[j].y; o.z *= rs2 * gg[j].z; o.w *= rs2 * gg[j].w; y2[64 * j] = o; } }
    }
}

__global__ void __launch_bounds__(NTHR, 2) fwd_kernel(Params p) {
    extern __shared__ __attribute__((aligned(16))) unsigned char lds_raw[];
    LAS unsigned char* lds = (LAS unsigned char*)lds_raw;
    { volatile LAS unsigned* st0 = (volatile LAS unsigned*)(lds + LDS_BYTES - 64); if (threadIdx.x < 16) st0[threadIdx.x] = 0u; }
    __syncthreads();
    const XcdBarrier bar = xcd_barrier_post((unsigned*)p.ws, (volatile LAS unsigned*)(lds + LDS_BYTES - 64));
    const int G = gridDim.x, vb = blockIdx.x;
    unsigned long long stamps[16];
#define STAMP(k) do { if (PROBE_A >= 0) stamps[k] = __builtin_amdgcn_s_memrealtime(); } while (0)
    STAMP(0);
    bf16_t* WT1 = (bf16_t*)(p.ws + WS_WT1); bf16_t* WT2 = (bf16_t*)(p.ws + WS_WT2); bf16_t* WT3 = (bf16_t*)(p.ws + WS_WT3); bf16_t* WT4 = (bf16_t*)(p.ws + WS_WT4);
    bf16_t* ZR = (bf16_t*)(p.ws + WS_R1);

    phase0(p, lds, vb, G);
    xcd_barrier(bar); STAMP(1);
    { Epi1 E{ZR, (const float*)(p.ws + WS_LB)}; GEMM(lds, (const bf16_t*)p.out, WT1, T, N1, D, E, vb, G); STAMP(14); }
    xcd_barrier(bar); STAMP(2);
    hgrn_phaseA(p, lds, vb, G); STAMP(10);
    hgrn_sample(p, lds, vb, G); STAMP(11);
    conv_fast(p, lds, vb, G); STAMP(12);
    xcd_barrier(bar); STAMP(3);
    hgrn_phaseB(p, lds, vb, G);
    xcd_barrier(bar); STAMP(4);
    { Epi2 E{p.in[0], p.in[1], (float*)(p.ws + WS_X1), (bf16_t*)(p.ws + WS_X1B), (float*)(p.ws + WS_SSP1)}; GEMM(lds, (const bf16_t*)p.out, WT2, TP, D, 2048, E, vb, G); STAMP(15); gemm_small<Epi2, 8>(lds, (const bf16_t*)p.out + (size_t)TP * 2048, WT2, D, 2048, E, TP, vb, G); }
    xcd_barrier(bar); STAMP(5);
    { Epi3 E{(const float*)(p.ws + WS_SSP1), (bf16_t*)(p.ws + WS_UG), (bf16_t*)p.out, (f32x2*)(p.ws + WS_VST)}; GEMM(lds, (const bf16_t*)(p.ws + WS_X1B), WT3, T, N3, D, E, vb, G); }
    xcd_barrier(bar); STAMP(6);
    gmlp_fast(p, lds, vb, G); STAMP(13);
    gmlp_sample(p, lds, vb, G);
    xcd_barrier(bar); STAMP(7);
    { Epi4 E{(const float*)(p.ws + WS_X1), p.out, (float*)(p.ws + WS_SSP2)}; GEMM(lds, (const bf16_t*)(p.ws + WS_UG), WT4, TP, D, 2048, E, vb, G); gemm_small<Epi4, 8>(lds, (const bf16_t*)(p.ws + WS_UG) + (size_t)TP * 2048, WT4, D, 2048, E, TP, vb, G); }
    xcd_barrier(bar); STAMP(8);
    final_norm(p, vb, G);
    STAMP(9);
    if (PROBE_A >= 0 && blockIdx.x == 0 && threadIdx.x == 0) {
#ifdef PROBE_EXPR
        const unsigned long long da = PROBE_EXPR;
#else
        const unsigned long long da = stamps[PROBE_B] - stamps[PROBE_A];
#endif
        const unsigned long long wait = 8ull * da, t0 = __builtin_amdgcn_s_memrealtime();
        while (__builtin_amdgcn_s_memrealtime() - t0 < wait) __builtin_amdgcn_s_sleep(32);
    }
}

extern "C" void kernel_launch(void* const* d_in, const int* in_sizes, int n_in, void* d_out, int out_size, void* d_ws, size_t ws_size, hipStream_t stream) {
    static int grid = 0;
    if (grid == 0) {
        if (n_in != 21 || (size_t)out_size != O_END || ws_size < WS_END) { fprintf(stderr, "kernel_launch: unexpected shapes: n_in %d out %d ws %zu\n", n_in, out_size, ws_size); grid = -1; return; }
        int dev = 0, cus = 0, per_cu = 0;
        if (hipGetDevice(&dev) != hipSuccess || hipDeviceGetAttribute(&cus, hipDeviceAttributeMultiprocessorCount, dev) != hipSuccess) { grid = -1; return; }
        if (hipFuncSetAttribute((const void*)fwd_kernel, hipFuncAttributeMaxDynamicSharedMemorySize, LDS_BYTES) != hipSuccess) { fprintf(stderr, "kernel_launch: hipFuncSetAttribute failed\n"); grid = -1; return; }
        if (hipOccupancyMaxActiveBlocksPerMultiprocessor(&per_cu, (const void*)fwd_kernel, NTHR, LDS_BYTES) != hipSuccess || per_cu < 1) { fprintf(stderr, "kernel_launch: occupancy query says %d\n", per_cu); grid = -1; return; }
        grid = cus;
    }
    if (grid < 0) return;
    if (hipMemsetAsync(d_ws, 0, 16384, stream) != hipSuccess) { fprintf(stderr, "kernel_launch: memset failed\n"); return; }
    Params p{};
    for (int i = 0; i < 21; ++i) p.in[i] = (const float*)d_in[i];
    p.out = (float*)d_out; p.ws = (unsigned char*)d_ws;
    void* args[] = {&p};
    hipError_t e = hipLaunchCooperativeKernel((const void*)fwd_kernel, dim3(grid), dim3(NTHR), args, LDS_BYTES, stream);
    if (e != hipSuccess) fprintf(stderr, "kernel_launch: cooperative launch failed: %s (grid %d)\n", hipGetErrorString(e), grid);
}
```

```cpp
#include <hip/hip_runtime.h>
#include <cstdio>
#include <cstdint>

#ifndef PROBE_A
#define PROBE_A -1
#define PROBE_B -1
#endif
#ifndef FAST_GEMM
#define FAST_GEMM 1
#endif

#define LAS __attribute__((address_space(3)))
typedef unsigned short bf16_t;
typedef short bf16x8 __attribute__((ext_vector_type(8)));
typedef float f32x4 __attribute__((ext_vector_type(4)));
typedef float f32x2 __attribute__((ext_vector_type(2)));
typedef unsigned u32x4 __attribute__((ext_vector_type(4)));
typedef unsigned u32x2 __attribute__((ext_vector_type(2)));

constexpr int D = 1024, TP = 16384, TS = 1024, T = TP + TS;
constexpr int N1 = 7168, N3 = 6144, DC = 2048;
constexpr float EPS = 1e-6f;
constexpr int NWAVES = 8, NTHR = 512;
constexpr int LDS_BYTES = 147456;
constexpr size_t MiB = (size_t)1 << 20;
constexpr size_t WS_LB = 65536;
constexpr size_t WS_WT1 = 1 * MiB, WS_WT2 = 15 * MiB, WS_WT3 = 19 * MiB, WS_WT4 = 31 * MiB;
constexpr size_t WS_R1 = 35 * MiB;
constexpr size_t WS_X1 = WS_R1, WS_X1B = WS_R1 + 68 * MiB, WS_UG = WS_R1 + 102 * MiB;
constexpr size_t WS_SSP1 = WS_R1 + 170 * MiB, WS_VST = WS_R1 + 172 * MiB, WS_SSP2 = WS_R1 + 178 * MiB;
constexpr size_t WS_SEG = 239 * MiB;
constexpr size_t WS_END = 255 * MiB;
constexpr size_t O_YP = 0, O_YS = 16777216, O_CP = 17825792, O_HP = 18071552, O_GP = 19120128, O_CS = 21217280, O_HS = 25149440, O_GS = 41926656, O_END = 44023808;

struct Params { const float* in[21]; float* out; unsigned char* ws; };

__device__ __forceinline__ int opaque(int x) { asm volatile("" : "+v"(x)); return x; }
__device__ __forceinline__ float bf2f(unsigned b) { return __uint_as_float(b << 16); }
__device__ __forceinline__ float bflo(unsigned w) { return __uint_as_float(w << 16); }
__device__ __forceinline__ float bfhi(unsigned w) { return __uint_as_float(w & 0xffff0000u); }
__device__ __forceinline__ unsigned f2bf(float f) { unsigned u = __float_as_uint(f); return (u + 0x7fffu + ((u >> 16) & 1u)) >> 16; }
__device__ __forceinline__ unsigned pk2(float lo, float hi) { unsigned r; asm("v_cvt_pk_bf16_f32 %0, %1, %2" : "=v"(r) : "v"(lo), "v"(hi)); return r; }
__device__ __forceinline__ float sigm(float x) { return 1.0f / (1.0f + __expf(-x)); }
__device__ __forceinline__ float silu(float x) { return x * sigm(x); }
__device__ __forceinline__ float gelu_t(float x) { return x * sigm(1.5957691216057308f * (x + 0.044715f * x * x * x)); }
__device__ __forceinline__ float wave_sum(float v) {
#pragma unroll
    for (int o = 1; o < 64; o <<= 1) v += __shfl_xor(v, o);
    return v;
}
__device__ __forceinline__ void st8(bf16_t* p, const float (&v)[8]) {
    u32x4 w; w.x = pk2(v[0], v[1]); w.y = pk2(v[2], v[3]); w.z = pk2(v[4], v[5]); w.w = pk2(v[6], v[7]); *(u32x4*)p = w;
}
__device__ __forceinline__ float block_sum(float v, LAS float* red) {
    v = wave_sum(v);
    __syncthreads();
    if ((threadIdx.x & 63) == 0) red[threadIdx.x >> 6] = v;
    __syncthreads();
    float s = 0.f;
#pragma unroll
    for (int i = 0; i < 8; ++i) s += red[i];
    return s;
}


typedef __attribute__((address_space(1))) unsigned gu32;
#define XB_TMO      128
#define XB_XCNT(j)  (256  + 64 * (j))
#define XB_XSUB(j)  (1280 + 64 * (j))
#define XB_XGEN(j)  (2304 + 64 * (j))
#define XB_TOP      3328
#define XB_TOPGEN   3392
#define XCD_BAR_WORDS 3456
#define XB_SPIN_CAP (1u << 20)

__device__ __forceinline__ unsigned xb_ld(unsigned* p)              { return __hip_atomic_load(p, __ATOMIC_RELAXED, __HIP_MEMORY_SCOPE_AGENT); }
__device__ __forceinline__ unsigned xb_add(unsigned* p, unsigned v) { return __hip_atomic_fetch_add(p, v, __ATOMIC_RELAXED, __HIP_MEMORY_SCOPE_AGENT); }
__device__ __forceinline__ unsigned xb_xcc_id() { return (unsigned)__builtin_amdgcn_s_getreg((3 << 11) | 20) & 0xFu; }
#define XB_SPIN(cond, bar) do { unsigned _sp = 0; while (cond) { __builtin_amdgcn_s_sleep(1); \
    if ((++_sp & 255u) == 0u) { if (xb_ld(&(bar)[XB_TMO])) break; if (_sp > XB_SPIN_CAP) { atomicAdd(&(bar)[XB_TMO], 1u); break; } } } } while (0)

struct XcdBarrier {
    unsigned* bar; unsigned x;
    volatile LAS unsigned* st;
};

__device__ __forceinline__ XcdBarrier xcd_barrier_post(unsigned* bar, volatile LAS unsigned* st) {
    XcdBarrier b; b.bar = bar; b.x = xb_xcc_id(); b.st = st;
    if (threadIdx.x == 0) (void)xb_add(&bar[XB_XCNT(b.x)], 1u);
    return b;
}
__device__ __forceinline__ void xcd_barrier_complete(unsigned* bar, unsigned x, unsigned& nloc, unsigned& nx) {
    const unsigned G = gridDim.x * gridDim.y * gridDim.z;
    unsigned sum, cnt, mine, sp = 0u;
    for (;;) {
        sum = 0u; cnt = 0u; mine = 0u;
#pragma unroll
        for (unsigned j = 0; j < 16; ++j) { const unsigned c = xb_ld(&bar[XB_XCNT(j)]); sum += c; cnt += (c > 0u) ? 1u : 0u; mine = (j == x) ? c : mine; }
        if (sum == G) break;
        __builtin_amdgcn_s_sleep(1);
        if ((++sp & 255u) == 0u) { if (xb_ld(&bar[XB_TMO])) break; if (sp > XB_SPIN_CAP) { atomicAdd(&bar[XB_TMO], 1u); break; } }
    }
    nloc = mine > 0u ? mine : 1u; nx = cnt > 0u ? cnt : 1u;
}

__device__ __forceinline__ void xcd_barrier(const XcdBarrier& b) {
    asm volatile("s_waitcnt vmcnt(0)" ::: "memory");
    __syncthreads();
    if (threadIdx.x == 0) {
        unsigned* bar = b.bar;
        __builtin_amdgcn_s_waitcnt(0);
        unsigned nloc = b.st[0], nx = b.st[1];
        if (nloc == 0u) { xcd_barrier_complete(bar, b.x, nloc, nx); b.st[0] = nloc; b.st[1] = nx; }
        const unsigned old = xb_add(&bar[XB_XSUB(b.x)], 1u);
        const unsigned gen = old / nloc;
        if (old + 1u == (gen + 1u) * nloc) {
            __builtin_amdgcn_fence(__ATOMIC_RELEASE, "agent");
            asm volatile("s_waitcnt vmcnt(0)" ::: "memory");
            const unsigned og = xb_add(&bar[XB_TOP], 1u);
            const unsigned tg = og / nx;
            if (og + 1u == (tg + 1u) * nx) xb_add(&bar[XB_TOPGEN], 1u);
            else XB_SPIN(xb_ld(&bar[XB_TOPGEN]) == tg, bar);
            __builtin_amdgcn_fence(__ATOMIC_ACQUIRE, "agent");
            xb_add(&bar[XB_XGEN(b.x)], 1u);
            asm volatile("s_waitcnt vmcnt(0)" ::: "memory");
        } else {
            XB_SPIN(xb_ld(&bar[XB_XGEN(b.x)]) == gen, bar);
            __builtin_amdgcn_fence(__ATOMIC_ACQUIRE, "agent");
            asm volatile("s_waitcnt vmcnt(0)" ::: "memory");
        }
    }
    __syncthreads();
}

template <int MAP> __device__ __forceinline__ int vmap(int vc) {
    const int vt = vc >> 8, c = vc & 255;
    if (MAP == 1) return vt < 8 ? (c < 128 ? 128 * vt + c : 1024 + 128 * vt + (c - 128)) : vc;
    if (MAP == 3) return vt < 16 ? (c < 128 ? 128 * vt + c : 4096 + 128 * vt + (c - 128)) : vc - 2048;
    return vc;
}

template <int MAP> __device__ __forceinline__ void transpose_item(const float* W, int K, int N, bf16_t* WT, const float* kscale, LAS float* scr, int item, int lane) {
    const int nblk = N / 32, kb = item / nblk, nb = item % nblk, k0 = 64 * kb, n0 = 32 * nb;
    const int on0 = vmap<MAP>(n0);
#pragma unroll 8
    for (int i = 0; i < 32; ++i) { const int kk = 2 * i + (lane >> 5); float w = W[(size_t)(k0 + kk) * N + on0 + (lane & 31)]; if (kscale) w *= kscale[k0 + kk]; scr[kk * 33 + (lane & 31)] = w; }
    asm volatile("s_waitcnt lgkmcnt(0)" ::: "memory");
    const int c = lane & 7;
#pragma unroll
    for (int j = 0; j < 4; ++j) { const int n = (lane >> 3) + 8 * j; const LAS float* s = scr + (8 * c) * 33 + n;
        u32x4 o; o.x = pk2(s[0 * 33], s[1 * 33]); o.y = pk2(s[2 * 33], s[3 * 33]); o.z = pk2(s[4 * 33], s[5 * 33]); o.w = pk2(s[6 * 33], s[7 * 33]);
        *(u32x4*)(WT + (size_t)(n0 + n) * K + k0 + 8 * c) = o; }
    asm volatile("s_waitcnt lgkmcnt(0)" ::: "memory");
}
__device__ __forceinline__ void rms_row_to_bf16(const float* xrow, const float* g, bf16_t* orow, int lane) {
    const f32x4* xr = (const f32x4*)xrow + lane; f32x4 v[4]; float s = 0.f;
#pragma unroll
    for (int j = 0; j < 4; ++j) { v[j] = xr[64 * j]; s += (v[j].x * v[j].x + v[j].y * v[j].y) + (v[j].z * v[j].z + v[j].w * v[j].w); }
    const float rs = rsqrtf(wave_sum(s) * (1.f / 1024.f) + EPS);
    u32x2* o8 = (u32x2*)orow + lane;
#pragma unroll
    for (int j = 0; j < 4; ++j) { const f32x4 gg = ((const f32x4*)g)[lane + 64 * j]; u32x2 w; w.x = pk2(v[j].x * rs * gg.x, v[j].y * rs * gg.y); w.y = pk2(v[j].z * rs * gg.z, v[j].w * rs * gg.w); o8[64 * j] = w; }
}
__device__ __forceinline__ void phase0(const Params& p, LAS unsigned char* lds, int vb, int G) {
    const int tid = opaque((int)threadIdx.x), lane = tid & 63, wave = tid >> 6;
    const int gw = vb * NWAVES + wave, NGW = G * NWAVES;
    float* LB = (float*)(p.ws + WS_LB);
    for (int i = vb * NTHR + tid; i < 1024; i += G * NTHR) { const float l0 = p.in[10][i], l1 = p.in[10][1024 + i]; LB[i] = 1.0f / (1.0f + __expf(l1 - l0)); }
    LAS float* scr = (LAS float*)(lds + wave * 16384);
    constexpr int I1 = (D / 64) * (N1 / 32), I2 = (2048 / 64) * (D / 32), I3 = (D / 64) * (N3 / 32), I4 = I2;
    for (int it = gw; it < I1 + I2 + I3 + I4; it += NGW) {
        int r = it;
        if (r < I1) { transpose_item<1>(p.in[5], D, N1, (bf16_t*)(p.ws + WS_WT1), nullptr, scr, r, lane); continue; } r -= I1;
        if (r < I2) { transpose_item<0>(p.in[12], 2048, D, (bf16_t*)(p.ws + WS_WT2), nullptr, scr, r, lane); continue; } r -= I2;
        if (r < I3) { transpose_item<3>(p.in[14], D, N3, (bf16_t*)(p.ws + WS_WT3), p.in[13], scr, r, lane); continue; } r -= I3;
        transpose_item<0>(p.in[19], 2048, D, (bf16_t*)(p.ws + WS_WT4), nullptr, scr, r, lane);
    }
    bf16_t* XN0 = (bf16_t*)p.out;
    for (int r = gw; r < T; r += NGW) { const float* xr = r < TP ? p.in[0] + (size_t)r * D : p.in[1] + (size_t)(r - TP) * D; rms_row_to_bf16(xr, p.in[4], XN0 + (size_t)r * D, lane); }
}

struct Epi1 {
    bf16_t* Z; const float* LB;
    __device__ __forceinline__ float rowscale(int) const { return 1.f; }
    template <int X1M, int X2M> __device__ __forceinline__ void tile8(int row, int pn, int c0, const float (&lo)[8], const float (&hi)[8], float) const {
        if (pn < 8) { float a[8];
#pragma unroll
            for (int i = 0; i < 8; ++i) a[i] = lo[i] * sigm(hi[i]);
            st8(Z + (size_t)row * 1024 + 128 * pn + c0, a);
        } else {
            const int g = (pn - 8) >> 2, col = ((pn - 8) & 3) * 256 + c0;
            bf16_t* base = Z + (size_t)(g + 1) * T * 1024 + (size_t)row * 1024 + col;
            float x[8], y[8];
            if (g == 1) {
#pragma unroll
                for (int i = 0; i < 8; ++i) { x[i] = lo[i]; y[i] = hi[i]; }
            } else if (g == 2) {
#pragma unroll
                for (int i = 0; i < 8; ++i) { const float l0 = LB[col + i], l1 = LB[col + 128 + i]; x[i] = __logf(l0 + (1.f - l0) * sigm(lo[i])); y[i] = __logf(l1 + (1.f - l1) * sigm(hi[i])); }
            } else {
#pragma unroll
                for (int i = 0; i < 8; ++i) { x[i] = silu(lo[i]); y[i] = silu(hi[i]); }
            }
            st8(base, x); st8(base + 128, y);
        }
    }
};
struct Epi2 {
    const float* xp; const float* xs; float* X1; bf16_t* X1B; float* SSP;
    __device__ __forceinline__ float rowscale(int) const { return 1.f; }
    template <int X1M, int X2M> __device__ __forceinline__ void tile8(int row, int pn, int c0, const float (&lo)[8], const float (&hi)[8], float) const {
        const int col = 256 * pn + c0;
        const float* xr = (row < TP ? xp + (size_t)row * D : xs + (size_t)(row - TP) * D) + col;
        const f32x4 a0 = *(const f32x4*)xr, a1 = *(const f32x4*)(xr + 4), b0 = *(const f32x4*)(xr + 128), b1 = *(const f32x4*)(xr + 132);
        float v[8], w[8];
        v[0] = a0.x + lo[0]; v[1] = a0.y + lo[1]; v[2] = a0.z + lo[2]; v[3] = a0.w + lo[3]; v[4] = a1.x + lo[4]; v[5] = a1.y + lo[5]; v[6] = a1.z + lo[6]; v[7] = a1.w + lo[7];
        w[0] = b0.x + hi[0]; w[1] = b0.y + hi[1]; w[2] = b0.z + hi[2]; w[3] = b0.w + hi[3]; w[4] = b1.x + hi[4]; w[5] = b1.y + hi[5]; w[6] = b1.z + hi[6]; w[7] = b1.w + hi[7];
        float* o = X1 + (size_t)row * D + col;
        *(f32x4*)o = (f32x4){v[0], v[1], v[2], v[3]}; *(f32x4*)(o + 4) = (f32x4){v[4], v[5], v[6], v[7]};
        *(f32x4*)(o + 128) = (f32x4){w[0], w[1], w[2], w[3]}; *(f32x4*)(o + 132) = (f32x4){w[4], w[5], w[6], w[7]};
        bf16_t* ob = X1B + (size_t)row * D + col; st8(ob, v); st8(ob + 128, w);
        float ss = 0.f;
#pragma unroll
        for (int i = 0; i < 8; ++i) ss += v[i] * v[i] + w[i] * w[i];
        ss += __shfl_xor(ss, X1M); ss += __shfl_xor(ss, X2M);
        if ((c0 & 31) == 0) SSP[(size_t)row * 16 + pn * 4 + (c0 >> 5)] = ss;
    }
};
struct Epi3 {
    const float* SSP1; bf16_t* UG; bf16_t* GV; f32x2* VST;
    __device__ __forceinline__ float rowscale(int row) const {
        const f32x4* s = (const f32x4*)(SSP1 + (size_t)row * 16); const f32x4 a = s[0], b = s[1], c = s[2], d = s[3];
        const float t = ((a.x + a.y) + (a.z + a.w)) + ((b.x + b.y) + (b.z + b.w)) + ((c.x + c.y) + (c.z + c.w)) + ((d.x + d.y) + (d.z + d.w));
        return rsqrtf(t * (1.f / 1024.f) + EPS);
    }
    template <int X1M, int X2M> __device__ __forceinline__ void tile8(int row, int pn, int c0, const float (&lo)[8], const float (&hi)[8], float rs) const {
        if (pn < 16) { float a[8];
#pragma unroll
            for (int i = 0; i < 8; ++i) a[i] = gelu_t(lo[i] * rs) * silu(hi[i] * rs);
            st8(UG + (size_t)row * DC + 128 * pn + c0, a);
        } else {
            const int col = 256 * (pn - 16) + c0; float x[8], y[8], s = 0.f, q = 0.f;
#pragma unroll
            for (int i = 0; i < 8; ++i) { x[i] = gelu_t(lo[i] * rs); y[i] = gelu_t(hi[i] * rs); s += x[i] + y[i]; q += x[i] * x[i] + y[i] * y[i]; }
            bf16_t* o = GV + (size_t)row * DC + col; st8(o, x); st8(o + 128, y);
            s += __shfl_xor(s, X1M); q += __shfl_xor(q, X1M); s += __shfl_xor(s, X2M); q += __shfl_xor(q, X2M);
            if ((c0 & 31) == 0) VST[(size_t)row * 32 + (pn - 16) * 4 + (c0 >> 5)] = (f32x2){s, q};
        }
    }
};
struct Epi4 {
    const float* X1; float* Y; float* SSP;
    __device__ __forceinline__ float rowscale(int) const { return 1.f; }
    template <int X1M, int X2M> __device__ __forceinline__ void tile8(int row, int pn, int c0, const float (&lo)[8], const float (&hi)[8], float) const {
        const int col = 256 * pn + c0;
        const float* xr = X1 + (size_t)row * D + col;
        const f32x4 a0 = *(const f32x4*)xr, a1 = *(const f32x4*)(xr + 4), b0 = *(const f32x4*)(xr + 128), b1 = *(const f32x4*)(xr + 132);
        float v[8], w[8];
        v[0] = a0.x + lo[0]; v[1] = a0.y + lo[1]; v[2] = a0.z + lo[2]; v[3] = a0.w + lo[3]; v[4] = a1.x + lo[4]; v[5] = a1.y + lo[5]; v[6] = a1.z + lo[6]; v[7] = a1.w + lo[7];
        w[0] = b0.x + hi[0]; w[1] = b0.y + hi[1]; w[2] = b0.z + hi[2]; w[3] = b0.w + hi[3]; w[4] = b1.x + hi[4]; w[5] = b1.y + hi[5]; w[6] = b1.z + hi[6]; w[7] = b1.w + hi[7];
        float* o = Y + (size_t)row * D + col;
        *(f32x4*)o = (f32x4){v[0], v[1], v[2], v[3]}; *(f32x4*)(o + 4) = (f32x4){v[4], v[5], v[6], v[7]};
        *(f32x4*)(o + 128) = (f32x4){w[0], w[1], w[2], w[3]}; *(f32x4*)(o + 132) = (f32x4){w[4], w[5], w[6], w[7]};
        float ss = 0.f;
#pragma unroll
        for (int i = 0; i < 8; ++i) ss += v[i] * v[i] + w[i] * w[i];
        ss += __shfl_xor(ss, X1M); ss += __shfl_xor(ss, X2M);
        if ((c0 & 31) == 0) SSP[(size_t)row * 16 + pn * 4 + (c0 >> 5)] = ss;
    }
};

template <class Epi> __device__ __forceinline__ void gemm_simple(LAS unsigned char* lds, const bf16_t* A, const bf16_t* Bt, int M, int N, int K, const Epi& E, int vb, int G) {
    LAS bf16_t* sA = (LAS bf16_t*)lds;
    LAS bf16_t* sB = (LAS bf16_t*)(lds + 4096);
    const int tid = opaque((int)threadIdx.x), r = tid >> 4, c0 = (tid & 15) * 8;
    const int nN = N / 256, nunits = (M / 32) * nN;
    for (int u = vb; u < nunits; u += G) {
        const int ms = u / nN, pn = u % nN, row0 = ms * 32, col0 = pn * 256;
        float lo[8], hi[8];
#pragma unroll
        for (int i = 0; i < 8; ++i) { lo[i] = 0.f; hi[i] = 0.f; }
        for (int k0 = 0; k0 < K; k0 += 32) {
            __syncthreads();
            if (tid < 128) { const int rr = tid >> 2, kc = (tid & 3) * 8; *(LAS u32x4*)(sA + rr * 40 + kc) = *(const u32x4*)(A + (size_t)(row0 + rr) * K + k0 + kc); }
            for (int q = tid; q < 1024; q += NTHR) { const int rr = q >> 2, kc = (q & 3) * 8; *(LAS u32x4*)(sB + rr * 40 + kc) = *(const u32x4*)(Bt + (size_t)(col0 + rr) * K + k0 + kc); }
            __syncthreads();
#pragma unroll 1
            for (int kc = 0; kc < 32; kc += 8) {
                const u32x4 av = *(const LAS u32x4*)(sA + r * 40 + kc);
                const float a0 = bflo(av.x), a1 = bfhi(av.x), a2 = bflo(av.y), a3 = bfhi(av.y), a4 = bflo(av.z), a5 = bfhi(av.z), a6 = bflo(av.w), a7 = bfhi(av.w);
#pragma unroll
                for (int i = 0; i < 8; ++i) {
                    const u32x4 b = *(const LAS u32x4*)(sB + (c0 + i) * 40 + kc);
                    lo[i] += a0 * bflo(b.x) + a1 * bfhi(b.x) + a2 * bflo(b.y) + a3 * bfhi(b.y) + a4 * bflo(b.z) + a5 * bfhi(b.z) + a6 * bflo(b.w) + a7 * bfhi(b.w);
                    const u32x4 c = *(const LAS u32x4*)(sB + (128 + c0 + i) * 40 + kc);
                    hi[i] += a0 * bflo(c.x) + a1 * bfhi(c.x) + a2 * bflo(c.y) + a3 * bfhi(c.y) + a4 * bflo(c.z) + a5 * bfhi(c.z) + a6 * bflo(c.w) + a7 * bfhi(c.w);
                }
            }
        }
        const int row = row0 + r; const float rsc = E.rowscale(row);
        E.template tile8<1, 2>(row, pn, c0, lo, hi, rsc);
    }
}

namespace pg8 {
#define PG8_LAS __attribute__((address_space(3)))
constexpr int BM = 256, BK = 64, HALF = 128, HTB = HALF * BK * 2  , STAGE_BYTES = 8 * HTB, NXCD = 8, WGM = 8;

__host__ __device__ __forceinline__ int lds_byte(int r, int c) { const int st = (r >> 4) * 2 + (c >> 5), rr = r & 15, cc = c & 31, ob = rr * 64 + cc * 2; return st * 1024 + (ob ^ (((ob >> 9) & 1) << 5)); }
__host__ __device__ __forceinline__ void stage_rc(int b, int& R, int& C) { const int st = b / 1024, sb = b % 1024, swz = sb ^ (((sb >> 9) & 1) << 5); R = (st >> 1) * 16 + swz / 64; C = (st & 1) * 32 + (swz % 64) / 2; }
__host__ __device__ __forceinline__ int perm32(int rho) { const int n = rho >> 4, i = rho & 15; return 8 * (i >> 2) + 4 * n + (i & 3); }

struct Unit { int pm, pn; };
struct Gemm { const bf16_t* A; const bf16_t* Bt; int M, N, K; };

struct StaticOrder {
    int nM, nN, nwg, G, c;
    __host__ __device__ void init(int M, int N, int G_, int c_) { nM = M / BM; nN = N / BM; nwg = nM * nN; G = G_; c = c_; }
    __host__ __device__ bool next(int i, Unit& u) const {
        const long L = (long)i * G + c; if (L >= nwg) return false;
        int wgid = (int)L; { const int q = nwg / NXCD, r = nwg % NXCD, xcd = wgid % NXCD, off = wgid / NXCD; wgid = (xcd < r ? xcd * (q + 1) : r * (q + 1) + (xcd - r) * q) + off; }
        const int nig = WGM * nN, gid = wgid / nig, fm = gid * WGM, gsz = (nM - fm) < WGM ? (nM - fm) : WGM;
        u.pm = fm + ((wgid % nig) % gsz); u.pn = (wgid % nig) / gsz; return true;
    }
    __device__ __forceinline__ void a_ready(const Unit&) const {}
    __device__ __forceinline__ void done(const Unit&) const {}
};
template <class Epi, class Sched, bool ALIGN_EPI = false, bool SP2 = false>
__device__ __forceinline__ void gemm_phase(PG8_LAS unsigned char* lds, const Gemm g, const Sched& S, const Epi& E) {
    const int tid = opaque((int)threadIdx.x), wid = __builtin_amdgcn_readfirstlane(tid >> 6), lane = tid & 63, wr = wid >> 2, wc = wid & 3, fr = lane & 15, fq = lane >> 4;
    const int K = g.K, nt = K / BK;
    unsigned voffA[2], voffB[2];
#pragma unroll
    for (int i = 0; i < 2; ++i) { int R, C; stage_rc(tid * 16 + i * 8192, R, C); const int Rb = Epi::PERM ? ((R & ~31) + perm32(R & 31)) : R;
        voffA[i] = (unsigned)(R * K + C) * 2u; voffB[i] = (unsigned)(Rb * K + C) * 2u; }
    const size_t kstep = (size_t)(BK * 2);
    const size_t hstep = (size_t)HALF * K * 2;
    const size_t tstep = 2 * hstep;
    const unsigned ldsw = (unsigned)wid * 1024u;
    const int aoff = lds_byte(wr * 64 + fr, fq * 8), boff = lds_byte(wc * 32 + fr, fq * 8);
#define PG8_SA(b, h) (((b) * 2 + (h)) * HTB)
#define PG8_SB(b, h) ((4 + (b) * 2 + (h)) * HTB)
#define PG8_STAGE(bufoff, gbase, voff) do { _Pragma("unroll") for (int _i = 0; _i < 2; ++_i) \
        __builtin_amdgcn_global_load_lds((const unsigned*)((const char*)(gbase) + (voff)[_i]), (PG8_LAS unsigned*)(lds + (bufoff) + ldsw + _i * 8192), 16, 0, 0); } while (0)
#define PG8_LDA(dst, b, h) do { _Pragma("unroll") for (int m = 0; m < 4; ++m) _Pragma("unroll") for (int k = 0; k < 2; ++k) dst[m][k] = *(const PG8_LAS bf16x8*)(lds + PG8_SA(b, h) + aoff + m * 2048 + k * 1024); } while (0)
#define PG8_LDB(dst, b, h) do { _Pragma("unroll") for (int n = 0; n < 2; ++n) _Pragma("unroll") for (int k = 0; k < 2; ++k) dst[n][k] = *(const PG8_LAS bf16x8*)(lds + PG8_SB(b, h) + boff + n * 2048 + k * 1024); } while (0)
#define PG8_MMA(ai, bj, At, Bt) do { __builtin_amdgcn_s_setprio(1); _Pragma("unroll") for (int m = 0; m < 4; ++m) _Pragma("unroll") for (int n = 0; n < 2; ++n) _Pragma("unroll") for (int k = 0; k < 2; ++k) \
        acc[ai][bj][m][n] = __builtin_amdgcn_mfma_f32_16x16x32_bf16(Bt[n][k], At[m][k], acc[ai][bj][m][n], 0, 0, 0); __builtin_amdgcn_s_setprio(0); } while (0)
#define PG8_WAIT_V(n) asm volatile("s_waitcnt vmcnt(" #n ")" ::: "memory")
#define PG8_WAIT_L(n) asm volatile("s_waitcnt lgkmcnt(" #n ")" ::: "memory")
#define PG8_BAR __builtin_amdgcn_s_barrier()
#define PG8_SCHED __builtin_amdgcn_sched_barrier(0)
    Unit cur, nxt; int ui = 0;
    if (!S.next(0, cur)) return;
    f32x4 acc[2][2][4][2];
#pragma unroll
    for (int a = 0; a < 2; ++a)
#pragma unroll
        for (int b = 0; b < 2; ++b)
#pragma unroll
            for (int m = 0; m < 4; ++m)
#pragma unroll
                for (int n = 0; n < 2; ++n) acc[a][b][m][n] = (f32x4){0.f, 0.f, 0.f, 0.f};
    bf16x8 At[4][2], B0[2][2], B1[2][2];
    const char* cA = (const char*)g.A + (size_t)cur.pm * tstep; const char* cB = (const char*)g.Bt + (size_t)cur.pn * tstep;
    S.a_ready(cur);
    if constexpr (SP2) {
        PG8_STAGE(PG8_SB(0, 0), cB, voffB); PG8_STAGE(PG8_SB(0, 1), cB + hstep, voffB); PG8_STAGE(PG8_SA(0, 0), cA, voffA); PG8_STAGE(PG8_SA(0, 1), cA + hstep, voffA);
        if (wr == 1) PG8_BAR;
        PG8_WAIT_V(2); PG8_BAR;
        PG8_STAGE(PG8_SB(1, 0), cB + kstep, voffB); PG8_STAGE(PG8_SA(1, 0), cA + kstep, voffA); PG8_STAGE(PG8_SB(1, 1), cB + hstep + kstep, voffB);
        PG8_WAIT_V(6); PG8_BAR;
    } else {
        PG8_STAGE(PG8_SB(0, 0), cB, voffB); PG8_STAGE(PG8_SA(0, 0), cA, voffA); PG8_STAGE(PG8_SB(0, 1), cB + hstep, voffB); PG8_STAGE(PG8_SA(0, 1), cA + hstep, voffA);
        if (wr == 1) PG8_BAR;
        PG8_WAIT_V(4); PG8_BAR;
        PG8_STAGE(PG8_SB(1, 0), cB + kstep, voffB); PG8_STAGE(PG8_SA(1, 0), cA + kstep, voffA); PG8_STAGE(PG8_SB(1, 1), cB + hstep + kstep, voffB);
        PG8_WAIT_V(6); PG8_BAR;
    }
    for (;;) {
        const bool has_next = S.next(ui + 1, nxt);
        const char* nA = has_next ? (const char*)g.A + (size_t)nxt.pm * tstep : cA; const char* nB = has_next ? (const char*)g.Bt + (size_t)nxt.pn * tstep : cB;
        for (int t = 0; t < nt; t += 2) {
            const bool last = (t == nt - 2);
            const char* a1 = cA + (size_t)(t + 1) * kstep;
            const char* a2 = last ? nA : cA + (size_t)(t + 2) * kstep; const char* b2 = last ? nB : cB + (size_t)(t + 2) * kstep;
            const char* a3 = a2 + kstep; const char* b3 = b2 + kstep;
            if (last && has_next) S.a_ready(nxt);
            if constexpr (SP2) {
            PG8_LDB(B0, 0, 0); PG8_LDB(B1, 0, 1); PG8_SCHED; PG8_LDA(At, 0, 0); PG8_STAGE(PG8_SA(1, 1), a1 + hstep, voffA);
            PG8_WAIT_V(8); PG8_WAIT_L(0); PG8_BAR; PG8_MMA(0, 0, At, B0); PG8_MMA(0, 1, At, B1); PG8_BAR; PG8_SCHED;
            PG8_LDA(At, 0, 1); PG8_STAGE(PG8_SB(0, 0), b2, voffB); PG8_STAGE(PG8_SB(0, 1), b2 + hstep, voffB); PG8_STAGE(PG8_SA(0, 0), a2, voffA);
            PG8_WAIT_V(8); PG8_WAIT_L(0); PG8_BAR; PG8_MMA(1, 0, At, B0); PG8_MMA(1, 1, At, B1); PG8_BAR; PG8_SCHED;
            PG8_LDB(B0, 1, 0); PG8_LDB(B1, 1, 1); PG8_SCHED; PG8_LDA(At, 1, 0); PG8_STAGE(PG8_SA(0, 1), a2 + hstep, voffA);
            PG8_WAIT_V(8); PG8_WAIT_L(0); PG8_BAR; PG8_MMA(0, 0, At, B0); PG8_MMA(0, 1, At, B1); PG8_BAR; PG8_SCHED;
            PG8_LDA(At, 1, 1); PG8_STAGE(PG8_SB(1, 0), b3, voffB); PG8_STAGE(PG8_SB(1, 1), b3 + hstep, voffB); PG8_STAGE(PG8_SA(1, 0), a3, voffA);
            PG8_WAIT_V(8); PG8_WAIT_L(0); PG8_BAR; PG8_MMA(1, 0, At, B0); PG8_MMA(1, 1, At, B1); PG8_BAR; PG8_SCHED;
            } else {
            PG8_LDB(B0, 0, 0); PG8_SCHED; PG8_LDA(At, 0, 0); PG8_STAGE(PG8_SA(1, 1), a1 + hstep, voffA);
            PG8_WAIT_L(8); PG8_BAR; PG8_WAIT_L(0); PG8_MMA(0, 0, At, B0); PG8_BAR; PG8_SCHED;
            PG8_LDB(B1, 0, 1); PG8_STAGE(PG8_SB(0, 0), b2, voffB);
            PG8_BAR; PG8_WAIT_L(0); PG8_MMA(0, 1, At, B1); PG8_BAR;
            PG8_LDA(At, 0, 1); PG8_STAGE(PG8_SA(0, 0), a2, voffA);
            PG8_BAR; PG8_WAIT_L(0); PG8_MMA(1, 0, At, B0); PG8_BAR; PG8_SCHED;
            PG8_STAGE(PG8_SB(0, 1), b2 + hstep, voffB);
            PG8_WAIT_V(6); PG8_BAR; PG8_MMA(1, 1, At, B1); PG8_BAR;
            PG8_LDB(B0, 1, 0); PG8_SCHED; PG8_LDA(At, 1, 0); PG8_STAGE(PG8_SA(0, 1), a2 + hstep, voffA);
            PG8_WAIT_L(8); PG8_BAR; PG8_WAIT_L(0); PG8_MMA(0, 0, At, B0); PG8_BAR; PG8_SCHED;
            PG8_LDB(B1, 1, 1); PG8_STAGE(PG8_SB(1, 0), b3, voffB);
            PG8_BAR; PG8_WAIT_L(0); PG8_MMA(0, 1, At, B1); PG8_BAR;
            PG8_LDA(At, 1, 1); PG8_STAGE(PG8_SA(1, 0), a3, voffA);
            PG8_BAR; PG8_WAIT_L(0); PG8_MMA(1, 0, At, B0); PG8_BAR; PG8_SCHED;
            PG8_STAGE(PG8_SB(1, 1), b3 + hstep, voffB);
            PG8_WAIT_V(6); PG8_BAR; PG8_MMA(1, 1, At, B1); PG8_BAR;
            }
        }
        if constexpr (ALIGN_EPI) { if (wr == 0) PG8_BAR; }
        if constexpr (!Epi::AFTER_DRAIN) { E(acc, cur, wr, wc, fr, fq); S.done(cur); }
        if (!has_next) break;
#pragma unroll
        for (int a = 0; a < 2; ++a)
#pragma unroll
            for (int b = 0; b < 2; ++b)
#pragma unroll
                for (int m = 0; m < 4; ++m)
#pragma unroll
                    for (int n = 0; n < 2; ++n) acc[a][b][m][n] = (f32x4){0.f, 0.f, 0.f, 0.f};
        cur = nxt; cA = nA; cB = nB; ++ui;
        if constexpr (ALIGN_EPI) { if (wr == 1) PG8_BAR; }
    }
    PG8_WAIT_V(0);
    if constexpr (!ALIGN_EPI) { if (wr == 0) PG8_BAR; }
    PG8_BAR;
    if constexpr (Epi::AFTER_DRAIN) { E.fused(acc, cur, wr, wc, fr, fq, lds, wid, lane); S.done(cur); }
#undef PG8_SA
#undef PG8_SB
#undef PG8_STAGE
#undef PG8_LDA
#undef PG8_LDB
#undef PG8_MMA
#undef PG8_WAIT_V
#undef PG8_WAIT_L
#undef PG8_BAR
#undef PG8_SCHED
}
}

template <class E> struct EpiAd {
    static constexpr bool PERM = true, AFTER_DRAIN = false; E e;
    __device__ __forceinline__ void operator()(const f32x4 (&acc)[2][2][4][2], const pg8::Unit& u, int wr, int wc, int fr, int fq) const {
#pragma unroll
        for (int ai = 0; ai < 2; ++ai)
#pragma unroll
            for (int m = 0; m < 4; ++m) {
                const int row = u.pm * 256 + ai * 128 + wr * 64 + m * 16 + fr;
                const float rsc = e.rowscale(row);
                float lo[8], hi[8];
#pragma unroll
                for (int j = 0; j < 4; ++j) { lo[j] = acc[ai][0][m][0][j]; lo[4 + j] = acc[ai][0][m][1][j]; hi[j] = acc[ai][1][m][0][j]; hi[4 + j] = acc[ai][1][m][1][j]; }
                e.template tile8<16, 32>(row, u.pn, wc * 32 + 8 * fq, lo, hi, rsc);
            }
    }
};
template <class E> __device__ __forceinline__ void gemm_fast(LAS unsigned char* lds, const bf16_t* A, const bf16_t* Bt, int M, int N, int K, const E& e, int vb, int G) {
    pg8::Gemm g{A, Bt, M, N, K}; pg8::StaticOrder S; S.init(M, N, G, vb);
    EpiAd<E> Ea{e};
    pg8::gemm_phase<EpiAd<E>, pg8::StaticOrder, true, true>(lds, g, S, Ea);
}

template <class E, int KS>
__device__ __forceinline__ void gemm_small(LAS unsigned char* lds, const bf16_t* A, const bf16_t* Bt, int N, int K, const E& e, int row_base, int vb, int G) {
    const int tid = opaque((int)threadIdx.x), lane = tid & 63, wave = __builtin_amdgcn_readfirstlane(tid >> 6), fr = lane & 15, fq = lane >> 4;
    const int nwork = 16 * (N / 64) * KS;
    for (int wbase = vb * NWAVES; wbase < nwork; wbase += G * NWAVES) {
        const int wk = wbase + wave; const bool act = wk < nwork;
        const int tile = act ? wk / KS : 0, ks = wk % KS;
        const int ct = tile >> 4, rt = tile & 15, pn = ct >> 2, cg = ct & 3;
        const int klen = K / KS, kb = ks * klen;
        f32x4 acc[4][4];
#pragma unroll
        for (int m = 0; m < 4; ++m)
#pragma unroll
            for (int n = 0; n < 4; ++n) acc[m][n] = (f32x4){0.f, 0.f, 0.f, 0.f};
        if (act) {
            const bf16_t* ap = A + (size_t)(rt * 64 + fr) * K + kb + 8 * fq;
            const bf16_t* bp[4];
#pragma unroll
            for (int n = 0; n < 4; ++n) { const int vcol = 256 * pn + (n >> 1) * 128 + 32 * cg + pg8::perm32(16 * (n & 1) + fr); bp[n] = Bt + (size_t)vcol * K + kb + 8 * fq; }
            bf16x8 a0[4], b0[4], a1[4], b1[4];
#define GS_LD(aa, bb, koff) do { _Pragma("unroll") for (int m = 0; m < 4; ++m) aa[m] = *(const bf16x8*)(ap + (size_t)m * 16 * K + (koff)); \
                                 _Pragma("unroll") for (int n = 0; n < 4; ++n) bb[n] = *(const bf16x8*)(bp[n] + (koff)); } while (0)
#define GS_MMA(aa, bb) do { _Pragma("unroll") for (int m = 0; m < 4; ++m) _Pragma("unroll") for (int n = 0; n < 4; ++n) \
                                 acc[m][n] = __builtin_amdgcn_mfma_f32_16x16x32_bf16(bb[n], aa[m], acc[m][n], 0, 0, 0); } while (0)
            GS_LD(a0, b0, 0);
            for (int k = 0; k < klen; k += 64) {
                GS_LD(a1, b1, k + 32);
                GS_MMA(a0, b0);
                if (k + 64 < klen) GS_LD(a0, b0, k + 64);
                GS_MMA(a1, b1);
            }
#undef GS_LD
#undef GS_MMA
        }
        if (KS == 1) {
            if (act) {
#pragma unroll
                for (int m = 0; m < 4; ++m) { const int row = row_base + rt * 64 + 16 * m + fr; const float rsc = e.rowscale(row); float lo[8], hi[8];
#pragma unroll
                    for (int j = 0; j < 4; ++j) { lo[j] = acc[m][0][j]; lo[4 + j] = acc[m][1][j]; hi[j] = acc[m][2][j]; hi[4 + j] = acc[m][3][j]; }
                    e.template tile8<16, 32>(row, pn, 32 * cg + 8 * fq, lo, hi, rsc); }
            }
        } else {
            LAS float* P = (LAS float*)lds;
            __syncthreads();
#pragma unroll
            for (int m = 0; m < 4; ++m)
#pragma unroll
                for (int n = 0; n < 4; ++n)
#pragma unroll
                    for (int j = 0; j < 4; ++j) P[((wave * 16 + m * 4 + n) * 4 + j) * 64 + lane] = acc[m][n][j];
            __syncthreads();
            if (wave < 4 && act) {
                const int m = wave; float lo[8], hi[8];
#pragma unroll
                for (int n = 0; n < 4; ++n)
#pragma unroll
                    for (int j = 0; j < 4; ++j) { float sum = 0.f;
#pragma unroll
                        for (int sl = 0; sl < KS; ++sl) sum += P[((sl * 16 + m * 4 + n) * 4 + j) * 64 + lane];
                        if (n < 2) lo[(n & 1) * 4 + j] = sum; else hi[(n & 1) * 4 + j] = sum; }
                const int row = row_base + rt * 64 + 16 * m + fr; const float rsc = e.rowscale(row);
                e.template tile8<16, 32>(row, pn, 32 * cg + 8 * fq, lo, hi, rsc);
            }
        }
    }
}
#if FAST_GEMM
#define GEMM gemm_fast
#else
#define GEMM gemm_simple
#endif

__device__ __forceinline__ void conv_simple(const Params& p, LAS unsigned char* lds, int vb, int G) {
    LAS float* red = (LAS float*)lds;
    const bf16_t* A = (const bf16_t*)(p.ws + WS_R1); const bf16_t* SGA = A + (size_t)T * 1024; bf16_t* H0 = (bf16_t*)p.out;
    const float *cw = p.in[6], *cb = p.in[7], *lg = p.in[8], *lbeta = p.in[9], *sc = p.in[2];
    const int tid = opaque((int)threadIdx.x), c = tid * 2;
    for (int r = vb; r < T; r += G) {
        int t, rowbase; const float* hist;
        if (r < TP) { t = r & 2047; rowbase = r - t; hist = nullptr; } else { const int b = (r - TP) >> 3; t = (r - TP) & 7; rowbase = r - t; hist = sc + (size_t)b * 30 * 1024; }
        float y0 = cb[c], y1 = cb[c + 1];
        for (int j = 0; j < 31; ++j) { const int i = t + j - 30; float a0 = 0.f, a1 = 0.f;
            if (i >= 0) { const unsigned w = *(const unsigned*)(A + (size_t)(rowbase + i) * 1024 + c); a0 = bflo(w); a1 = bfhi(w); }
            else if (hist) { a0 = hist[(30 + i) * 1024 + c]; a1 = hist[(30 + i) * 1024 + c + 1]; }
            y0 += cw[j * 1024 + c] * a0; y1 += cw[j * 1024 + c + 1] * a1; }
        const float mean = block_sum(y0 + y1, red) * (1.f / 1024.f);
        const float d0 = y0 - mean, d1 = y1 - mean;
        const float rstd = rsqrtf(block_sum(d0 * d0 + d1 * d1, red) * (1.f / 1024.f) + EPS);
        const float n0 = d0 * rstd * lg[c] + lbeta[c], n1 = d1 * rstd * lg[c + 1] + lbeta[c + 1];
        const unsigned gw = *(const unsigned*)(SGA + (size_t)r * 1024 + c);
        *(unsigned*)(H0 + (size_t)r * 2048 + c) = pk2(silu(n0) * bflo(gw), silu(n1) * bfhi(gw));
    }
    for (int idx = vb * NTHR + tid; idx < 8 * 30 * 1024; idx += G * NTHR) { const int b = idx / 30720, rem = idx % 30720, i = rem >> 10, cc = rem & 1023;
        p.out[O_CP + idx] = bf2f(A[(size_t)(b * 2048 + 2018 + i) * 1024 + cc]); }
    for (int idx = vb * NTHR + tid; idx < 128 * 30 * 1024; idx += G * NTHR) { const int b = idx / 30720, rem = idx % 30720, i = rem >> 10, cc = rem & 1023;
        p.out[O_CS + idx] = (i < 22) ? sc[(size_t)(b * 30 + 8 + i) * 1024 + cc] : bf2f(A[(size_t)(TP + b * 8 + i - 22) * 1024 + cc]); }
}


typedef float f32x16 __attribute__((ext_vector_type(16)));
__device__ __forceinline__ bf16x8 ldfrag(const LAS unsigned char* img, int pitchB, int row0, int k0, int lane) {
    return *(const LAS bf16x8*)(img + (row0 + (lane & 31)) * pitchB + (k0 + 8 * (lane >> 5)) * 2);
}
__device__ __forceinline__ unsigned ld_u16(const void* base, unsigned boff) { return *(const unsigned short*)((const char*)base + boff); }
__device__ __forceinline__ void st_u16(void* base, unsigned boff, unsigned v) { *(unsigned short*)((char*)base + boff) = (unsigned short)v; }
#define MFMA32(a, b, c) __builtin_amdgcn_mfma_f32_32x32x16_bf16((a), (b), (c), 0, 0, 0)
__device__ __forceinline__ int accrow(int r, int lane) { return (r & 3) + 8 * (r >> 2) + 4 * (lane >> 5); }

__device__ __forceinline__ void conv_fast(const Params& p, LAS unsigned char* lds, int vb, int G) {
    LAS float* red = (LAS float*)lds;
    const bf16_t* A = (const bf16_t*)(p.ws + WS_R1); const bf16_t* SGA = A + (size_t)T * 1024; bf16_t* H0 = (bf16_t*)p.out;
    const float *cw = p.in[6], *cb = p.in[7], *lg = p.in[8], *lbeta = p.in[9], *sc = p.in[2];
    const int tid = opaque((int)threadIdx.x), lane = tid & 63, wave = tid >> 6, c = tid * 2;
    LAS float* cwl = (LAS float*)(lds + 1024);
    __syncthreads();
    for (int q = tid; q < 31 * 256; q += NTHR) *(LAS f32x4*)(cwl + q * 4) = *(const f32x4*)(cw + q * 4);
    __syncthreads();
    const float cb0 = cb[c], cb1 = cb[c + 1], g0 = lg[c], g1 = lg[c + 1], be0 = lbeta[c], be1 = lbeta[c + 1];
    const f32x2 cbv = (f32x2){cb0, cb1}, gv2 = (f32x2){g0, g1}, bev = (f32x2){be0, be1};
    for (int item = vb; item < 384; item += G) {
        int L, rowfirst; f32x2 w[38];
        if (item < 256) { const int b = item >> 5, t0 = (item & 31) * 64; L = 64; rowfirst = b * 2048 + t0;
#pragma unroll
            for (int i = 0; i < 30; ++i) { unsigned u = 0u; if (t0 > 0) u = *(const unsigned*)(A + (size_t)(rowfirst - 30 + i) * 1024 + c); w[i] = (f32x2){bflo(u), bfhi(u)}; }
        } else { const int sb = item - 256; L = 8; rowfirst = TP + sb * 8; const float* hist = sc + (size_t)sb * 30 * 1024;
#pragma unroll
            for (int i = 0; i < 30; ++i) w[i] = *(const f32x2*)(hist + i * 1024 + c);
        }
        unsigned an[8], gn[8];
#pragma unroll
        for (int k = 0; k < 8; ++k) { an[k] = *(const unsigned*)(A + (size_t)(rowfirst + k) * 1024 + c); gn[k] = *(const unsigned*)(SGA + (size_t)(rowfirst + k) * 1024 + c); }
        for (int g = 0; g < L; g += 8) {
            unsigned gc[8];
#pragma unroll
            for (int k = 0; k < 8; ++k) { w[30 + k] = (f32x2){bflo(an[k]), bfhi(an[k])}; gc[k] = gn[k]; }
            if (g + 8 < L) {
#pragma unroll
                for (int k = 0; k < 8; ++k) { an[k] = *(const unsigned*)(A + (size_t)(rowfirst + g + 8 + k) * 1024 + c); gn[k] = *(const unsigned*)(SGA + (size_t)(rowfirst + g + 8 + k) * 1024 + c); } }
            f32x2 y[8]; float st[16];
#pragma unroll
            for (int k = 0; k < 8; ++k) y[k] = cbv;
#pragma unroll
            for (int j = 0; j < 31; ++j) { const f32x2 wj = *(const LAS f32x2*)(cwl + j * 1024 + c);
#pragma unroll
                for (int k = 0; k < 8; ++k) y[k] += wj * w[k + j]; }
#pragma unroll
            for (int k = 0; k < 8; ++k) { const f32x2 sq = y[k] * y[k]; st[k] = y[k].x + y[k].y; st[8 + k] = sq.x + sq.y; }
#pragma unroll
            for (int k = 0; k < 16; ++k) st[k] = wave_sum(st[k]);
            if (lane == 0) {
#pragma unroll
                for (int k = 0; k < 16; ++k) red[wave * 16 + k] = st[k]; }
            __syncthreads();
            if (tid < 16) { float sacc = 0.f;
#pragma unroll
                for (int ww = 0; ww < 8; ++ww) sacc += red[ww * 16 + tid];
                red[128 + tid] = sacc; }
            __syncthreads();
#pragma unroll
            for (int k = 0; k < 8; ++k) { const float mean = red[128 + k] * (1.f / 1024.f); const float var = red[136 + k] * (1.f / 1024.f) - mean * mean; const float rstd = rsqrtf(var + EPS);
                const f32x2 n = (y[k] - mean) * rstd * gv2 + bev;
                *(unsigned*)(H0 + (size_t)(rowfirst + g + k) * 2048 + c) = pk2(silu(n.x) * bflo(gc[k]), silu(n.y) * bfhi(gc[k])); }
#pragma unroll
            for (int i = 0; i < 30; ++i) w[i] = w[i + 8];
        }
        if (item >= 256) { float* o = p.out + O_CS + (size_t)(item - 256) * 30 * 1024 + c;
#pragma unroll
            for (int i = 0; i < 30; ++i) *(f32x2*)(o + i * 1024) = w[i]; }
        else if ((item & 31) == 31) { float* o = p.out + O_CP + (size_t)(item >> 5) * 30 * 1024 + c;
#pragma unroll
            for (int i = 0; i < 30; ++i) *(f32x2*)(o + i * 1024) = w[i]; }
    }
}

__device__ __forceinline__ void hgrn_simple(const Params& p, LAS unsigned char* lds, int vb, int G, int item_lo, int item_hi) {
    LAS float* sf = (LAS float*)lds; LAS float* sk = sf + 1024; LAS float* sq = sk + 1024; LAS float* si = sq + 1024; LAS float* so = si + 1024; LAS float* so2 = so + 4096;
    const int tid = opaque((int)threadIdx.x), v = tid & 127, dq = tid >> 7, lane = tid & 63, wave = tid >> 6;
    const bf16_t* Z = (const bf16_t*)(p.ws + WS_R1);
    const bf16_t *Q = Z + (size_t)2 * T * 1024, *LOGF = Z + (size_t)3 * T * 1024, *I = Z + (size_t)4 * T * 1024, *SGB = Z + (size_t)5 * T * 1024;
    const float* og = p.in[11]; bf16_t* H0 = (bf16_t*)p.out;
    for (int item = item_lo + vb; item < item_hi; item += G) {
        int h, L, rowbase; const float* s0; float* sout;
        if (item < 64) { const int b = item >> 3; h = item & 7; L = 2048; rowbase = b * 2048; s0 = nullptr; sout = p.out + O_HP + (size_t)item * 16384; }
        else { const int it = item - 64, b = it >> 3; h = it & 7; L = 8; rowbase = TP + b * 8; s0 = p.in[3] + (size_t)it * 16384; sout = p.out + O_HS + (size_t)it * 16384; }
        float S[32];
#pragma unroll
        for (int j = 0; j < 32; ++j) S[j] = s0 ? s0[(dq * 32 + j) * 128 + v] : 0.f;
        for (int t0 = 0; t0 < L; t0 += 8) {
            __syncthreads();
            for (int e = tid; e < 1024; e += NTHR) { const int tt = e >> 7, d = e & 127; const size_t off = (size_t)(rowbase + t0 + tt) * 1024 + h * 128 + d;
                const float f = __expf(bf2f(LOGF[off])); sf[e] = f; sk[e] = 1.f - f; sq[e] = bf2f(Q[off]); si[e] = bf2f(I[off]); }
            __syncthreads();
#pragma unroll 1
            for (int tt = 0; tt < 8; ++tt) { const float iv = si[tt * 128 + v]; float op = 0.f;
#pragma unroll
                for (int j = 0; j < 32; ++j) { const int d = dq * 32 + j; S[j] = sf[tt * 128 + d] * S[j] + sk[tt * 128 + d] * iv; op += S[j] * sq[tt * 128 + d]; }
                so[(tt * 4 + dq) * 128 + v] = op; }
            __syncthreads();
            for (int e = tid; e < 1024; e += NTHR) { const int tt = e >> 7, vv = e & 127; so2[e] = (so[(tt * 4 + 0) * 128 + vv] + so[(tt * 4 + 1) * 128 + vv]) + (so[(tt * 4 + 2) * 128 + vv] + so[(tt * 4 + 3) * 128 + vv]); }
            __syncthreads();
            { const int tt = wave; const size_t row = (size_t)(rowbase + t0 + tt);
              const float o0 = so2[tt * 128 + lane], o1 = so2[tt * 128 + 64 + lane];
              const float rs = rsqrtf(wave_sum(o0 * o0 + o1 * o1) * (1.f / 128.f) + EPS);
              const float r0 = o0 * rs * og[h * 128 + lane] * bf2f(SGB[row * 1024 + h * 128 + lane]);
              const float r1 = o1 * rs * og[h * 128 + 64 + lane] * bf2f(SGB[row * 1024 + h * 128 + 64 + lane]);
              H0[row * 2048 + 1024 + h * 128 + lane] = (bf16_t)f2bf(r0); H0[row * 2048 + 1024 + h * 128 + 64 + lane] = (bf16_t)f2bf(r1); }
        }
#pragma unroll
        for (int j = 0; j < 32; ++j) sout[(dq * 32 + j) * 128 + v] = S[j];
    }
}


__device__ __forceinline__ void hgrn_sample(const Params& p, LAS unsigned char* lds, int vb, int G) {
    LAS float* sf = (LAS float*)lds; LAS float* sk = sf + 1024; LAS float* sq = sk + 1024; LAS float* si = sq + 1024; LAS float* so = si + 1024; LAS float* so2 = so + 4096;
    const int tid = opaque((int)threadIdx.x), v = tid & 127, dq = tid >> 7, lane = tid & 63, wave = tid >> 6;
    const bf16_t* Z = (const bf16_t*)(p.ws + WS_R1);
    const bf16_t *Q = Z + (size_t)2 * T * 1024, *LOGF = Z + (size_t)3 * T * 1024, *I = Z + (size_t)4 * T * 1024, *SGB = Z + (size_t)5 * T * 1024;
    const float* og = p.in[11]; bf16_t* H0 = (bf16_t*)p.out;
    float S[32], Sn[32]; unsigned rl[2], rq2[2], ri2[2];
#define HS_LOAD(it_, SS) do { const float* s0_ = p.in[3] + (size_t)(it_) * 16384 + (dq * 32) * 128 + v; \
        _Pragma("unroll") for (int j = 0; j < 32; ++j) SS[j] = s0_[j * 128]; \
        _Pragma("unroll") for (int u = 0; u < 2; ++u) { const int e = tid + u * NTHR; const size_t off = (size_t)(TP + ((it_) >> 3) * 8 + (e >> 7)) * 1024 + ((it_) & 7) * 128 + (e & 127); \
            rl[u] = LOGF[off]; rq2[u] = Q[off]; ri2[u] = I[off]; } } while (0)
    int it = vb;
    if (it < 1024) HS_LOAD(it, S);
    for (; it < 1024; it += G) {
        const int b = it >> 3, h = it & 7, rowbase = TP + b * 8;
        __syncthreads();
#pragma unroll
        for (int u = 0; u < 2; ++u) { const int e = tid + u * NTHR; const float f = __expf(bf2f(rl[u])); sf[e] = f; sk[e] = 1.f - f; sq[e] = bf2f(rq2[u]); si[e] = bf2f(ri2[u]); }
        if (it + G < 1024) HS_LOAD(it + G, Sn);
        __syncthreads();
#pragma unroll 1
        for (int tt = 0; tt < 8; ++tt) { const float iv = si[tt * 128 + v]; float op = 0.f;
            const LAS f32x4* f4 = (const LAS f32x4*)(sf + tt * 128 + dq * 32); const LAS f32x4* k4 = (const LAS f32x4*)(sk + tt * 128 + dq * 32); const LAS f32x4* q4 = (const LAS f32x4*)(sq + tt * 128 + dq * 32);
#pragma unroll
            for (int jj = 0; jj < 8; ++jj) { const f32x4 fv = f4[jj], kv = k4[jj], qv = q4[jj];
                S[4 * jj] = fv.x * S[4 * jj] + kv.x * iv; op += S[4 * jj] * qv.x; S[4 * jj + 1] = fv.y * S[4 * jj + 1] + kv.y * iv; op += S[4 * jj + 1] * qv.y;
                S[4 * jj + 2] = fv.z * S[4 * jj + 2] + kv.z * iv; op += S[4 * jj + 2] * qv.z; S[4 * jj + 3] = fv.w * S[4 * jj + 3] + kv.w * iv; op += S[4 * jj + 3] * qv.w; }
            so[(tt * 4 + dq) * 128 + v] = op; }
        __syncthreads();
#pragma unroll
        for (int u = 0; u < 2; ++u) { const int e = tid + u * NTHR; const int tt = e >> 7, vv = e & 127; so2[e] = (so[(tt * 4 + 0) * 128 + vv] + so[(tt * 4 + 1) * 128 + vv]) + (so[(tt * 4 + 2) * 128 + vv] + so[(tt * 4 + 3) * 128 + vv]); }
        __syncthreads();
        { const int tt = wave; const size_t row = (size_t)(rowbase + tt);
          const float o0 = so2[tt * 128 + lane], o1 = so2[tt * 128 + 64 + lane];
          const float rs = rsqrtf(wave_sum(o0 * o0 + o1 * o1) * (1.f / 128.f) + EPS);
          const float r0 = o0 * rs * og[h * 128 + lane] * bf2f(SGB[row * 1024 + h * 128 + lane]);
          const float r1 = o1 * rs * og[h * 128 + 64 + lane] * bf2f(SGB[row * 1024 + h * 128 + 64 + lane]);
          H0[row * 2048 + 1024 + h * 128 + lane] = (bf16_t)f2bf(r0); H0[row * 2048 + 1024 + h * 128 + 64 + lane] = (bf16_t)f2bf(r1); }
        { float* sout = p.out + O_HS + (size_t)it * 16384 + (dq * 32) * 128 + v;
#pragma unroll
          for (int j = 0; j < 32; ++j) { sout[j * 128] = S[j]; S[j] = Sn[j]; } }
    }
#undef HS_LOAD
}

constexpr size_t WS_BSUM = 131072;
constexpr int HA_QM = 0, HA_KM = 17408, HA_KMT = 34816, HA_VT = 53248, HA_P = 71680, HA_ST = 80896, HA_TOT = 115712, HA_DEC = 117760;
constexpr int PQ = 272, PS = 144;
__device__ __forceinline__ void hgrn_phaseA(const Params& p, LAS unsigned char* lds, int vb, int G) {
    const int tid = opaque((int)threadIdx.x), lane = tid & 63, wid = __builtin_amdgcn_readfirstlane(tid >> 6);
    const int d = tid & 127, tq = tid >> 7;
    bf16_t* Zb = (bf16_t*)(p.ws + WS_R1);
    bf16_t* Qg = Zb + (size_t)2 * T * 1024; bf16_t* LFg = Zb + (size_t)3 * T * 1024; const bf16_t* Ig = Zb + (size_t)4 * T * 1024;
    float* SEG = (float*)(p.ws + WS_SEG); float* BSUM = (float*)(p.ws + WS_BSUM);
    LAS float* TOT = (LAS float*)(lds + HA_TOT); LAS float* DEC = (LAS float*)(lds + HA_DEC);
    for (int item = vb; item < 256; item += G) {
        const int bh = item >> 2, seg = item & 3, b = bh >> 3, h = bh & 7;
        const size_t row0 = (size_t)b * 2048 + seg * 512; const int cb = h * 128;
        __syncthreads();
        for (int i = tid; i < 2176; i += NTHR) *(LAS u32x4*)(lds + HA_ST + i * 16) = (u32x4){0u, 0u, 0u, 0u};
        const int dt = wid >> 1, vts = (wid & 1) * 2;
        f32x16 S[2];
#pragma unroll
        for (int j2 = 0; j2 < 2; ++j2)
#pragma unroll
            for (int r = 0; r < 16; ++r) S[j2][r] = 0.f;
        float bsum = 0.f;
        unsigned rq[16], rf[16], ri[16];
        const unsigned toff = ((unsigned)(16 * tq) * 1024u + (unsigned)d) * 2u;
        { const bf16_t* qb = Qg + row0 * 1024 + cb; const bf16_t* fb = LFg + row0 * 1024 + cb; const bf16_t* ib = Ig + row0 * 1024 + cb;
#pragma unroll
          for (int j = 0; j < 16; ++j) { rq[j] = ld_u16(qb, toff + j * 2048u); rf[j] = ld_u16(fb, toff + j * 2048u); ri[j] = ld_u16(ib, toff + j * 2048u); } }
        for (int c = 0; c < 8; ++c) {
            const size_t r0 = row0 + c * 64;
            float bc[16]; float run = 0.f;
#pragma unroll
            for (int j = 0; j < 16; ++j) { run += bf2f(rf[j]); bc[j] = run; }
            TOT[tq * 128 + d] = run;
            __syncthreads();
            float pre = 0.f, bend = 0.f;
#pragma unroll
            for (int q = 0; q < 4; ++q) { const float t = TOT[q * 128 + d]; pre += (q < tq) ? t : 0.f; bend += t; }
            if (tq == 0) DEC[d] = __expf(bend);
            const float eseg = __expf(bsum);
            unsigned kmp[8], vtp[8]; const unsigned to1 = (unsigned)opaque((int)toff);
#pragma unroll
            for (int j = 0; j < 16; j += 2) {
                float km2[2];
#pragma unroll
                for (int u = 0; u < 2; ++u) { const int jj = j + u; const float bcum = pre + bc[jj]; const float f = __expf(bf2f(rf[jj]));
                    const float qm = bf2f(rq[jj]) * __expf(bcum), km = (1.f - f) * __expf(-bcum); km2[u] = km;
                    const int t = 16 * tq + jj;
                    *(LAS bf16_t*)(lds + HA_QM + t * PQ + d * 2) = (bf16_t)f2bf(qm); *(LAS bf16_t*)(lds + HA_KM + t * PQ + d * 2) = (bf16_t)f2bf(km);
                    st_u16(LFg + r0 * 1024 + cb, to1 + jj * 2048u, f2bf(qm * eseg)); }
                kmp[j >> 1] = pk2(km2[0], km2[1]); vtp[j >> 1] = ri[j] | (ri[j + 1] << 16);
            }
            *(LAS u32x4*)(lds + HA_KMT + d * PS + tq * 32) = (u32x4){kmp[0], kmp[1], kmp[2], kmp[3]}; *(LAS u32x4*)(lds + HA_KMT + d * PS + tq * 32 + 16) = (u32x4){kmp[4], kmp[5], kmp[6], kmp[7]};
            *(LAS u32x4*)(lds + HA_VT + d * PS + tq * 32) = (u32x4){vtp[0], vtp[1], vtp[2], vtp[3]}; *(LAS u32x4*)(lds + HA_VT + d * PS + tq * 32 + 16) = (u32x4){vtp[4], vtp[5], vtp[6], vtp[7]};
            bsum += bend;
            __syncthreads();
            f32x16 dS[2];
#pragma unroll
            for (int j2 = 0; j2 < 2; ++j2)
#pragma unroll
                for (int r = 0; r < 16; ++r) dS[j2][r] = 0.f;
            { bf16x8 af[4];
#pragma unroll
              for (int ks = 0; ks < 4; ++ks) af[ks] = ldfrag(lds + HA_KMT, PS, 32 * dt, 16 * ks, lane);
#pragma unroll
              for (int j2 = 0; j2 < 2; ++j2)
#pragma unroll
                  for (int ks = 0; ks < 4; ++ks) { const bf16x8 bb = ldfrag(lds + HA_VT, PS, 32 * (vts + j2), 16 * ks, lane); dS[j2] = MFMA32(af[ks], bb, dS[j2]); } }
            if (wid < 4) {
                const int mt = (wid + 1) >> 1, nt = (wid == 2 || wid == 3) ? 1 : 0;
                const int mtt = (wid == 3) ? 0 : mt;
                f32x16 acc;
#pragma unroll
                for (int r = 0; r < 16; ++r) acc[r] = 0.f;
                if (wid < 3) {
#pragma unroll
                    for (int ks = 0; ks < 8; ++ks) { const bf16x8 a = ldfrag(lds + HA_QM, PQ, 32 * mtt, 16 * ks, lane), bb = ldfrag(lds + HA_KM, PQ, 32 * nt, 16 * ks, lane); acc = MFMA32(a, bb, acc); }
                }
                const int lnx = opaque(lane); const int sx = 32 * nt + (lnx & 31), tb = 32 * mtt + 4 * (lnx >> 5);
                LAS unsigned char* pp = lds + HA_P + tb * PS + sx * 2;
#pragma unroll
                for (int r = 0; r < 16; ++r) { const int tr = (r & 3) + 8 * (r >> 2);
                    *(LAS bf16_t*)(pp + tr * PS) = (bf16_t)f2bf((sx <= tb + tr) ? acc[r] : 0.f); }
            }
            __syncthreads();
            if (c + 1 < 8) { const bf16_t* qb = Qg + (r0 + 64) * 1024 + cb; const bf16_t* fb = LFg + (r0 + 64) * 1024 + cb; const bf16_t* ib = Ig + (r0 + 64) * 1024 + cb;
                const unsigned to2 = (unsigned)opaque((int)toff);
#pragma unroll
                for (int j = 0; j < 16; ++j) { rq[j] = ld_u16(qb, to2 + j * 2048u); rf[j] = ld_u16(fb, to2 + j * 2048u); ri[j] = ld_u16(ib, to2 + j * 2048u); } }
            { const int mt = wid >> 2, vt = wid & 3; f32x16 o;
#pragma unroll
              for (int r = 0; r < 16; ++r) o[r] = 0.f;
#pragma unroll
              for (int ks = 0; ks < 4; ++ks) { const bf16x8 a = ldfrag(lds + HA_P, PS, 32 * mt, 16 * ks, lane), bb = ldfrag(lds + HA_VT, PS, 32 * vt, 16 * ks, lane); o = MFMA32(a, bb, o); }
#pragma unroll
              for (int ks = 0; ks < 8; ++ks) { const bf16x8 a = ldfrag(lds + HA_QM, PQ, 32 * mt, 16 * ks, lane), bb = ldfrag(lds + HA_ST, PQ, 32 * vt, 16 * ks, lane); o = MFMA32(a, bb, o); }
              const int lny = opaque(lane); const unsigned ob = ((unsigned)(32 * mt + 4 * (lny >> 5)) * 1024u + 32 * vt + (lny & 31)) * 2u;
#pragma unroll
              for (int r = 0; r < 16; ++r) st_u16(Qg + r0 * 1024 + cb, ob + ((r & 3) + 8 * (r >> 2)) * 2048u, f2bf(o[r])); }
            __syncthreads();
            { float dec[16]; const int lnu = opaque(lane); const LAS float* dp = DEC + 32 * dt + 4 * (lnu >> 5);
#pragma unroll
              for (int r = 0; r < 16; ++r) dec[r] = dp[(r & 3) + 8 * (r >> 2)];
#pragma unroll
              for (int j2 = 0; j2 < 2; ++j2) {
#pragma unroll
                  for (int r = 0; r < 16; ++r) S[j2][r] = dec[r] * (S[j2][r] + dS[j2][r]);
                  LAS unsigned char* sp2 = lds + HA_ST + (32 * (vts + j2) + (lnu & 31)) * PQ + (32 * dt + 4 * (lnu >> 5)) * 2;
#pragma unroll
                  for (int g = 0; g < 4; ++g)
                      *(LAS u32x2*)(sp2 + 16 * g) = (u32x2){pk2(S[j2][4 * g], S[j2][4 * g + 1]), pk2(S[j2][4 * g + 2], S[j2][4 * g + 3])};
              } }
        }
        { const int lns = opaque(lane); float* sp = SEG + (size_t)item * 16384 + (32 * dt + 4 * (lns >> 5)) * 128 + 32 * vts + (lns & 31);
#pragma unroll
            for (int j2 = 0; j2 < 2; ++j2)
#pragma unroll
                for (int r = 0; r < 16; ++r) sp[((r & 3) + 8 * (r >> 2)) * 128 + 32 * j2] = S[j2][r]; }
        if (tq == 0) BSUM[item * 128 + d] = bsum;
    }
}
constexpr int HB_AQ = 0, HB_SIN = 34816, HB_OT = 69632;
__device__ __forceinline__ void hgrn_phaseB(const Params& p, LAS unsigned char* lds, int vb, int G) {
    const int tid = opaque((int)threadIdx.x), lane = tid & 63, wid = __builtin_amdgcn_readfirstlane(tid >> 6);
    const int v = tid & 127, dg = tid >> 7;
    const bf16_t* Zb = (const bf16_t*)(p.ws + WS_R1);
    const bf16_t* OLg = Zb + (size_t)2 * T * 1024; const bf16_t* QSg = Zb + (size_t)3 * T * 1024; const bf16_t* SGB = Zb + (size_t)5 * T * 1024;
    const float* SEG = (const float*)(p.ws + WS_SEG); const float* BSUM = (const float*)(p.ws + WS_BSUM);
    const float* og = p.in[11]; bf16_t* H0 = (bf16_t*)p.out;
    LAS float* OT = (LAS float*)(lds + HB_OT);
    for (int item = vb; item < 256; item += G) {
        const int bh = item >> 2, seg = item & 3, b = bh >> 3, h = bh & 7;
        const size_t row0 = (size_t)b * 2048 + seg * 512; const int cb = h * 128;
        __syncthreads();
        if (seg > 0) {
            const float* S0 = SEG + (size_t)(bh * 4 + 0) * 16384; const float* S1 = S0 + 16384; const float* S2 = S1 + 16384; const float* S3 = S2 + 16384;
            const float* B1 = BSUM + (bh * 4 + 1) * 128; const float* B2 = B1 + 128; const float* B3 = B2 + 128;
#pragma unroll 2
            for (int d0 = dg * 32; d0 < dg * 32 + 32; d0 += 4) { float sv[4];
#pragma unroll
                for (int i = 0; i < 4; ++i) { const int dd = d0 + i; float s = S0[dd * 128 + v];
                    if (seg >= 2) s = __expf(B1[dd]) * s + S1[dd * 128 + v];
                    if (seg >= 3) s = __expf(B2[dd]) * s + S2[dd * 128 + v];
                    sv[i] = s;
                    if (seg == 3) p.out[O_HP + (size_t)bh * 16384 + dd * 128 + v] = __expf(B3[dd]) * s + S3[dd * 128 + v]; }
                *(LAS u32x2*)(lds + HB_SIN + v * PQ + d0 * 2) = (u32x2){pk2(sv[0], sv[1]), pk2(sv[2], sv[3])}; }
        }
        const int prow = tid >> 2, ppart = tid & 3; const int pc0 = cb + 32 * ppart;
        u32x4 aq[4], ol[4], gt[4];
#define HB_LOAD(rt_) do { const size_t rr = row0 + (rt_) * 128; \
            _Pragma("unroll") for (int i = 0; i < 4; ++i) { const int q = tid + i * NTHR; aq[i] = *(const u32x4*)(QSg + (rr + (q >> 4)) * 1024 + cb + (q & 15) * 8); \
                ol[i] = *(const u32x4*)(OLg + (rr + prow) * 1024 + pc0 + 8 * i); gt[i] = *(const u32x4*)(SGB + (rr + prow) * 1024 + pc0 + 8 * i); } } while (0)
        HB_LOAD(0);
        for (int rt = 0; rt < 4; ++rt) {
            const size_t r0 = row0 + rt * 128;
            u32x4 olc[4], gtc[4];
#pragma unroll
            for (int i = 0; i < 4; ++i) { olc[i] = ol[i]; gtc[i] = gt[i]; }
            if (seg > 0) {
#pragma unroll
                for (int i = 0; i < 4; ++i) { const int q = tid + i * NTHR; *(LAS u32x4*)(lds + HB_AQ + (q >> 4) * PQ + (q & 15) * 16) = aq[i]; }
            }
            if (rt < 3) HB_LOAD(rt + 1);
            if (seg > 0) {
                __syncthreads();
                const int mt = wid >> 1, vt0 = (wid & 1) * 2; f32x16 acc0, acc1;
#pragma unroll
                for (int r = 0; r < 16; ++r) { acc0[r] = 0.f; acc1[r] = 0.f; }
#pragma unroll
                for (int ks = 0; ks < 8; ++ks) { const bf16x8 a = ldfrag(lds + HB_AQ, PQ, 32 * mt, 16 * ks, lane), b0 = ldfrag(lds + HB_SIN, PQ, 32 * vt0, 16 * ks, lane), b1 = ldfrag(lds + HB_SIN, PQ, 32 * (vt0 + 1), 16 * ks, lane);
                    acc0 = MFMA32(a, b0, acc0); acc1 = MFMA32(a, b1, acc1); }
                { const int lno = opaque(lane); LAS float* op = OT + (32 * mt + 4 * (lno >> 5)) * 132 + 32 * vt0 + (lno & 31);
#pragma unroll
                  for (int r = 0; r < 16; ++r) { const int tr = (r & 3) + 8 * (r >> 2); op[tr * 132] = acc0[r]; op[tr * 132 + 32] = acc1[r]; } }
                __syncthreads();
            }
            { const size_t grow = r0 + prow;
              float o[32];
#pragma unroll
              for (int i = 0; i < 4; ++i) { const u32x4 w = olc[i];
                  o[8 * i] = bflo(w.x); o[8 * i + 1] = bfhi(w.x); o[8 * i + 2] = bflo(w.y); o[8 * i + 3] = bfhi(w.y); o[8 * i + 4] = bflo(w.z); o[8 * i + 5] = bfhi(w.z); o[8 * i + 6] = bflo(w.w); o[8 * i + 7] = bfhi(w.w); }
              if (seg > 0) {
#pragma unroll
                  for (int i = 0; i < 8; ++i) { const f32x4 x = *(const LAS f32x4*)(OT + prow * 132 + 32 * ppart + 4 * i); o[4 * i] += x.x; o[4 * i + 1] += x.y; o[4 * i + 2] += x.z; o[4 * i + 3] += x.w; } }
              float ss = 0.f;
#pragma unroll
              for (int i = 0; i < 32; ++i) ss += o[i] * o[i];
              ss += __shfl_xor(ss, 1); ss += __shfl_xor(ss, 2);
              const float rs = rsqrtf(ss * (1.f / 128.f) + EPS);
#pragma unroll
              for (int i = 0; i < 4; ++i) { const u32x4 gw = gtc[i];
                  const f32x4 g0 = *(const f32x4*)(og + h * 128 + 32 * ppart + 8 * i), g1 = *(const f32x4*)(og + h * 128 + 32 * ppart + 8 * i + 4);
                  float e[8];
                  e[0] = o[8 * i] * rs * g0.x * bflo(gw.x); e[1] = o[8 * i + 1] * rs * g0.y * bfhi(gw.x); e[2] = o[8 * i + 2] * rs * g0.z * bflo(gw.y); e[3] = o[8 * i + 3] * rs * g0.w * bfhi(gw.y);
                  e[4] = o[8 * i + 4] * rs * g1.x * bflo(gw.z); e[5] = o[8 * i + 5] * rs * g1.y * bfhi(gw.z); e[6] = o[8 * i + 6] * rs * g1.z * bflo(gw.w); e[7] = o[8 * i + 7] * rs * g1.w * bfhi(gw.w);
                  st8(H0 + grow * 2048 + 1024 + pc0 + 8 * i, e); }
            }
        }
#undef HB_LOAD
    }
}

__device__ __forceinline__ void gmlp_simple(const Params& p, LAS unsigned char* lds, int vb, int G, int row_lo) {
    LAS float* smean = (LAS float*)lds; LAS float* srstd = smean + 128;
    const f32x2* VST = (const f32x2*)(p.ws + WS_VST); const bf16_t* GV = (const bf16_t*)p.out; bf16_t* UG = (bf16_t*)(p.ws + WS_UG);
    const float *lg = p.in[15], *lb_ = p.in[16], *wsp = p.in[17], *bs = p.in[18];
    const int tid = opaque((int)threadIdx.x), ch = tid * 4, h = tid >> 6;
    const f32x4 g4 = *(const f32x4*)(lg + ch), b4 = *(const f32x4*)(lb_ + ch);
    for (int r = row_lo + vb; r < T; r += G) {
        int t, cstart;
        if (r < TP) { t = r & 127; cstart = r - t; } else { t = (r - TP) & 7; cstart = r - t; }
        __syncthreads();
        if (tid <= t) { const size_t row = (size_t)(cstart + tid); float s = 0.f, q = 0.f;
            for (int j = 0; j < 32; ++j) { const f32x2 st = VST[row * 32 + j]; s += st.x; q += st.y; }
            const float mean = s * (1.f / 2048.f); const float var = q * (1.f / 2048.f) - mean * mean; smean[tid] = mean; srstd[tid] = rsqrtf(var + EPS); }
        __syncthreads();
        float a0 = 0.f, a1 = 0.f, a2 = 0.f, a3 = 0.f, v0 = 0.f, v1 = 0.f, v2 = 0.f, v3 = 0.f;
        for (int s = 0; s <= t; ++s) {
            const float w = wsp[(size_t)(h * 128 + t) * 128 + s], m = smean[s], rs = srstd[s];
            const u32x2 gvw = *(const u32x2*)(GV + (size_t)(cstart + s) * DC + ch);
            v0 = (bflo(gvw.x) - m) * rs * g4.x + b4.x; v1 = (bfhi(gvw.x) - m) * rs * g4.y + b4.y; v2 = (bflo(gvw.y) - m) * rs * g4.z + b4.z; v3 = (bfhi(gvw.y) - m) * rs * g4.w + b4.w;
            a0 += w * v0; a1 += w * v1; a2 += w * v2; a3 += w * v3;
        }
        const float bias = bs[h * 128 + t];
        const u32x2 ugw = *(const u32x2*)(UG + (size_t)r * DC + ch);
        u32x2 o; o.x = pk2(bflo(ugw.x) * (a0 + bias), bfhi(ugw.x) * (a1 + bias)); o.y = pk2(bflo(ugw.y) * (a2 + bias), bfhi(ugw.y) * (a3 + bias));
        *(u32x2*)(UG + (size_t)r * DC + ch) = o;
        if (r < TP) { const int tt = (r & 2047) - 1920; if (tt >= 0) *(f32x4*)(p.out + O_GP + ((size_t)(r >> 11) * 128 + tt) * DC + ch) = (f32x4){v0, v1, v2, v3}; }
        else *(f32x4*)(p.out + O_GS + (size_t)(r - TP) * DC + ch) = (f32x4){v0, v1, v2, v3};
    }
}


constexpr int GM_W = 0, GM_VT = 34816, GM_MR = 34816 + 69632, GM_PITCH = 272;
__device__ __forceinline__ void gmlp_fast(const Params& p, LAS unsigned char* lds, int vb, int G) {
    LAS float* smean = (LAS float*)(lds + GM_MR); LAS float* srstd = smean + 128;
    const f32x2* VST = (const f32x2*)(p.ws + WS_VST); const bf16_t* GV = (const bf16_t*)p.out; bf16_t* UG = (bf16_t*)(p.ws + WS_UG);
    const float *lg = p.in[15], *lb_ = p.in[16], *wsp = p.in[17], *bs = p.in[18];
    const int tid = opaque((int)threadIdx.x), lane = tid & 63, wid = __builtin_amdgcn_readfirstlane(tid >> 6);
    for (int sitem = vb; sitem < 256; sitem += G) {
        const int chunk = sitem >> 1, hh = (sitem & 1) * 4; const size_t cstart = (size_t)chunk * 128;
        const bool lastchunk = (chunk & 15) == 15; const int bseq = chunk >> 4;
        __syncthreads();
        if (tid < 128) { const f32x4* sp = (const f32x4*)(VST + (cstart + tid) * 32); float s = 0.f, q = 0.f;
#pragma unroll
            for (int j = 0; j < 16; ++j) { const f32x4 a = sp[j]; s += a.x + a.z; q += a.y + a.w; }
            const float mean = s * (1.f / 2048.f); const float var = q * (1.f / 2048.f) - mean * mean; smean[tid] = mean; srstd[tid] = rsqrtf(var + EPS); }
        for (int h = hh; h < hh + 4; ++h) {
            __syncthreads();
            for (int q = tid; q < 4096; q += NTHR) { const int t = q >> 5, s0 = (q & 31) * 4; const f32x4 w = *(const f32x4*)(wsp + (size_t)(h * 128 + t) * 128 + s0);
                u32x2 o; o.x = pk2(s0 <= t ? w.x : 0.f, s0 + 1 <= t ? w.y : 0.f); o.y = pk2(s0 + 2 <= t ? w.z : 0.f, s0 + 3 <= t ? w.w : 0.f);
                *(LAS u32x2*)(lds + GM_W + t * GM_PITCH + s0 * 2) = o; }
            { u32x4 ra[4], rb[4];
#pragma unroll
              for (int it = 0; it < 4; ++it) { const int q = tid + it * NTHR, l = q & 63, wq = q >> 6; const int sp = 16 * (wq & 3) + (l & 15), oc = 4 * (wq >> 2) + (l >> 4);
                  const bf16_t* src = GV + (cstart + 2 * sp) * DC + h * 256 + 8 * oc; ra[it] = *(const u32x4*)src; rb[it] = *(const u32x4*)(src + DC); }
#pragma unroll
              for (int it = 0; it < 4; ++it) { const int q = tid + it * NTHR, l = q & 63, wq = q >> 6; const int sp = 16 * (wq & 3) + (l & 15), oc = 4 * (wq >> 2) + (l >> 4);
                  const int col = h * 256 + 8 * oc; const f32x4 ga = *(const f32x4*)(lg + col), gb = *(const f32x4*)(lg + col + 4), ba = *(const f32x4*)(lb_ + col), bb = *(const f32x4*)(lb_ + col + 4);
                  const float m0 = smean[2 * sp], r0s = srstd[2 * sp], m1 = smean[2 * sp + 1], r1s = srstd[2 * sp + 1];
                  float x[8], y[8];
                  x[0] = (bflo(ra[it].x) - m0) * r0s * ga.x + ba.x; x[1] = (bfhi(ra[it].x) - m0) * r0s * ga.y + ba.y; x[2] = (bflo(ra[it].y) - m0) * r0s * ga.z + ba.z; x[3] = (bfhi(ra[it].y) - m0) * r0s * ga.w + ba.w;
                  x[4] = (bflo(ra[it].z) - m0) * r0s * gb.x + bb.x; x[5] = (bfhi(ra[it].z) - m0) * r0s * gb.y + bb.y; x[6] = (bflo(ra[it].w) - m0) * r0s * gb.z + bb.z; x[7] = (bfhi(ra[it].w) - m0) * r0s * gb.w + bb.w;
                  y[0] = (bflo(rb[it].x) - m1) * r1s * ga.x + ba.x; y[1] = (bfhi(rb[it].x) - m1) * r1s * ga.y + ba.y; y[2] = (bflo(rb[it].y) - m1) * r1s * ga.z + ba.z; y[3] = (bfhi(rb[it].y) - m1) * r1s * ga.w + ba.w;
                  y[4] = (bflo(rb[it].z) - m1) * r1s * gb.x + bb.x; y[5] = (bfhi(rb[it].z) - m1) * r1s * gb.y + bb.y; y[6] = (bflo(rb[it].w) - m1) * r1s * gb.z + bb.z; y[7] = (bfhi(rb[it].w) - m1) * r1s * gb.w + bb.w;
                  LAS unsigned char* vp = lds + GM_VT + (8 * oc) * GM_PITCH + sp * 4;
#pragma unroll
                  for (int e = 0; e < 8; ++e) *(LAS unsigned*)(vp + e * GM_PITCH) = pk2(x[e], y[e]);
                  if (lastchunk) { float* o = p.out + O_GP + ((size_t)bseq * 128 + 2 * sp) * DC + col;
                      *(f32x4*)o = (f32x4){x[0], x[1], x[2], x[3]}; *(f32x4*)(o + 4) = (f32x4){x[4], x[5], x[6], x[7]};
                      *(f32x4*)(o + DC) = (f32x4){y[0], y[1], y[2], y[3]}; *(f32x4*)(o + DC + 4) = (f32x4){y[4], y[5], y[6], y[7]}; }
              } }
            __syncthreads();
            f32x16 acc[4];
#pragma unroll
            for (int mt = 0; mt < 4; ++mt)
#pragma unroll
                for (int r = 0; r < 16; ++r) acc[mt][r] = 0.f;
#pragma unroll
            for (int ks = 0; ks < 8; ++ks) { const bf16x8 b = ldfrag(lds + GM_VT, GM_PITCH, 32 * wid, 16 * ks, lane);
#pragma unroll
                for (int mt = 0; mt < 4; ++mt) if (ks < 2 * (mt + 1)) { const bf16x8 a = ldfrag(lds + GM_W, GM_PITCH, 32 * mt, 16 * ks, lane); acc[mt] = MFMA32(a, b, acc[mt]); } }
            u32x4 ugv[8];
#pragma unroll
            for (int it = 0; it < 8; ++it) { const int q = tid + it * NTHR; ugv[it] = *(const u32x4*)(UG + (cstart + (q >> 5)) * DC + h * 256 + 8 * (q & 31)); }
            __syncthreads();
            { const int lnm = opaque(lane); LAS unsigned char* mp = lds + GM_VT + (4 * (lnm >> 5)) * 528 + (32 * wid + (lnm & 31)) * 2; const float* bp = bs + h * 128 + 4 * (lnm >> 5);
#pragma unroll
              for (int mt = 0; mt < 4; ++mt)
#pragma unroll
                  for (int r = 0; r < 16; ++r) { const int tr = 32 * mt + (r & 3) + 8 * (r >> 2); *(LAS bf16_t*)(mp + tr * 528) = (bf16_t)f2bf(acc[mt][r] + bp[tr]); } }
            __syncthreads();
#pragma unroll
            for (int it = 0; it < 8; ++it) { const int q = tid + it * NTHR; const int t = q >> 5, oc = q & 31;
                const u32x4 m = *(const LAS u32x4*)(lds + GM_VT + t * 528 + oc * 16); const u32x4 u = ugv[it]; u32x4 o;
                o.x = pk2(bflo(u.x) * bflo(m.x), bfhi(u.x) * bfhi(m.x)); o.y = pk2(bflo(u.y) * bflo(m.y), bfhi(u.y) * bfhi(m.y));
                o.z = pk2(bflo(u.z) * bflo(m.z), bfhi(u.z) * bfhi(m.z)); o.w = pk2(bflo(u.w) * bflo(m.w), bfhi(u.w) * bfhi(m.w));
                *(u32x4*)(UG + (cstart + t) * DC + h * 256 + 8 * oc) = o; }
        }
    }
}


__device__ __forceinline__ void gmlp_sample(const Params& p, LAS unsigned char* lds, int vb, int G) {
    LAS float* smean = (LAS float*)(lds + GM_MR); LAS float* srstd = smean + 128;
    const f32x2* VST = (const f32x2*)(p.ws + WS_VST); const bf16_t* GV = (const bf16_t*)p.out; bf16_t* UG = (bf16_t*)(p.ws + WS_UG);
    const float *lg = p.in[15], *lb_ = p.in[16], *wsp = p.in[17], *bs = p.in[18];
    const int tid = opaque((int)threadIdx.x), ch = tid * 4; const int h = __builtin_amdgcn_readfirstlane(tid >> 6);
    const f32x4 g4 = *(const f32x4*)(lg + ch), b4 = *(const f32x4*)(lb_ + ch);
    for (int sb = vb; sb < 128; sb += G) {
        const size_t r0 = (size_t)TP + sb * 8;
        __syncthreads();
        if (tid < 64) { const int t = tid >> 3, q = tid & 7; const f32x4* sp = (const f32x4*)(VST + (r0 + t) * 32 + q * 4); const f32x4 a = sp[0], b = sp[1];
            float s_ = (a.x + a.z) + (b.x + b.z), q_ = (a.y + a.w) + (b.y + b.w);
            s_ += __shfl_xor(s_, 1); q_ += __shfl_xor(q_, 1); s_ += __shfl_xor(s_, 2); q_ += __shfl_xor(q_, 2); s_ += __shfl_xor(s_, 4); q_ += __shfl_xor(q_, 4);
            const float mean = s_ * (1.f / 2048.f); const float var = q_ * (1.f / 2048.f) - mean * mean;
            if (q == 0) { smean[t] = mean; srstd[t] = rsqrtf(var + EPS); } }
        u32x2 gvw[8], ugw[8];
#pragma unroll
        for (int t = 0; t < 8; ++t) { gvw[t] = *(const u32x2*)(GV + (r0 + t) * DC + ch); ugw[t] = *(const u32x2*)(UG + (r0 + t) * DC + ch); }
        __syncthreads();
        float vn[8][4];
#pragma unroll
        for (int sx = 0; sx < 8; ++sx) { const float m = smean[sx], rs = srstd[sx];
            vn[sx][0] = (bflo(gvw[sx].x) - m) * rs * g4.x + b4.x; vn[sx][1] = (bfhi(gvw[sx].x) - m) * rs * g4.y + b4.y; vn[sx][2] = (bflo(gvw[sx].y) - m) * rs * g4.z + b4.z; vn[sx][3] = (bfhi(gvw[sx].y) - m) * rs * g4.w + b4.w; }
#pragma unroll
        for (int t = 0; t < 8; ++t) { const float bias = bs[h * 128 + t]; float a0 = bias, a1 = bias, a2 = bias, a3 = bias;
#pragma unroll
            for (int sx = 0; sx <= t; ++sx) { const float w = wsp[(size_t)(h * 128 + t) * 128 + sx]; a0 += w * vn[sx][0]; a1 += w * vn[sx][1]; a2 += w * vn[sx][2]; a3 += w * vn[sx][3]; }
            u32x2 o; o.x = pk2(bflo(ugw[t].x) * a0, bfhi(ugw[t].x) * a1); o.y = pk2(bflo(ugw[t].y) * a2, bfhi(ugw[t].y) * a3);
            *(u32x2*)(UG + (r0 + t) * DC + ch) = o;
            *(f32x4*)(p.out + O_GS + ((size_t)sb * 8 + t) * DC + ch) = (f32x4){vn[t][0], vn[t][1], vn[t][2], vn[t][3]}; }
    }
}

__device__ __forceinline__ void final_norm(const Params& p, int vb, int G) {
    const int tid = opaque((int)threadIdx.x), lane = tid & 63, wave = tid >> 6;
    const int gw = vb * NWAVES + wave, NGW = G * NWAVES;
    const float* SSP = (const float*)(p.ws + WS_SSP2); const float* g = p.in[20];
    f32x4 gg[4];
#pragma unroll
    for (int j = 0; j < 4; ++j) gg[j] = ((const f32x4*)g)[lane + 64 * j];
    for (int r = gw; r < T; r += 2 * NGW) {
        const int r2 = (r + NGW < T) ? r + NGW : r;
        f32x4* y = (f32x4*)(p.out + (size_t)r * D) + lane; f32x4* y2 = (f32x4*)(p.out + (size_t)r2 * D) + lane;
        f32x4 v[4], w[4];
#pragma unroll
        for (int j = 0; j < 4; ++j) { v[j] = y[64 * j]; w[j] = y2[64 * j]; }
        float rs, rs2;
        { const f32x4* s = (const f32x4*)(SSP + (size_t)r * 16); const f32x4 a = s[0], b = s[1], c = s[2], d = s[3];
          rs = rsqrtf((((a.x + a.y) + (a.z + a.w)) + ((b.x + b.y) + (b.z + b.w)) + ((c.x + c.y) + (c.z + c.w)) + ((d.x + d.y) + (d.z + d.w))) * (1.f / 1024.f) + EPS); }
        { const f32x4* s = (const f32x4*)(SSP + (size_t)r2 * 16); const f32x4 a = s[0], b = s[1], c = s[2], d = s[3];
          rs2 = rsqrtf((((a.x + a.y) + (a.z + a.w)) + ((b.x + b.y) + (b.z + b.w)) + ((c.x + c.y) + (c.z + c.w)) + ((d.x + d.y) + (d.z + d.w))) * (1.f / 1024.f) + EPS); }
#pragma unroll
        for (int j = 0; j < 4; ++j) { f32x4 o = v[j]; o.x *= rs * gg[j].x; o.y *= rs * gg[j].y; o.z *= rs * gg[j].z; o.w *= rs * gg[j].w; y[64 * j] = o; }
        if (r2 != r) {
#pragma unroll
            for (int j = 0; j < 4; ++j) { f32x4 o = w[j]; o.x *= rs2 * gg[j].x; o.y *= rs2 * gg[j].y; o.z *= rs2 * gg[j].z; o.w *= rs2 * gg[j].w; y2[64 * j] = o; } }
    }
}

__global__ void __launch_bounds__(NTHR, 2) fwd_kernel(Params p) {
    extern __shared__ __attribute__((aligned(16))) unsigned char lds_raw[];
    LAS unsigned char* lds = (LAS unsigned char*)lds_raw;
    { volatile LAS unsigned* st0 = (volatile LAS unsigned*)(lds + LDS_BYTES - 64); if (threadIdx.x < 16) st0[threadIdx.x] = 0u; }
    __syncthreads();
    const XcdBarrier bar = xcd_barrier_post((unsigned*)p.ws, (volatile LAS unsigned*)(lds + LDS_BYTES - 64));
    const int G = gridDim.x, vb = blockIdx.x;
    unsigned long long stamps[16];
#define STAMP(k) do { if (PROBE_A >= 0) stamps[k] = __builtin_amdgcn_s_memrealtime(); } while (0)
    STAMP(0);
    bf16_t* WT1 = (bf16_t*)(p.ws + WS_WT1); bf16_t* WT2 = (bf16_t*)(p.ws + WS_WT2); bf16_t* WT3 = (bf16_t*)(p.ws + WS_WT3); bf16_t* WT4 = (bf16_t*)(p.ws + WS_WT4);
    bf16_t* ZR = (bf16_t*)(p.ws + WS_R1);

    phase0(p, lds, vb, G);
    xcd_barrier(bar); STAMP(1);
    { Epi1 E{ZR, (const float*)(p.ws + WS_LB)}; GEMM(lds, (const bf16_t*)p.out, WT1, T, N1, D, E, vb, G); STAMP(14); }
    xcd_barrier(bar); STAMP(2);
    hgrn_phaseA(p, lds, vb, G); STAMP(10);
    hgrn_sample(p, lds, vb, G); STAMP(11);
    conv_fast(p, lds, vb, G); STAMP(12);
    xcd_barrier(bar); STAMP(3);
    hgrn_phaseB(p, lds, vb, G);
    xcd_barrier(bar); STAMP(4);
    { Epi2 E{p.in[0], p.in[1], (float*)(p.ws + WS_X1), (bf16_t*)(p.ws + WS_X1B), (float*)(p.ws + WS_SSP1)}; GEMM(lds, (const bf16_t*)p.out, WT2, TP, D, 2048, E, vb, G); STAMP(15); gemm_small<Epi2, 8>(lds, (const bf16_t*)p.out + (size_t)TP * 2048, WT2, D, 2048, E, TP, vb, G); }
    xcd_barrier(bar); STAMP(5);
    { Epi3 E{(const float*)(p.ws + WS_SSP1), (bf16_t*)(p.ws + WS_UG), (bf16_t*)p.out, (f32x2*)(p.ws + WS_VST)}; GEMM(lds, (const bf16_t*)(p.ws + WS_X1B), WT3, T, N3, D, E, vb, G); }
    xcd_barrier(bar); STAMP(6);
    gmlp_fast(p, lds, vb, G); STAMP(13);
    gmlp_sample(p, lds, vb, G);
    xcd_barrier(bar); STAMP(7);
    { Epi4 E{(const float*)(p.ws + WS_X1), p.out, (float*)(p.ws + WS_SSP2)}; GEMM(lds, (const bf16_t*)(p.ws + WS_UG), WT4, TP, D, 2048, E, vb, G); gemm_small<Epi4, 8>(lds, (const bf16_t*)(p.ws + WS_UG) + (size_t)TP * 2048, WT4, D, 2048, E, TP, vb, G); }
    xcd_barrier(bar); STAMP(8);
    final_norm(p, vb, G);
    STAMP(9);
    if (PROBE_A >= 0 && blockIdx.x == 0 && threadIdx.x == 0) {
#ifdef PROBE_EXPR
        const unsigned long long da = PROBE_EXPR;
#else
        const unsigned long long da = stamps[PROBE_B] - stamps[PROBE_A];
#endif
        const unsigned long long wait = 8ull * da, t0 = __builtin_amdgcn_s_memrealtime();
        while (__builtin_amdgcn_s_memrealtime() - t0 < wait) __builtin_amdgcn_s_sleep(32);
    }
}

extern "C" void kernel_launch(void* const* d_in, const int* in_sizes, int n_in, void* d_out, int out_size, void* d_ws, size_t ws_size, hipStream_t stream) {
    static int grid = 0;
    if (grid == 0) {
        if (n_in != 21 || (size_t)out_size != O_END || ws_size < WS_END) { fprintf(stderr, "kernel_launch: unexpected shapes: n_in %d out %d ws %zu\n", n_in, out_size, ws_size); grid = -1; return; }
        int dev = 0, cus = 0, per_cu = 0;
        if (hipGetDevice(&dev) != hipSuccess || hipDeviceGetAttribute(&cus, hipDeviceAttributeMultiprocessorCount, dev) != hipSuccess) { grid = -1; return; }
        if (hipFuncSetAttribute((const void*)fwd_kernel, hipFuncAttributeMaxDynamicSharedMemorySize, LDS_BYTES) != hipSuccess) { fprintf(stderr, "kernel_launch: hipFuncSetAttribute failed\n"); grid = -1; return; }
        if (hipOccupancyMaxActiveBlocksPerMultiprocessor(&per_cu, (const void*)fwd_kernel, NTHR, LDS_BYTES) != hipSuccess || per_cu < 1) { fprintf(stderr, "kernel_launch: occupancy query says %d\n", per_cu); grid = -1; return; }
        grid = cus;
    }
    if (grid < 0) return;
    if (hipMemsetAsync(d_ws, 0, 16384, stream) != hipSuccess) { fprintf(stderr, "kernel_launch: memset failed\n"); return; }
    Params p{};
    for (int i = 0; i < 21; ++i) p.in[i] = (const float*)d_in[i];
    p.out = (float*)d_out; p.ws = (unsigned char*)d_ws;
    void* args[] = {&p};
    hipError_t e = hipLaunchCooperativeKernel((const void*)fwd_kernel, dim3(grid), dim3(NTHR), args, LDS_BYTES, stream);
    if (e != hipSuccess) fprintf(stderr, "kernel_launch: cooperative launch failed: %s (grid %d)\n", hipGetErrorString(e), grid);
}
```

```cpp
#include <hip/hip_runtime.h>
#include <cstdio>
#include <cstdint>

#ifndef PROBE_A
#define PROBE_A -1
#define PROBE_B -1
#endif
#ifndef FAST_GEMM
#define FAST_GEMM 1
#endif

#define LAS __attribute__((address_space(3)))
typedef unsigned short bf16_t;
typedef short bf16x8 __attribute__((ext_vector_type(8)));
typedef float f32x4 __attribute__((ext_vector_type(4)));
typedef float f32x2 __attribute__((ext_vector_type(2)));
typedef unsigned u32x4 __attribute__((ext_vector_type(4)));
typedef unsigned u32x2 __attribute__((ext_vector_type(2)));

constexpr int D = 1024, TP = 16384, TS = 1024, T = TP + TS;
constexpr int N1 = 7168, N3 = 6144, DC = 2048;
constexpr float EPS = 1e-6f;
constexpr int NWAVES = 8, NTHR = 512;
constexpr int LDS_BYTES = 147456;
constexpr size_t MiB = (size_t)1 << 20;
constexpr size_t WS_LB = 65536;
constexpr size_t WS_WT1 = 1 * MiB, WS_WT2 = 15 * MiB, WS_WT3 = 19 * MiB, WS_WT4 = 31 * MiB;
constexpr size_t WS_R1 = 35 * MiB;
constexpr size_t WS_X1 = WS_R1, WS_X1B = WS_R1 + 68 * MiB, WS_UG = WS_R1 + 102 * MiB;
constexpr size_t WS_SSP1 = WS_R1 + 170 * MiB, WS_VST = WS_R1 + 172 * MiB, WS_SSP2 = WS_R1 + 178 * MiB;
constexpr size_t WS_SEG = 239 * MiB;
constexpr size_t WS_END = 255 * MiB;
constexpr size_t O_YP = 0, O_YS = 16777216, O_CP = 17825792, O_HP = 18071552, O_GP = 19120128, O_CS = 21217280, O_HS = 25149440, O_GS = 41926656, O_END = 44023808;

struct Params { const float* in[21]; float* out; unsigned char* ws; };

__device__ __forceinline__ int opaque(int x) { asm volatile("" : "+v"(x)); return x; }
__device__ __forceinline__ float bf2f(unsigned b) { return __uint_as_float(b << 16); }
__device__ __forceinline__ float bflo(unsigned w) { return __uint_as_float(w << 16); }
__device__ __forceinline__ float bfhi(unsigned w) { return __uint_as_float(w & 0xffff0000u); }
__device__ __forceinline__ unsigned f2bf(float f) { unsigned u = __float_as_uint(f); return (u + 0x7fffu + ((u >> 16) & 1u)) >> 16; }
__device__ __forceinline__ unsigned pk2(float lo, float hi) { unsigned r; asm("v_cvt_pk_bf16_f32 %0, %1, %2" : "=v"(r) : "v"(lo), "v"(hi)); return r; }
__device__ __forceinline__ float sigm(float x) { return __builtin_amdgcn_rcpf(1.0f + __builtin_amdgcn_exp2f(-1.4426950408889634f * x)); }
__device__ __forceinline__ float silu(float x) { return x * sigm(x); }
__device__ __forceinline__ float gelu_t(float x) { return x * sigm(1.5957691216057308f * (x + 0.044715f * x * x * x)); }
__device__ __forceinline__ float wave_sum(float v) {
#pragma unroll
    for (int o = 1; o < 64; o <<= 1) v += __shfl_xor(v, o);
    return v;
}
__device__ __forceinline__ void st8(bf16_t* p, const float (&v)[8]) {
    u32x4 w; w.x = pk2(v[0], v[1]); w.y = pk2(v[2], v[3]); w.z = pk2(v[4], v[5]); w.w = pk2(v[6], v[7]); *(u32x4*)p = w;
}
__device__ __forceinline__ float block_sum(float v, LAS float* red) {
    v = wave_sum(v);
    __syncthreads();
    if ((threadIdx.x & 63) == 0) red[threadIdx.x >> 6] = v;
    __syncthreads();
    float s = 0.f;
#pragma unroll
    for (int i = 0; i < 8; ++i) s += red[i];
    return s;
}


typedef __attribute__((address_space(1))) unsigned gu32;
#define XB_TMO      128
#define XB_XCNT(j)  (256  + 64 * (j))
#define XB_XSUB(j)  (1280 + 64 * (j))
#define XB_XGEN(j)  (2304 + 64 * (j))
#define XB_TOP      3328
#define XB_TOPGEN   3392
#define XCD_BAR_WORDS 3456
#define XB_SPIN_CAP (1u << 20)

__device__ __forceinline__ unsigned xb_ld(unsigned* p)              { return __hip_atomic_load(p, __ATOMIC_RELAXED, __HIP_MEMORY_SCOPE_AGENT); }
__device__ __forceinline__ unsigned xb_add(unsigned* p, unsigned v) { return __hip_atomic_fetch_add(p, v, __ATOMIC_RELAXED, __HIP_MEMORY_SCOPE_AGENT); }
__device__ __forceinline__ unsigned xb_xcc_id() { return (unsigned)__builtin_amdgcn_s_getreg((3 << 11) | 20) & 0xFu; }
#define XB_SPIN(cond, bar) do { unsigned _sp = 0; while (cond) { __builtin_amdgcn_s_sleep(1); \
    if ((++_sp & 255u) == 0u) { if (xb_ld(&(bar)[XB_TMO])) break; if (_sp > XB_SPIN_CAP) { atomicAdd(&(bar)[XB_TMO], 1u); break; } } } } while (0)

struct XcdBarrier {
    unsigned* bar; unsigned x;
    volatile LAS unsigned* st;
};

__device__ __forceinline__ XcdBarrier xcd_barrier_post(unsigned* bar, volatile LAS unsigned* st) {
    XcdBarrier b; b.bar = bar; b.x = xb_xcc_id(); b.st = st;
    if (threadIdx.x == 0) (void)xb_add(&bar[XB_XCNT(b.x)], 1u);
    return b;
}
__device__ __forceinline__ void xcd_barrier_complete(unsigned* bar, unsigned x, unsigned& nloc, unsigned& nx) {
    const unsigned G = gridDim.x * gridDim.y * gridDim.z;
    unsigned sum, cnt, mine, sp = 0u;
    for (;;) {
        sum = 0u; cnt = 0u; mine = 0u;
#pragma unroll
        for (unsigned j = 0; j < 16; ++j) { const unsigned c = xb_ld(&bar[XB_XCNT(j)]); sum += c; cnt += (c > 0u) ? 1u : 0u; mine = (j == x) ? c : mine; }
        if (sum == G) break;
        __builtin_amdgcn_s_sleep(1);
        if ((++sp & 255u) == 0u) { if (xb_ld(&bar[XB_TMO])) break; if (sp > XB_SPIN_CAP) { atomicAdd(&bar[XB_TMO], 1u); break; } }
    }
    nloc = mine > 0u ? mine : 1u; nx = cnt > 0u ? cnt : 1u;
}

__device__ __forceinline__ void xcd_barrier(const XcdBarrier& b) {
    asm volatile("s_waitcnt vmcnt(0)" ::: "memory");
    __syncthreads();
    if (threadIdx.x == 0) {
        unsigned* bar = b.bar;
        __builtin_amdgcn_s_waitcnt(0);
        unsigned nloc = b.st[0], nx = b.st[1];
        if (nloc == 0u) { xcd_barrier_complete(bar, b.x, nloc, nx); b.st[0] = nloc; b.st[1] = nx; }
        const unsigned old = xb_add(&bar[XB_XSUB(b.x)], 1u);
        const unsigned gen = old / nloc;
        if (old + 1u == (gen + 1u) * nloc) {
            __builtin_amdgcn_fence(__ATOMIC_RELEASE, "agent");
            asm volatile("s_waitcnt vmcnt(0)" ::: "memory");
            const unsigned og = xb_add(&bar[XB_TOP], 1u);
            const unsigned tg = og / nx;
            if (og + 1u == (tg + 1u) * nx) xb_add(&bar[XB_TOPGEN], 1u);
            else XB_SPIN(xb_ld(&bar[XB_TOPGEN]) == tg, bar);
            __builtin_amdgcn_fence(__ATOMIC_ACQUIRE, "agent");
            xb_add(&bar[XB_XGEN(b.x)], 1u);
            asm volatile("s_waitcnt vmcnt(0)" ::: "memory");
        } else {
            XB_SPIN(xb_ld(&bar[XB_XGEN(b.x)]) == gen, bar);
            __builtin_amdgcn_fence(__ATOMIC_ACQUIRE, "agent");
            asm volatile("s_waitcnt vmcnt(0)" ::: "memory");
        }
    }
    __syncthreads();
}

template <int MAP> __device__ __forceinline__ int vmap(int vc) {
    const int vt = vc >> 8, c = vc & 255;
    if (MAP == 1) return vt < 8 ? (c < 128 ? 128 * vt + c : 1024 + 128 * vt + (c - 128)) : vc;
    if (MAP == 3) return vt < 16 ? (c < 128 ? 128 * vt + c : 4096 + 128 * vt + (c - 128)) : vc - 2048;
    return vc;
}

template <int MAP> __device__ __forceinline__ void transpose_item(const float* W, int K, int N, bf16_t* WT, const float* kscale, LAS float* scr, int item, int lane) {
    const int nblk = N / 32, kb = item / nblk, nb = item % nblk, k0 = 64 * kb, n0 = 32 * nb;
    const int on0 = vmap<MAP>(n0);
#pragma unroll 8
    for (int i = 0; i < 32; ++i) { const int kk = 2 * i + (lane >> 5); float w = W[(size_t)(k0 + kk) * N + on0 + (lane & 31)]; if (kscale) w *= kscale[k0 + kk]; scr[kk * 33 + (lane & 31)] = w; }
    asm volatile("s_waitcnt lgkmcnt(0)" ::: "memory");
    const int c = lane & 7;
#pragma unroll
    for (int j = 0; j < 4; ++j) { const int n = (lane >> 3) + 8 * j; const LAS float* s = scr + (8 * c) * 33 + n;
        u32x4 o; o.x = pk2(s[0 * 33], s[1 * 33]); o.y = pk2(s[2 * 33], s[3 * 33]); o.z = pk2(s[4 * 33], s[5 * 33]); o.w = pk2(s[6 * 33], s[7 * 33]);
        *(u32x4*)(WT + (size_t)(n0 + n) * K + k0 + 8 * c) = o; }
    asm volatile("s_waitcnt lgkmcnt(0)" ::: "memory");
}
__device__ __forceinline__ void rms_row_to_bf16(const float* xrow, const float* g, bf16_t* orow, int lane) {
    const f32x4* xr = (const f32x4*)xrow + lane; f32x4 v[4]; float s = 0.f;
#pragma unroll
    for (int j = 0; j < 4; ++j) { v[j] = xr[64 * j]; s += (v[j].x * v[j].x + v[j].y * v[j].y) + (v[j].z * v[j].z + v[j].w * v[j].w); }
    const float rs = rsqrtf(wave_sum(s) * (1.f / 1024.f) + EPS);
    u32x2* o8 = (u32x2*)orow + lane;
#pragma unroll
    for (int j = 0; j < 4; ++j) { const f32x4 gg = ((const f32x4*)g)[lane + 64 * j]; u32x2 w; w.x = pk2(v[j].x * rs * gg.x, v[j].y * rs * gg.y); w.y = pk2(v[j].z * rs * gg.z, v[j].w * rs * gg.w); o8[64 * j] = w; }
}
__device__ __forceinline__ void phase0(const Params& p, LAS unsigned char* lds, int vb, int G) {
    const int tid = opaque((int)threadIdx.x), lane = tid & 63, wave = tid >> 6;
    const int gw = vb * NWAVES + wave, NGW = G * NWAVES;
    float* LB = (float*)(p.ws + WS_LB);
    for (int i = vb * NTHR + tid; i < 1024; i += G * NTHR) { const float l0 = p.in[10][i], l1 = p.in[10][1024 + i]; LB[i] = 1.0f / (1.0f + __expf(l1 - l0)); }
    LAS float* scr = (LAS float*)(lds + wave * 16384);
    constexpr int I1 = (D / 64) * (N1 / 32), I2 = (2048 / 64) * (D / 32), I3 = (D / 64) * (N3 / 32), I4 = I2;
    for (int it = gw; it < I1 + I2 + I3 + I4; it += NGW) {
        int r = it;
        if (r < I1) { transpose_item<1>(p.in[5], D, N1, (bf16_t*)(p.ws + WS_WT1), nullptr, scr, r, lane); continue; } r -= I1;
        if (r < I2) { transpose_item<0>(p.in[12], 2048, D, (bf16_t*)(p.ws + WS_WT2), nullptr, scr, r, lane); continue; } r -= I2;
        if (r < I3) { transpose_item<3>(p.in[14], D, N3, (bf16_t*)(p.ws + WS_WT3), p.in[13], scr, r, lane); continue; } r -= I3;
        transpose_item<0>(p.in[19], 2048, D, (bf16_t*)(p.ws + WS_WT4), nullptr, scr, r, lane);
    }
    bf16_t* XN0 = (bf16_t*)p.out;
    for (int r = gw; r < T; r += NGW) { const float* xr = r < TP ? p.in[0] + (size_t)r * D : p.in[1] + (size_t)(r - TP) * D; rms_row_to_bf16(xr, p.in[4], XN0 + (size_t)r * D, lane); }
}

struct Epi1 {
    bf16_t* Z; const float* LB;
    __device__ __forceinline__ float rowscale(int) const { return 1.f; }
    template <int X1M, int X2M> __device__ __forceinline__ void tile8(int row, int pn, int c0, const float (&lo)[8], const float (&hi)[8], float) const {
        if (pn < 8) { float a[8];
#pragma unroll
            for (int i = 0; i < 8; ++i) a[i] = lo[i] * sigm(hi[i]);
            st8(Z + (size_t)row * 1024 + 128 * pn + c0, a);
        } else {
            const int g = (pn - 8) >> 2, col = ((pn - 8) & 3) * 256 + c0;
            bf16_t* base = Z + (size_t)(g + 1) * T * 1024 + (size_t)row * 1024 + col;
            float x[8], y[8];
            if (g == 1) {
#pragma unroll
                for (int i = 0; i < 8; ++i) { x[i] = lo[i]; y[i] = hi[i]; }
            } else if (g == 2) {
#pragma unroll
                for (int i = 0; i < 8; ++i) { const float l0 = LB[col + i], l1 = LB[col + 128 + i]; x[i] = __logf(l0 + (1.f - l0) * sigm(lo[i])); y[i] = __logf(l1 + (1.f - l1) * sigm(hi[i])); }
            } else {
#pragma unroll
                for (int i = 0; i < 8; ++i) { x[i] = silu(lo[i]); y[i] = silu(hi[i]); }
            }
            st8(base, x); st8(base + 128, y);
        }
    }
};
struct Epi2 {
    const float* xp; const float* xs; float* X1; bf16_t* X1B; float* SSP;
    __device__ __forceinline__ float rowscale(int) const { return 1.f; }
    template <int X1M, int X2M> __device__ __forceinline__ void tile8(int row, int pn, int c0, const float (&lo)[8], const float (&hi)[8], float) const {
        const int col = 256 * pn + c0;
        const float* xr = (row < TP ? xp + (size_t)row * D : xs + (size_t)(row - TP) * D) + col;
        const f32x4 a0 = *(const f32x4*)xr, a1 = *(const f32x4*)(xr + 4), b0 = *(const f32x4*)(xr + 128), b1 = *(const f32x4*)(xr + 132);
        float v[8], w[8];
        v[0] = a0.x + lo[0]; v[1] = a0.y + lo[1]; v[2] = a0.z + lo[2]; v[3] = a0.w + lo[3]; v[4] = a1.x + lo[4]; v[5] = a1.y + lo[5]; v[6] = a1.z + lo[6]; v[7] = a1.w + lo[7];
        w[0] = b0.x + hi[0]; w[1] = b0.y + hi[1]; w[2] = b0.z + hi[2]; w[3] = b0.w + hi[3]; w[4] = b1.x + hi[4]; w[5] = b1.y + hi[5]; w[6] = b1.z + hi[6]; w[7] = b1.w + hi[7];
        float* o = X1 + (size_t)row * D + col;
        *(f32x4*)o = (f32x4){v[0], v[1], v[2], v[3]}; *(f32x4*)(o + 4) = (f32x4){v[4], v[5], v[6], v[7]};
        *(f32x4*)(o + 128) = (f32x4){w[0], w[1], w[2], w[3]}; *(f32x4*)(o + 132) = (f32x4){w[4], w[5], w[6], w[7]};
        bf16_t* ob = X1B + (size_t)row * D + col; st8(ob, v); st8(ob + 128, w);
        float ss = 0.f;
#pragma unroll
        for (int i = 0; i < 8; ++i) ss += v[i] * v[i] + w[i] * w[i];
        ss += __shfl_xor(ss, X1M); ss += __shfl_xor(ss, X2M);
        if ((c0 & 31) == 0) SSP[(size_t)row * 16 + pn * 4 + (c0 >> 5)] = ss;
    }
};
struct Epi3 {
    const float* SSP1; bf16_t* UG; bf16_t* GV; f32x2* VST;
    __device__ __forceinline__ float rowscale(int row) const {
        const f32x4* s = (const f32x4*)(SSP1 + (size_t)row * 16); const f32x4 a = s[0], b = s[1], c = s[2], d = s[3];
        const float t = ((a.x + a.y) + (a.z + a.w)) + ((b.x + b.y) + (b.z + b.w)) + ((c.x + c.y) + (c.z + c.w)) + ((d.x + d.y) + (d.z + d.w));
        return rsqrtf(t * (1.f / 1024.f) + EPS);
    }
    template <int X1M, int X2M> __device__ __forceinline__ void tile8(int row, int pn, int c0, const float (&lo)[8], const float (&hi)[8], float rs) const {
        if (pn < 16) { float a[8];
#pragma unroll
            for (int i = 0; i < 8; ++i) a[i] = gelu_t(lo[i] * rs) * silu(hi[i] * rs);
            st8(UG + (size_t)row * DC + 128 * pn + c0, a);
        } else {
            const int col = 256 * (pn - 16) + c0; float x[8], y[8], s = 0.f, q = 0.f;
#pragma unroll
            for (int i = 0; i < 8; ++i) { x[i] = gelu_t(lo[i] * rs); y[i] = gelu_t(hi[i] * rs); s += x[i] + y[i]; q += x[i] * x[i] + y[i] * y[i]; }
            bf16_t* o = GV + (size_t)row * DC + col; st8(o, x); st8(o + 128, y);
            s += __shfl_xor(s, X1M); q += __shfl_xor(q, X1M); s += __shfl_xor(s, X2M); q += __shfl_xor(q, X2M);
            if ((c0 & 31) == 0) VST[(size_t)row * 32 + (pn - 16) * 4 + (c0 >> 5)] = (f32x2){s, q};
        }
    }
};
struct Epi4 {
    const float* X1; float* Y; float* SSP;
    __device__ __forceinline__ float rowscale(int) const { return 1.f; }
    template <int X1M, int X2M> __device__ __forceinline__ void tile8(int row, int pn, int c0, const float (&lo)[8], const float (&hi)[8], float) const {
        const int col = 256 * pn + c0;
        const float* xr = X1 + (size_t)row * D + col;
        const f32x4 a0 = *(const f32x4*)xr, a1 = *(const f32x4*)(xr + 4), b0 = *(const f32x4*)(xr + 128), b1 = *(const f32x4*)(xr + 132);
        float v[8], w[8];
        v[0] = a0.x + lo[0]; v[1] = a0.y + lo[1]; v[2] = a0.z + lo[2]; v[3] = a0.w + lo[3]; v[4] = a1.x + lo[4]; v[5] = a1.y + lo[5]; v[6] = a1.z + lo[6]; v[7] = a1.w + lo[7];
        w[0] = b0.x + hi[0]; w[1] = b0.y + hi[1]; w[2] = b0.z + hi[2]; w[3] = b0.w + hi[3]; w[4] = b1.x + hi[4]; w[5] = b1.y + hi[5]; w[6] = b1.z + hi[6]; w[7] = b1.w + hi[7];
        float* o = Y + (size_t)row * D + col;
        *(f32x4*)o = (f32x4){v[0], v[1], v[2], v[3]}; *(f32x4*)(o + 4) = (f32x4){v[4], v[5], v[6], v[7]};
        *(f32x4*)(o + 128) = (f32x4){w[0], w[1], w[2], w[3]}; *(f32x4*)(o + 132) = (f32x4){w[4], w[5], w[6], w[7]};
        float ss = 0.f;
#pragma unroll
        for (int i = 0; i < 8; ++i) ss += v[i] * v[i] + w[i] * w[i];
        ss += __shfl_xor(ss, X1M); ss += __shfl_xor(ss, X2M);
        if ((c0 & 31) == 0) SSP[(size_t)row * 16 + pn * 4 + (c0 >> 5)] = ss;
    }
};

template <class Epi> __device__ __forceinline__ void gemm_simple(LAS unsigned char* lds, const bf16_t* A, const bf16_t* Bt, int M, int N, int K, const Epi& E, int vb, int G) {
    LAS bf16_t* sA = (LAS bf16_t*)lds;
    LAS bf16_t* sB = (LAS bf16_t*)(lds + 4096);
    const int tid = opaque((int)threadIdx.x), r = tid >> 4, c0 = (tid & 15) * 8;
    const int nN = N / 256, nunits = (M / 32) * nN;
    for (int u = vb; u < nunits; u += G) {
        const int ms = u / nN, pn = u % nN, row0 = ms * 32, col0 = pn * 256;
        float lo[8], hi[8];
#pragma unroll
        for (int i = 0; i < 8; ++i) { lo[i] = 0.f; hi[i] = 0.f; }
        for (int k0 = 0; k0 < K; k0 += 32) {
            __syncthreads();
            if (tid < 128) { const int rr = tid >> 2, kc = (tid & 3) * 8; *(LAS u32x4*)(sA + rr * 40 + kc) = *(const u32x4*)(A + (size_t)(row0 + rr) * K + k0 + kc); }
            for (int q = tid; q < 1024; q += NTHR) { const int rr = q >> 2, kc = (q & 3) * 8; *(LAS u32x4*)(sB + rr * 40 + kc) = *(const u32x4*)(Bt + (size_t)(col0 + rr) * K + k0 + kc); }
            __syncthreads();
#pragma unroll 1
            for (int kc = 0; kc < 32; kc += 8) {
                const u32x4 av = *(const LAS u32x4*)(sA + r * 40 + kc);
                const float a0 = bflo(av.x), a1 = bfhi(av.x), a2 = bflo(av.y), a3 = bfhi(av.y), a4 = bflo(av.z), a5 = bfhi(av.z), a6 = bflo(av.w), a7 = bfhi(av.w);
#pragma unroll
                for (int i = 0; i < 8; ++i) {
                    const u32x4 b = *(const LAS u32x4*)(sB + (c0 + i) * 40 + kc);
                    lo[i] += a0 * bflo(b.x) + a1 * bfhi(b.x) + a2 * bflo(b.y) + a3 * bfhi(b.y) + a4 * bflo(b.z) + a5 * bfhi(b.z) + a6 * bflo(b.w) + a7 * bfhi(b.w);
                    const u32x4 c = *(const LAS u32x4*)(sB + (128 + c0 + i) * 40 + kc);
                    hi[i] += a0 * bflo(c.x) + a1 * bfhi(c.x) + a2 * bflo(c.y) + a3 * bfhi(c.y) + a4 * bflo(c.z) + a5 * bfhi(c.z) + a6 * bflo(c.w) + a7 * bfhi(c.w);
                }
            }
        }
        const int row = row0 + r; const float rsc = E.rowscale(row);
        E.template tile8<1, 2>(row, pn, c0, lo, hi, rsc);
    }
}

namespace pg8 {
#define PG8_LAS __attribute__((address_space(3)))
constexpr int BM = 256, BK = 64, HALF = 128, HTB = HALF * BK * 2  , STAGE_BYTES = 8 * HTB, NXCD = 8, WGM = 8;

__host__ __device__ __forceinline__ int lds_byte(int r, int c) { const int st = (r >> 4) * 2 + (c >> 5), rr = r & 15, cc = c & 31, ob = rr * 64 + cc * 2; return st * 1024 + (ob ^ (((ob >> 9) & 1) << 5)); }
__host__ __device__ __forceinline__ void stage_rc(int b, int& R, int& C) { const int st = b / 1024, sb = b % 1024, swz = sb ^ (((sb >> 9) & 1) << 5); R = (st >> 1) * 16 + swz / 64; C = (st & 1) * 32 + (swz % 64) / 2; }
__host__ __device__ __forceinline__ int perm32(int rho) { const int n = rho >> 4, i = rho & 15; return 8 * (i >> 2) + 4 * n + (i & 3); }

struct Unit { int pm, pn; };
struct Gemm { const bf16_t* A; const bf16_t* Bt; int M, N, K; };

struct StaticOrder {
    int nM, nN, nwg, G, c;
    __host__ __device__ void init(int M, int N, int G_, int c_) { nM = M / BM; nN = N / BM; nwg = nM * nN; G = G_; c = c_; }
    __host__ __device__ bool next(int i, Unit& u) const {
        const long L = (long)i * G + c; if (L >= nwg) return false;
        int wgid = (int)L; { const int q = nwg / NXCD, r = nwg % NXCD, xcd = wgid % NXCD, off = wgid / NXCD; wgid = (xcd < r ? xcd * (q + 1) : r * (q + 1) + (xcd - r) * q) + off; }
        const int nig = WGM * nN, gid = wgid / nig, fm = gid * WGM, gsz = (nM - fm) < WGM ? (nM - fm) : WGM;
        u.pm = fm + ((wgid % nig) % gsz); u.pn = (wgid % nig) / gsz; return true;
    }
    __device__ __forceinline__ void a_ready(const Unit&) const {}
    __device__ __forceinline__ void done(const Unit&) const {}
};
template <class Epi, class Sched, bool ALIGN_EPI = false, bool SP2 = false>
__device__ __forceinline__ void gemm_phase(PG8_LAS unsigned char* lds, const Gemm g, const Sched& S, const Epi& E) {
    const int tid = opaque((int)threadIdx.x), wid = __builtin_amdgcn_readfirstlane(tid >> 6), lane = tid & 63, wr = wid >> 2, wc = wid & 3, fr = lane & 15, fq = lane >> 4;
    const int K = g.K, nt = K / BK;
    unsigned voffA[2], voffB[2];
#pragma unroll
    for (int i = 0; i < 2; ++i) { int R, C; stage_rc(tid * 16 + i * 8192, R, C); const int Rb = Epi::PERM ? ((R & ~31) + perm32(R & 31)) : R;
        voffA[i] = (unsigned)(R * K + C) * 2u; voffB[i] = (unsigned)(Rb * K + C) * 2u; }
    const size_t kstep = (size_t)(BK * 2);
    const size_t hstep = (size_t)HALF * K * 2;
    const size_t tstep = 2 * hstep;
    const unsigned ldsw = (unsigned)wid * 1024u;
    const int aoff = lds_byte(wr * 64 + fr, fq * 8), boff = lds_byte(wc * 32 + fr, fq * 8);
#define PG8_SA(b, h) (((b) * 2 + (h)) * HTB)
#define PG8_SB(b, h) ((4 + (b) * 2 + (h)) * HTB)
#define PG8_STAGE(bufoff, gbase, voff) do { _Pragma("unroll") for (int _i = 0; _i < 2; ++_i) \
        __builtin_amdgcn_global_load_lds((const unsigned*)((const char*)(gbase) + (voff)[_i]), (PG8_LAS unsigned*)(lds + (bufoff) + ldsw + _i * 8192), 16, 0, 0); } while (0)
#define PG8_LDA(dst, b, h) do { _Pragma("unroll") for (int m = 0; m < 4; ++m) _Pragma("unroll") for (int k = 0; k < 2; ++k) dst[m][k] = *(const PG8_LAS bf16x8*)(lds + PG8_SA(b, h) + aoff + m * 2048 + k * 1024); } while (0)
#define PG8_LDB(dst, b, h) do { _Pragma("unroll") for (int n = 0; n < 2; ++n) _Pragma("unroll") for (int k = 0; k < 2; ++k) dst[n][k] = *(const PG8_LAS bf16x8*)(lds + PG8_SB(b, h) + boff + n * 2048 + k * 1024); } while (0)
#define PG8_MMA(ai, bj, At, Bt) do { __builtin_amdgcn_s_setprio(1); _Pragma("unroll") for (int m = 0; m < 4; ++m) _Pragma("unroll") for (int n = 0; n < 2; ++n) _Pragma("unroll") for (int k = 0; k < 2; ++k) \
        acc[ai][bj][m][n] = __builtin_amdgcn_mfma_f32_16x16x32_bf16(Bt[n][k], At[m][k], acc[ai][bj][m][n], 0, 0, 0); __builtin_amdgcn_s_setprio(0); } while (0)
#define PG8_WAIT_V(n) asm volatile("s_waitcnt vmcnt(" #n ")" ::: "memory")
#define PG8_WAIT_L(n) asm volatile("s_waitcnt lgkmcnt(" #n ")" ::: "memory")
#define PG8_BAR __builtin_amdgcn_s_barrier()
#define PG8_SCHED __builtin_amdgcn_sched_barrier(0)
    Unit cur, nxt; int ui = 0;
    if (!S.next(0, cur)) return;
    f32x4 acc[2][2][4][2];
#pragma unroll
    for (int a = 0; a < 2; ++a)
#pragma unroll
        for (int b = 0; b < 2; ++b)
#pragma unroll
            for (int m = 0; m < 4; ++m)
#pragma unroll
                for (int n = 0; n < 2; ++n) acc[a][b][m][n] = (f32x4){0.f, 0.f, 0.f, 0.f};
    bf16x8 At[4][2], B0[2][2], B1[2][2];
    const char* cA = (const char*)g.A + (size_t)cur.pm * tstep; const char* cB = (const char*)g.Bt + (size_t)cur.pn * tstep;
    S.a_ready(cur);
    if constexpr (SP2) {
        PG8_STAGE(PG8_SB(0, 0), cB, voffB); PG8_STAGE(PG8_SB(0, 1), cB + hstep, voffB); PG8_STAGE(PG8_SA(0, 0), cA, voffA); PG8_STAGE(PG8_SA(0, 1), cA + hstep, voffA);
        if (wr == 1) PG8_BAR;
        PG8_WAIT_V(2); PG8_BAR;
        PG8_STAGE(PG8_SB(1, 0), cB + kstep, voffB); PG8_STAGE(PG8_SA(1, 0), cA + kstep, voffA); PG8_STAGE(PG8_SB(1, 1), cB + hstep + kstep, voffB);
        PG8_WAIT_V(6); PG8_BAR;
    } else {
        PG8_STAGE(PG8_SB(0, 0), cB, voffB); PG8_STAGE(PG8_SA(0, 0), cA, voffA); PG8_STAGE(PG8_SB(0, 1), cB + hstep, voffB); PG8_STAGE(PG8_SA(0, 1), cA + hstep, voffA);
        if (wr == 1) PG8_BAR;
        PG8_WAIT_V(4); PG8_BAR;
        PG8_STAGE(PG8_SB(1, 0), cB + kstep, voffB); PG8_STAGE(PG8_SA(1, 0), cA + kstep, voffA); PG8_STAGE(PG8_SB(1, 1), cB + hstep + kstep, voffB);
        PG8_WAIT_V(6); PG8_BAR;
    }
    for (;;) {
        const bool has_next = S.next(ui + 1, nxt);
        const char* nA = has_next ? (const char*)g.A + (size_t)nxt.pm * tstep : cA; const char* nB = has_next ? (const char*)g.Bt + (size_t)nxt.pn * tstep : cB;
        for (int t = 0; t < nt; t += 2) {
            const bool last = (t == nt - 2);
            const char* a1 = cA + (size_t)(t + 1) * kstep;
            const char* a2 = last ? nA : cA + (size_t)(t + 2) * kstep; const char* b2 = last ? nB : cB + (size_t)(t + 2) * kstep;
            const char* a3 = a2 + kstep; const char* b3 = b2 + kstep;
            if (last && has_next) S.a_ready(nxt);
            if constexpr (SP2) {
            PG8_LDB(B0, 0, 0); PG8_LDB(B1, 0, 1); PG8_SCHED; PG8_LDA(At, 0, 0); PG8_STAGE(PG8_SA(1, 1), a1 + hstep, voffA);
            PG8_WAIT_V(8); PG8_WAIT_L(0); PG8_BAR; PG8_MMA(0, 0, At, B0); PG8_MMA(0, 1, At, B1); PG8_BAR; PG8_SCHED;
            PG8_LDA(At, 0, 1); PG8_STAGE(PG8_SB(0, 0), b2, voffB); PG8_STAGE(PG8_SB(0, 1), b2 + hstep, voffB); PG8_STAGE(PG8_SA(0, 0), a2, voffA);
            PG8_WAIT_V(8); PG8_WAIT_L(0); PG8_BAR; PG8_MMA(1, 0, At, B0); PG8_MMA(1, 1, At, B1); PG8_BAR; PG8_SCHED;
            PG8_LDB(B0, 1, 0); PG8_LDB(B1, 1, 1); PG8_SCHED; PG8_LDA(At, 1, 0); PG8_STAGE(PG8_SA(0, 1), a2 + hstep, voffA);
            PG8_WAIT_V(8); PG8_WAIT_L(0); PG8_BAR; PG8_MMA(0, 0, At, B0); PG8_MMA(0, 1, At, B1); PG8_BAR; PG8_SCHED;
            PG8_LDA(At, 1, 1); PG8_STAGE(PG8_SB(1, 0), b3, voffB); PG8_STAGE(PG8_SB(1, 1), b3 + hstep, voffB); PG8_STAGE(PG8_SA(1, 0), a3, voffA);
            PG8_WAIT_V(8); PG8_WAIT_L(0); PG8_BAR; PG8_MMA(1, 0, At, B0); PG8_MMA(1, 1, At, B1); PG8_BAR; PG8_SCHED;
            } else {
            PG8_LDB(B0, 0, 0); PG8_SCHED; PG8_LDA(At, 0, 0); PG8_STAGE(PG8_SA(1, 1), a1 + hstep, voffA);
            PG8_WAIT_L(8); PG8_BAR; PG8_WAIT_L(0); PG8_MMA(0, 0, At, B0); PG8_BAR; PG8_SCHED;
            PG8_LDB(B1, 0, 1); PG8_STAGE(PG8_SB(0, 0), b2, voffB);
            PG8_BAR; PG8_WAIT_L(0); PG8_MMA(0, 1, At, B1); PG8_BAR;
            PG8_LDA(At, 0, 1); PG8_STAGE(PG8_SA(0, 0), a2, voffA);
            PG8_BAR; PG8_WAIT_L(0); PG8_MMA(1, 0, At, B0); PG8_BAR; PG8_SCHED;
            PG8_STAGE(PG8_SB(0, 1), b2 + hstep, voffB);
            PG8_WAIT_V(6); PG8_BAR; PG8_MMA(1, 1, At, B1); PG8_BAR;
            PG8_LDB(B0, 1, 0); PG8_SCHED; PG8_LDA(At, 1, 0); PG8_STAGE(PG8_SA(0, 1), a2 + hstep, voffA);
            PG8_WAIT_L(8); PG8_BAR; PG8_WAIT_L(0); PG8_MMA(0, 0, At, B0); PG8_BAR; PG8_SCHED;
            PG8_LDB(B1, 1, 1); PG8_STAGE(PG8_SB(1, 0), b3, voffB);
            PG8_BAR; PG8_WAIT_L(0); PG8_MMA(0, 1, At, B1); PG8_BAR;
            PG8_LDA(At, 1, 1); PG8_STAGE(PG8_SA(1, 0), a3, voffA);
            PG8_BAR; PG8_WAIT_L(0); PG8_MMA(1, 0, At, B0); PG8_BAR; PG8_SCHED;
            PG8_STAGE(PG8_SB(1, 1), b3 + hstep, voffB);
            PG8_WAIT_V(6); PG8_BAR; PG8_MMA(1, 1, At, B1); PG8_BAR;
            }
        }
        if constexpr (ALIGN_EPI) { if (wr == 0) PG8_BAR; }
        if constexpr (!Epi::AFTER_DRAIN) { E(acc, cur, wr, wc, fr, fq); S.done(cur); }
        if (!has_next) break;
#pragma unroll
        for (int a = 0; a < 2; ++a)
#pragma unroll
            for (int b = 0; b < 2; ++b)
#pragma unroll
                for (int m = 0; m < 4; ++m)
#pragma unroll
                    for (int n = 0; n < 2; ++n) acc[a][b][m][n] = (f32x4){0.f, 0.f, 0.f, 0.f};
        cur = nxt; cA = nA; cB = nB; ++ui;
        if constexpr (ALIGN_EPI) { if (wr == 1) PG8_BAR; }
    }
    PG8_WAIT_V(0);
    if constexpr (!ALIGN_EPI) { if (wr == 0) PG8_BAR; }
    PG8_BAR;
    if constexpr (Epi::AFTER_DRAIN) { E.fused(acc, cur, wr, wc, fr, fq, lds, wid, lane); S.done(cur); }
#undef PG8_SA
#undef PG8_SB
#undef PG8_STAGE
#undef PG8_LDA
#undef PG8_LDB
#undef PG8_MMA
#undef PG8_WAIT_V
#undef PG8_WAIT_L
#undef PG8_BAR
#undef PG8_SCHED
}
}

template <class E> struct EpiAd {
    static constexpr bool PERM = true, AFTER_DRAIN = false; E e;
    __device__ __forceinline__ void operator()(const f32x4 (&acc)[2][2][4][2], const pg8::Unit& u, int wr, int wc, int fr, int fq) const {
#pragma unroll
        for (int ai = 0; ai < 2; ++ai)
#pragma unroll
            for (int m = 0; m < 4; ++m) {
                const int row = u.pm * 256 + ai * 128 + wr * 64 + m * 16 + fr;
                const float rsc = e.rowscale(row);
                float lo[8], hi[8];
#pragma unroll
                for (int j = 0; j < 4; ++j) { lo[j] = acc[ai][0][m][0][j]; lo[4 + j] = acc[ai][0][m][1][j]; hi[j] = acc[ai][1][m][0][j]; hi[4 + j] = acc[ai][1][m][1][j]; }
                e.template tile8<16, 32>(row, u.pn, wc * 32 + 8 * fq, lo, hi, rsc);
            }
    }
};
template <class E> __device__ __forceinline__ void gemm_fast(LAS unsigned char* lds, const bf16_t* A, const bf16_t* Bt, int M, int N, int K, const E& e, int vb, int G) {
    pg8::Gemm g{A, Bt, M, N, K}; pg8::StaticOrder S; S.init(M, N, G, vb);
    EpiAd<E> Ea{e};
    pg8::gemm_phase<EpiAd<E>, pg8::StaticOrder, true, true>(lds, g, S, Ea);
}

template <class E, int KS>
__device__ __forceinline__ void gemm_small(LAS unsigned char* lds, const bf16_t* A, const bf16_t* Bt, int N, int K, const E& e, int row_base, int vb, int G) {
    const int tid = opaque((int)threadIdx.x), lane = tid & 63, wave = __builtin_amdgcn_readfirstlane(tid >> 6), fr = lane & 15, fq = lane >> 4;
    const int nwork = 16 * (N / 64) * KS;
    for (int wbase = vb * NWAVES; wbase < nwork; wbase += G * NWAVES) {
        const int wk = wbase + wave; const bool act = wk < nwork;
        const int tile = act ? wk / KS : 0, ks = wk % KS;
        const int ct = tile >> 4, rt = tile & 15, pn = ct >> 2, cg = ct & 3;
        const int klen = K / KS, kb = ks * klen;
        f32x4 acc[4][4];
#pragma unroll
        for (int m = 0; m < 4; ++m)
#pragma unroll
            for (int n = 0; n < 4; ++n) acc[m][n] = (f32x4){0.f, 0.f, 0.f, 0.f};
        if (act) {
            const bf16_t* ap = A + (size_t)(rt * 64 + fr) * K + kb + 8 * fq;
            const bf16_t* bp[4];
#pragma unroll
            for (int n = 0; n < 4; ++n) { const int vcol = 256 * pn + (n >> 1) * 128 + 32 * cg + pg8::perm32(16 * (n & 1) + fr); bp[n] = Bt + (size_t)vcol * K + kb + 8 * fq; }
            bf16x8 a0[4], b0[4], a1[4], b1[4];
#define GS_LD(aa, bb, koff) do { _Pragma("unroll") for (int m = 0; m < 4; ++m) aa[m] = *(const bf16x8*)(ap + (size_t)m * 16 * K + (koff)); \
                                 _Pragma("unroll") for (int n = 0; n < 4; ++n) bb[n] = *(const bf16x8*)(bp[n] + (koff)); } while (0)
#define GS_MMA(aa, bb) do { _Pragma("unroll") for (int m = 0; m < 4; ++m) _Pragma("unroll") for (int n = 0; n < 4; ++n) \
                                 acc[m][n] = __builtin_amdgcn_mfma_f32_16x16x32_bf16(bb[n], aa[m], acc[m][n], 0, 0, 0); } while (0)
            GS_LD(a0, b0, 0);
            for (int k = 0; k < klen; k += 64) {
                GS_LD(a1, b1, k + 32);
                GS_MMA(a0, b0);
                if (k + 64 < klen) GS_LD(a0, b0, k + 64);
                GS_MMA(a1, b1);
            }
#undef GS_LD
#undef GS_MMA
        }
        if (KS == 1) {
            if (act) {
#pragma unroll
                for (int m = 0; m < 4; ++m) { const int row = row_base + rt * 64 + 16 * m + fr; const float rsc = e.rowscale(row); float lo[8], hi[8];
#pragma unroll
                    for (int j = 0; j < 4; ++j) { lo[j] = acc[m][0][j]; lo[4 + j] = acc[m][1][j]; hi[j] = acc[m][2][j]; hi[4 + j] = acc[m][3][j]; }
                    e.template tile8<16, 32>(row, pn, 32 * cg + 8 * fq, lo, hi, rsc); }
            }
        } else {
            LAS float* P = (LAS float*)lds;
            __syncthreads();
#pragma unroll
            for (int m = 0; m < 4; ++m)
#pragma unroll
                for (int n = 0; n < 4; ++n)
#pragma unroll
                    for (int j = 0; j < 4; ++j) P[((wave * 16 + m * 4 + n) * 4 + j) * 64 + lane] = acc[m][n][j];
            __syncthreads();
            if (wave < 4 && act) {
                const int m = wave; float lo[8], hi[8];
#pragma unroll
                for (int n = 0; n < 4; ++n)
#pragma unroll
                    for (int j = 0; j < 4; ++j) { float sum = 0.f;
#pragma unroll
                        for (int sl = 0; sl < KS; ++sl) sum += P[((sl * 16 + m * 4 + n) * 4 + j) * 64 + lane];
                        if (n < 2) lo[(n & 1) * 4 + j] = sum; else hi[(n & 1) * 4 + j] = sum; }
                const int row = row_base + rt * 64 + 16 * m + fr; const float rsc = e.rowscale(row);
                e.template tile8<16, 32>(row, pn, 32 * cg + 8 * fq, lo, hi, rsc);
            }
        }
    }
}
#if FAST_GEMM
#define GEMM gemm_fast
#else
#define GEMM gemm_simple
#endif

__device__ __forceinline__ void conv_simple(const Params& p, LAS unsigned char* lds, int vb, int G) {
    LAS float* red = (LAS float*)lds;
    const bf16_t* A = (const bf16_t*)(p.ws + WS_R1); const bf16_t* SGA = A + (size_t)T * 1024; bf16_t* H0 = (bf16_t*)p.out;
    const float *cw = p.in[6], *cb = p.in[7], *lg = p.in[8], *lbeta = p.in[9], *sc = p.in[2];
    const int tid = opaque((int)threadIdx.x), c = tid * 2;
    for (int r = vb; r < T; r += G) {
        int t, rowbase; const float* hist;
        if (r < TP) { t = r & 2047; rowbase = r - t; hist = nullptr; } else { const int b = (r - TP) >> 3; t = (r - TP) & 7; rowbase = r - t; hist = sc + (size_t)b * 30 * 1024; }
        float y0 = cb[c], y1 = cb[c + 1];
        for (int j = 0; j < 31; ++j) { const int i = t + j - 30; float a0 = 0.f, a1 = 0.f;
            if (i >= 0) { const unsigned w = *(const unsigned*)(A + (size_t)(rowbase + i) * 1024 + c); a0 = bflo(w); a1 = bfhi(w); }
            else if (hist) { a0 = hist[(30 + i) * 1024 + c]; a1 = hist[(30 + i) * 1024 + c + 1]; }
            y0 += cw[j * 1024 + c] * a0; y1 += cw[j * 1024 + c + 1] * a1; }
        const float mean = block_sum(y0 + y1, red) * (1.f / 1024.f);
        const float d0 = y0 - mean, d1 = y1 - mean;
        const float rstd = rsqrtf(block_sum(d0 * d0 + d1 * d1, red) * (1.f / 1024.f) + EPS);
        const float n0 = d0 * rstd * lg[c] + lbeta[c], n1 = d1 * rstd * lg[c + 1] + lbeta[c + 1];
        const unsigned gw = *(const unsigned*)(SGA + (size_t)r * 1024 + c);
        *(unsigned*)(H0 + (size_t)r * 2048 + c) = pk2(silu(n0) * bflo(gw), silu(n1) * bfhi(gw));
    }
    for (int idx = vb * NTHR + tid; idx < 8 * 30 * 1024; idx += G * NTHR) { const int b = idx / 30720, rem = idx % 30720, i = rem >> 10, cc = rem & 1023;
        p.out[O_CP + idx] = bf2f(A[(size_t)(b * 2048 + 2018 + i) * 1024 + cc]); }
    for (int idx = vb * NTHR + tid; idx < 128 * 30 * 1024; idx += G * NTHR) { const int b = idx / 30720, rem = idx % 30720, i = rem >> 10, cc = rem & 1023;
        p.out[O_CS + idx] = (i < 22) ? sc[(size_t)(b * 30 + 8 + i) * 1024 + cc] : bf2f(A[(size_t)(TP + b * 8 + i - 22) * 1024 + cc]); }
}


typedef float f32x16 __attribute__((ext_vector_type(16)));
__device__ __forceinline__ bf16x8 ldfrag(const LAS unsigned char* img, int pitchB, int row0, int k0, int lane) {
    return *(const LAS bf16x8*)(img + (row0 + (lane & 31)) * pitchB + (k0 + 8 * (lane >> 5)) * 2);
}
__device__ __forceinline__ unsigned ld_u16(const void* base, unsigned boff) { return *(const unsigned short*)((const char*)base + boff); }
__device__ __forceinline__ void st_u16(void* base, unsigned boff, unsigned v) { *(unsigned short*)((char*)base + boff) = (unsigned short)v; }
#define MFMA32(a, b, c) __builtin_amdgcn_mfma_f32_32x32x16_bf16((a), (b), (c), 0, 0, 0)
__device__ __forceinline__ int accrow(int r, int lane) { return (r & 3) + 8 * (r >> 2) + 4 * (lane >> 5); }

__device__ __forceinline__ void conv_fast(const Params& p, LAS unsigned char* lds, int vb, int G) {
    LAS float* red = (LAS float*)lds;
    const bf16_t* A = (const bf16_t*)(p.ws + WS_R1); const bf16_t* SGA = A + (size_t)T * 1024; bf16_t* H0 = (bf16_t*)p.out;
    const float *cw = p.in[6], *cb = p.in[7], *lg = p.in[8], *lbeta = p.in[9], *sc = p.in[2];
    const int tid = opaque((int)threadIdx.x), lane = tid & 63, wave = tid >> 6, c = tid * 2;
    LAS float* cwl = (LAS float*)(lds + 1024);
    __syncthreads();
    for (int q = tid; q < 31 * 256; q += NTHR) *(LAS f32x4*)(cwl + q * 4) = *(const f32x4*)(cw + q * 4);
    __syncthreads();
    const float cb0 = cb[c], cb1 = cb[c + 1], g0 = lg[c], g1 = lg[c + 1], be0 = lbeta[c], be1 = lbeta[c + 1];
    const f32x2 cbv = (f32x2){cb0, cb1}, gv2 = (f32x2){g0, g1}, bev = (f32x2){be0, be1};
    for (int item = vb; item < 384; item += G) {
        int L, rowfirst; f32x2 w[38];
        if (item < 256) { const int b = item >> 5, t0 = (item & 31) * 64; L = 64; rowfirst = b * 2048 + t0;
#pragma unroll
            for (int i = 0; i < 30; ++i) { unsigned u = 0u; if (t0 > 0) u = *(const unsigned*)(A + (size_t)(rowfirst - 30 + i) * 1024 + c); w[i] = (f32x2){bflo(u), bfhi(u)}; }
        } else { const int sb = item - 256; L = 8; rowfirst = TP + sb * 8; const float* hist = sc + (size_t)sb * 30 * 1024;
#pragma unroll
            for (int i = 0; i < 30; ++i) w[i] = *(const f32x2*)(hist + i * 1024 + c);
        }
        unsigned an[8], gn[8];
#pragma unroll
        for (int k = 0; k < 8; ++k) { an[k] = *(const unsigned*)(A + (size_t)(rowfirst + k) * 1024 + c); gn[k] = *(const unsigned*)(SGA + (size_t)(rowfirst + k) * 1024 + c); }
        for (int g = 0; g < L; g += 8) {
            unsigned gc[8];
#pragma unroll
            for (int k = 0; k < 8; ++k) { w[30 + k] = (f32x2){bflo(an[k]), bfhi(an[k])}; gc[k] = gn[k]; }
            if (g + 8 < L) {
#pragma unroll
                for (int k = 0; k < 8; ++k) { an[k] = *(const unsigned*)(A + (size_t)(rowfirst + g + 8 + k) * 1024 + c); gn[k] = *(const unsigned*)(SGA + (size_t)(rowfirst + g + 8 + k) * 1024 + c); } }
            f32x2 y[8]; float st[16];
#pragma unroll
            for (int k = 0; k < 8; ++k) y[k] = cbv;
#pragma unroll
            for (int j = 0; j < 31; ++j) { const f32x2 wj = *(const LAS f32x2*)(cwl + j * 1024 + c);
#pragma unroll
                for (int k = 0; k < 8; ++k) y[k] += wj * w[k + j]; }
#pragma unroll
            for (int k = 0; k < 8; ++k) { const f32x2 sq = y[k] * y[k]; st[k] = y[k].x + y[k].y; st[8 + k] = sq.x + sq.y; }
#pragma unroll
            for (int k = 0; k < 16; ++k) st[k] = wave_sum(st[k]);
            if (lane == 0) {
#pragma unroll
                for (int k = 0; k < 16; ++k) red[wave * 16 + k] = st[k]; }
            __syncthreads();
            if (tid < 16) { float sacc = 0.f;
#pragma unroll
                for (int ww = 0; ww < 8; ++ww) sacc += red[ww * 16 + tid];
                red[128 + tid] = sacc; }
            __syncthreads();
#pragma unroll
            for (int k = 0; k < 8; ++k) { const float mean = red[128 + k] * (1.f / 1024.f); const float var = red[136 + k] * (1.f / 1024.f) - mean * mean; const float rstd = rsqrtf(var + EPS);
                const f32x2 n = (y[k] - mean) * rstd * gv2 + bev;
                *(unsigned*)(H0 + (size_t)(rowfirst + g + k) * 2048 + c) = pk2(silu(n.x) * bflo(gc[k]), silu(n.y) * bfhi(gc[k])); }
#pragma unroll
            for (int i = 0; i < 30; ++i) w[i] = w[i + 8];
        }
        if (item >= 256) { float* o = p.out + O_CS + (size_t)(item - 256) * 30 * 1024 + c;
#pragma unroll
            for (int i = 0; i < 30; ++i) *(f32x2*)(o + i * 1024) = w[i]; }
        else if ((item & 31) == 31) { float* o = p.out + O_CP + (size_t)(item >> 5) * 30 * 1024 + c;
#pragma unroll
            for (int i = 0; i < 30; ++i) *(f32x2*)(o + i * 1024) = w[i]; }
    }
}

__device__ __forceinline__ void hgrn_simple(const Params& p, LAS unsigned char* lds, int vb, int G, int item_lo, int item_hi) {
    LAS float* sf = (LAS float*)lds; LAS float* sk = sf + 1024; LAS float* sq = sk + 1024; LAS float* si = sq + 1024; LAS float* so = si + 1024; LAS float* so2 = so + 4096;
    const int tid = opaque((int)threadIdx.x), v = tid & 127, dq = tid >> 7, lane = tid & 63, wave = tid >> 6;
    const bf16_t* Z = (const bf16_t*)(p.ws + WS_R1);
    const bf16_t *Q = Z + (size_t)2 * T * 1024, *LOGF = Z + (size_t)3 * T * 1024, *I = Z + (size_t)4 * T * 1024, *SGB = Z + (size_t)5 * T * 1024;
    const float* og = p.in[11]; bf16_t* H0 = (bf16_t*)p.out;
    for (int item = item_lo + vb; item < item_hi; item += G) {
        int h, L, rowbase; const float* s0; float* sout;
        if (item < 64) { const int b = item >> 3; h = item & 7; L = 2048; rowbase = b * 2048; s0 = nullptr; sout = p.out + O_HP + (size_t)item * 16384; }
        else { const int it = item - 64, b = it >> 3; h = it & 7; L = 8; rowbase = TP + b * 8; s0 = p.in[3] + (size_t)it * 16384; sout = p.out + O_HS + (size_t)it * 16384; }
        float S[32];
#pragma unroll
        for (int j = 0; j < 32; ++j) S[j] = s0 ? s0[(dq * 32 + j) * 128 + v] : 0.f;
        for (int t0 = 0; t0 < L; t0 += 8) {
            __syncthreads();
            for (int e = tid; e < 1024; e += NTHR) { const int tt = e >> 7, d = e & 127; const size_t off = (size_t)(rowbase + t0 + tt) * 1024 + h * 128 + d;
                const float f = __expf(bf2f(LOGF[off])); sf[e] = f; sk[e] = 1.f - f; sq[e] = bf2f(Q[off]); si[e] = bf2f(I[off]); }
            __syncthreads();
#pragma unroll 1
            for (int tt = 0; tt < 8; ++tt) { const float iv = si[tt * 128 + v]; float op = 0.f;
#pragma unroll
                for (int j = 0; j < 32; ++j) { const int d = dq * 32 + j; S[j] = sf[tt * 128 + d] * S[j] + sk[tt * 128 + d] * iv; op += S[j] * sq[tt * 128 + d]; }
                so[(tt * 4 + dq) * 128 + v] = op; }
            __syncthreads();
            for (int e = tid; e < 1024; e += NTHR) { const int tt = e >> 7, vv = e & 127; so2[e] = (so[(tt * 4 + 0) * 128 + vv] + so[(tt * 4 + 1) * 128 + vv]) + (so[(tt * 4 + 2) * 128 + vv] + so[(tt * 4 + 3) * 128 + vv]); }
            __syncthreads();
            { const int tt = wave; const size_t row = (size_t)(rowbase + t0 + tt);
              const float o0 = so2[tt * 128 + lane], o1 = so2[tt * 128 + 64 + lane];
              const float rs = rsqrtf(wave_sum(o0 * o0 + o1 * o1) * (1.f / 128.f) + EPS);
              const float r0 = o0 * rs * og[h * 128 + lane] * bf2f(SGB[row * 1024 + h * 128 + lane]);
              const float r1 = o1 * rs * og[h * 128 + 64 + lane] * bf2f(SGB[row * 1024 + h * 128 + 64 + lane]);
              H0[row * 2048 + 1024 + h * 128 + lane] = (bf16_t)f2bf(r0); H0[row * 2048 + 1024 + h * 128 + 64 + lane] = (bf16_t)f2bf(r1); }
        }
#pragma unroll
        for (int j = 0; j < 32; ++j) sout[(dq * 32 + j) * 128 + v] = S[j];
    }
}


__device__ __forceinline__ void hgrn_sample(const Params& p, LAS unsigned char* lds, int vb, int G) {
    LAS float* sf = (LAS float*)lds; LAS float* sk = sf + 1024; LAS float* sq = sk + 1024; LAS float* si = sq + 1024; LAS float* so = si + 1024; LAS float* so2 = so + 4096;
    const int tid = opaque((int)threadIdx.x), v = tid & 127, dq = tid >> 7, lane = tid & 63, wave = tid >> 6;
    const bf16_t* Z = (const bf16_t*)(p.ws + WS_R1);
    const bf16_t *Q = Z + (size_t)2 * T * 1024, *LOGF = Z + (size_t)3 * T * 1024, *I = Z + (size_t)4 * T * 1024, *SGB = Z + (size_t)5 * T * 1024;
    const float* og = p.in[11]; bf16_t* H0 = (bf16_t*)p.out;
    float S[32], Sn[32]; unsigned rl[2], rq2[2], ri2[2];
#define HS_LOAD(it_, SS) do { const float* s0_ = p.in[3] + (size_t)(it_) * 16384 + (dq * 32) * 128 + v; \
        _Pragma("unroll") for (int j = 0; j < 32; ++j) SS[j] = s0_[j * 128]; \
        _Pragma("unroll") for (int u = 0; u < 2; ++u) { const int e = tid + u * NTHR; const size_t off = (size_t)(TP + ((it_) >> 3) * 8 + (e >> 7)) * 1024 + ((it_) & 7) * 128 + (e & 127); \
            rl[u] = LOGF[off]; rq2[u] = Q[off]; ri2[u] = I[off]; } } while (0)
    int it = vb;
    if (it < 1024) HS_LOAD(it, S);
    for (; it < 1024; it += G) {
        const int b = it >> 3, h = it & 7, rowbase = TP + b * 8;
        __syncthreads();
#pragma unroll
        for (int u = 0; u < 2; ++u) { const int e = tid + u * NTHR; const float f = __expf(bf2f(rl[u])); sf[e] = f; sk[e] = 1.f - f; sq[e] = bf2f(rq2[u]); si[e] = bf2f(ri2[u]); }
        if (it + G < 1024) HS_LOAD(it + G, Sn);
        __syncthreads();
#pragma unroll 1
        for (int tt = 0; tt < 8; ++tt) { const float iv = si[tt * 128 + v]; float op = 0.f;
            const LAS f32x4* f4 = (const LAS f32x4*)(sf + tt * 128 + dq * 32); const LAS f32x4* k4 = (const LAS f32x4*)(sk + tt * 128 + dq * 32); const LAS f32x4* q4 = (const LAS f32x4*)(sq + tt * 128 + dq * 32);
#pragma unroll
            for (int jj = 0; jj < 8; ++jj) { const f32x4 fv = f4[jj], kv = k4[jj], qv = q4[jj];
                S[4 * jj] = fv.x * S[4 * jj] + kv.x * iv; op += S[4 * jj] * qv.x; S[4 * jj + 1] = fv.y * S[4 * jj + 1] + kv.y * iv; op += S[4 * jj + 1] * qv.y;
                S[4 * jj + 2] = fv.z * S[4 * jj + 2] + kv.z * iv; op += S[4 * jj + 2] * qv.z; S[4 * jj + 3] = fv.w * S[4 * jj + 3] + kv.w * iv; op += S[4 * jj + 3] * qv.w; }
            so[(tt * 4 + dq) * 128 + v] = op; }
        __syncthreads();
#pragma unroll
        for (int u = 0; u < 2; ++u) { const int e = tid + u * NTHR; const int tt = e >> 7, vv = e & 127; so2[e] = (so[(tt * 4 + 0) * 128 + vv] + so[(tt * 4 + 1) * 128 + vv]) + (so[(tt * 4 + 2) * 128 + vv] + so[(tt * 4 + 3) * 128 + vv]); }
        __syncthreads();
        { const int tt = wave; const size_t row = (size_t)(rowbase + tt);
          const float o0 = so2[tt * 128 + lane], o1 = so2[tt * 128 + 64 + lane];
          const float rs = rsqrtf(wave_sum(o0 * o0 + o1 * o1) * (1.f / 128.f) + EPS);
          const float r0 = o0 * rs * og[h * 128 + lane] * bf2f(SGB[row * 1024 + h * 128 + lane]);
          const float r1 = o1 * rs * og[h * 128 + 64 + lane] * bf2f(SGB[row * 1024 + h * 128 + 64 + lane]);
          H0[row * 2048 + 1024 + h * 128 + lane] = (bf16_t)f2bf(r0); H0[row * 2048 + 1024 + h * 128 + 64 + lane] = (bf16_t)f2bf(r1); }
        { float* sout = p.out + O_HS + (size_t)it * 16384 + (dq * 32) * 128 + v;
#pragma unroll
          for (int j = 0; j < 32; ++j) { sout[j * 128] = S[j]; S[j] = Sn[j]; } }
    }
#undef HS_LOAD
}

constexpr size_t WS_BSUM = 131072;
constexpr int HA_QM = 0, HA_KM = 17408, HA_KMT = 34816, HA_VT = 53248, HA_P = 71680, HA_ST = 80896, HA_TOT = 115712, HA_DEC = 117760;
constexpr int PQ = 272, PS = 144;
__device__ __forceinline__ void hgrn_phaseA(const Params& p, LAS unsigned char* lds, int vb, int G) {
    const int tid = opaque((int)threadIdx.x), lane = tid & 63, wid = __builtin_amdgcn_readfirstlane(tid >> 6);
    const int d = tid & 127, tq = tid >> 7;
    bf16_t* Zb = (bf16_t*)(p.ws + WS_R1);
    bf16_t* Qg = Zb + (size_t)2 * T * 1024; bf16_t* LFg = Zb + (size_t)3 * T * 1024; const bf16_t* Ig = Zb + (size_t)4 * T * 1024;
    float* SEG = (float*)(p.ws + WS_SEG); float* BSUM = (float*)(p.ws + WS_BSUM);
    LAS float* TOT = (LAS float*)(lds + HA_TOT); LAS float* DEC = (LAS float*)(lds + HA_DEC);
    for (int item = vb; item < 256; item += G) {
        const int bh = item >> 2, seg = item & 3, b = bh >> 3, h = bh & 7;
        const size_t row0 = (size_t)b * 2048 + seg * 512; const int cb = h * 128;
        __syncthreads();
        for (int i = tid; i < 2176; i += NTHR) *(LAS u32x4*)(lds + HA_ST + i * 16) = (u32x4){0u, 0u, 0u, 0u};
        const int dt = wid >> 1, vts = (wid & 1) * 2;
        f32x16 S[2];
#pragma unroll
        for (int j2 = 0; j2 < 2; ++j2)
#pragma unroll
            for (int r = 0; r < 16; ++r) S[j2][r] = 0.f;
        float bsum = 0.f;
        unsigned rq[16], rf[16], ri[16];
        const unsigned toff = ((unsigned)(16 * tq) * 1024u + (unsigned)d) * 2u;
        { const bf16_t* qb = Qg + row0 * 1024 + cb; const bf16_t* fb = LFg + row0 * 1024 + cb; const bf16_t* ib = Ig + row0 * 1024 + cb;
#pragma unroll
          for (int j = 0; j < 16; ++j) { rq[j] = ld_u16(qb, toff + j * 2048u); rf[j] = ld_u16(fb, toff + j * 2048u); ri[j] = ld_u16(ib, toff + j * 2048u); } }
        for (int c = 0; c < 8; ++c) {
            const size_t r0 = row0 + c * 64;
            float bc[16]; float run = 0.f;
#pragma unroll
            for (int j = 0; j < 16; ++j) { run += bf2f(rf[j]); bc[j] = run; }
            TOT[tq * 128 + d] = run;
            __syncthreads();
            float pre = 0.f, bend = 0.f;
#pragma unroll
            for (int q = 0; q < 4; ++q) { const float t = TOT[q * 128 + d]; pre += (q < tq) ? t : 0.f; bend += t; }
            if (tq == 0) DEC[d] = __expf(bend);
            const float eseg = __expf(bsum);
            unsigned kmp[8], vtp[8]; const unsigned to1 = (unsigned)opaque((int)toff);
#pragma unroll
            for (int j = 0; j < 16; j += 2) {
                float km2[2];
#pragma unroll
                for (int u = 0; u < 2; ++u) { const int jj = j + u; const float bcum = pre + bc[jj]; const float f = __expf(bf2f(rf[jj]));
                    const float qm = bf2f(rq[jj]) * __expf(bcum), km = (1.f - f) * __expf(-bcum); km2[u] = km;
                    const int t = 16 * tq + jj;
                    *(LAS bf16_t*)(lds + HA_QM + t * PQ + d * 2) = (bf16_t)f2bf(qm); *(LAS bf16_t*)(lds + HA_KM + t * PQ + d * 2) = (bf16_t)f2bf(km);
                    st_u16(LFg + r0 * 1024 + cb, to1 + jj * 2048u, f2bf(qm * eseg)); }
                kmp[j >> 1] = pk2(km2[0], km2[1]); vtp[j >> 1] = ri[j] | (ri[j + 1] << 16);
            }
            *(LAS u32x4*)(lds + HA_KMT + d * PS + tq * 32) = (u32x4){kmp[0], kmp[1], kmp[2], kmp[3]}; *(LAS u32x4*)(lds + HA_KMT + d * PS + tq * 32 + 16) = (u32x4){kmp[4], kmp[5], kmp[6], kmp[7]};
            *(LAS u32x4*)(lds + HA_VT + d * PS + tq * 32) = (u32x4){vtp[0], vtp[1], vtp[2], vtp[3]}; *(LAS u32x4*)(lds + HA_VT + d * PS + tq * 32 + 16) = (u32x4){vtp[4], vtp[5], vtp[6], vtp[7]};
            bsum += bend;
            __syncthreads();
            f32x16 dS[2];
#pragma unroll
            for (int j2 = 0; j2 < 2; ++j2)
#pragma unroll
                for (int r = 0; r < 16; ++r) dS[j2][r] = 0.f;
            { bf16x8 af[4];
#pragma unroll
              for (int ks = 0; ks < 4; ++ks) af[ks] = ldfrag(lds + HA_KMT, PS, 32 * dt, 16 * ks, lane);
#pragma unroll
              for (int j2 = 0; j2 < 2; ++j2)
#pragma unroll
                  for (int ks = 0; ks < 4; ++ks) { const bf16x8 bb = ldfrag(lds + HA_VT, PS, 32 * (vts + j2), 16 * ks, lane); dS[j2] = MFMA32(af[ks], bb, dS[j2]); } }
            if (wid < 4) {
                const int mt = (wid + 1) >> 1, nt = (wid == 2 || wid == 3) ? 1 : 0;
                const int mtt = (wid == 3) ? 0 : mt;
                f32x16 acc;
#pragma unroll
                for (int r = 0; r < 16; ++r) acc[r] = 0.f;
                if (wid < 3) {
#pragma unroll
                    for (int ks = 0; ks < 8; ++ks) { const bf16x8 a = ldfrag(lds + HA_QM, PQ, 32 * mtt, 16 * ks, lane), bb = ldfrag(lds + HA_KM, PQ, 32 * nt, 16 * ks, lane); acc = MFMA32(a, bb, acc); }
                }
                const int lnx = opaque(lane); const int sx = 32 * nt + (lnx & 31), tb = 32 * mtt + 4 * (lnx >> 5);
                LAS unsigned char* pp = lds + HA_P + tb * PS + sx * 2;
#pragma unroll
                for (int r = 0; r < 16; ++r) { const int tr = (r & 3) + 8 * (r >> 2);
                    *(LAS bf16_t*)(pp + tr * PS) = (bf16_t)f2bf((sx <= tb + tr) ? acc[r] : 0.f); }
            }
            __syncthreads();
            if (c + 1 < 8) { const bf16_t* qb = Qg + (r0 + 64) * 1024 + cb; const bf16_t* fb = LFg + (r0 + 64) * 1024 + cb; const bf16_t* ib = Ig + (r0 + 64) * 1024 + cb;
                const unsigned to2 = (unsigned)opaque((int)toff);
#pragma unroll
                for (int j = 0; j < 16; ++j) { rq[j] = ld_u16(qb, to2 + j * 2048u); rf[j] = ld_u16(fb, to2 + j * 2048u); ri[j] = ld_u16(ib, to2 + j * 2048u); } }
            { const int mt = wid >> 2, vt = wid & 3; f32x16 o;
#pragma unroll
              for (int r = 0; r < 16; ++r) o[r] = 0.f;
#pragma unroll
              for (int ks = 0; ks < 4; ++ks) { const bf16x8 a = ldfrag(lds + HA_P, PS, 32 * mt, 16 * ks, lane), bb = ldfrag(lds + HA_VT, PS, 32 * vt, 16 * ks, lane); o = MFMA32(a, bb, o); }
#pragma unroll
              for (int ks = 0; ks < 8; ++ks) { const bf16x8 a = ldfrag(lds + HA_QM, PQ, 32 * mt, 16 * ks, lane), bb = ldfrag(lds + HA_ST, PQ, 32 * vt, 16 * ks, lane); o = MFMA32(a, bb, o); }
              const int lny = opaque(lane); const unsigned ob = ((unsigned)(32 * mt + 4 * (lny >> 5)) * 1024u + 32 * vt + (lny & 31)) * 2u;
#pragma unroll
              for (int r = 0; r < 16; ++r) st_u16(Qg + r0 * 1024 + cb, ob + ((r & 3) + 8 * (r >> 2)) * 2048u, f2bf(o[r])); }
            __syncthreads();
            { float dec[16]; const int lnu = opaque(lane); const LAS float* dp = DEC + 32 * dt + 4 * (lnu >> 5);
#pragma unroll
              for (int r = 0; r < 16; ++r) dec[r] = dp[(r & 3) + 8 * (r >> 2)];
#pragma unroll
              for (int j2 = 0; j2 < 2; ++j2) {
#pragma unroll
                  for (int r = 0; r < 16; ++r) S[j2][r] = dec[r] * (S[j2][r] + dS[j2][r]);
                  LAS unsigned char* sp2 = lds + HA_ST + (32 * (vts + j2) + (lnu & 31)) * PQ + (32 * dt + 4 * (lnu >> 5)) * 2;
#pragma unroll
                  for (int g = 0; g < 4; ++g)
                      *(LAS u32x2*)(sp2 + 16 * g) = (u32x2){pk2(S[j2][4 * g], S[j2][4 * g + 1]), pk2(S[j2][4 * g + 2], S[j2][4 * g + 3])};
              } }
        }
        { const int lns = opaque(lane); float* sp = SEG + (size_t)item * 16384 + (32 * dt + 4 * (lns >> 5)) * 128 + 32 * vts + (lns & 31);
#pragma unroll
            for (int j2 = 0; j2 < 2; ++j2)
#pragma unroll
                for (int r = 0; r < 16; ++r) sp[((r & 3) + 8 * (r >> 2)) * 128 + 32 * j2] = S[j2][r]; }
        if (tq == 0) BSUM[item * 128 + d] = bsum;
    }
}
constexpr int HB_AQ = 0, HB_SIN = 34816, HB_OT = 69632;
__device__ __forceinline__ void hgrn_phaseB(const Params& p, LAS unsigned char* lds, int vb, int G) {
    const int tid = opaque((int)threadIdx.x), lane = tid & 63, wid = __builtin_amdgcn_readfirstlane(tid >> 6);
    const int v = tid & 127, dg = tid >> 7;
    const bf16_t* Zb = (const bf16_t*)(p.ws + WS_R1);
    const bf16_t* OLg = Zb + (size_t)2 * T * 1024; const bf16_t* QSg = Zb + (size_t)3 * T * 1024; const bf16_t* SGB = Zb + (size_t)5 * T * 1024;
    const float* SEG = (const float*)(p.ws + WS_SEG); const float* BSUM = (const float*)(p.ws + WS_BSUM);
    const float* og = p.in[11]; bf16_t* H0 = (bf16_t*)p.out;
    LAS float* OT = (LAS float*)(lds + HB_OT);
    for (int item = vb; item < 256; item += G) {
        const int bh = item >> 2, seg = item & 3, b = bh >> 3, h = bh & 7;
        const size_t row0 = (size_t)b * 2048 + seg * 512; const int cb = h * 128;
        __syncthreads();
        if (seg > 0) {
            const float* S0 = SEG + (size_t)(bh * 4 + 0) * 16384; const float* S1 = S0 + 16384; const float* S2 = S1 + 16384; const float* S3 = S2 + 16384;
            const float* B1 = BSUM + (bh * 4 + 1) * 128; const float* B2 = B1 + 128; const float* B3 = B2 + 128;
#pragma unroll 2
            for (int d0 = dg * 32; d0 < dg * 32 + 32; d0 += 4) { float sv[4];
#pragma unroll
                for (int i = 0; i < 4; ++i) { const int dd = d0 + i; float s = S0[dd * 128 + v];
                    if (seg >= 2) s = __expf(B1[dd]) * s + S1[dd * 128 + v];
                    if (seg >= 3) s = __expf(B2[dd]) * s + S2[dd * 128 + v];
                    sv[i] = s;
                    if (seg == 3) p.out[O_HP + (size_t)bh * 16384 + dd * 128 + v] = __expf(B3[dd]) * s + S3[dd * 128 + v]; }
                *(LAS u32x2*)(lds + HB_SIN + v * PQ + d0 * 2) = (u32x2){pk2(sv[0], sv[1]), pk2(sv[2], sv[3])}; }
        }
        const int prow = tid >> 2, ppart = tid & 3; const int pc0 = cb + 32 * ppart;
        u32x4 aq[4], ol[4], gt[4];
#define HB_LOAD(rt_) do { const size_t rr = row0 + (rt_) * 128; \
            _Pragma("unroll") for (int i = 0; i < 4; ++i) { const int q = tid + i * NTHR; aq[i] = *(const u32x4*)(QSg + (rr + (q >> 4)) * 1024 + cb + (q & 15) * 8); \
                ol[i] = *(const u32x4*)(OLg + (rr + prow) * 1024 + pc0 + 8 * i); gt[i] = *(const u32x4*)(SGB + (rr + prow) * 1024 + pc0 + 8 * i); } } while (0)
        HB_LOAD(0);
        for (int rt = 0; rt < 4; ++rt) {
            const size_t r0 = row0 + rt * 128;
            u32x4 olc[4], gtc[4];
#pragma unroll
            for (int i = 0; i < 4; ++i) { olc[i] = ol[i]; gtc[i] = gt[i]; }
            if (seg > 0) {
#pragma unroll
                for (int i = 0; i < 4; ++i) { const int q = tid + i * NTHR; *(LAS u32x4*)(lds + HB_AQ + (q >> 4) * PQ + (q & 15) * 16) = aq[i]; }
            }
            if (rt < 3) HB_LOAD(rt + 1);
            if (seg > 0) {
                __syncthreads();
                const int mt = wid >> 1, vt0 = (wid & 1) * 2; f32x16 acc0, acc1;
#pragma unroll
                for (int r = 0; r < 16; ++r) { acc0[r] = 0.f; acc1[r] = 0.f; }
#pragma unroll
                for (int ks = 0; ks < 8; ++ks) { const bf16x8 a = ldfrag(lds + HB_AQ, PQ, 32 * mt, 16 * ks, lane), b0 = ldfrag(lds + HB_SIN, PQ, 32 * vt0, 16 * ks, lane), b1 = ldfrag(lds + HB_SIN, PQ, 32 * (vt0 + 1), 16 * ks, lane);
                    acc0 = MFMA32(a, b0, acc0); acc1 = MFMA32(a, b1, acc1); }
                { const int lno = opaque(lane); LAS float* op = OT + (32 * mt + 4 * (lno >> 5)) * 132 + 32 * vt0 + (lno & 31);
#pragma unroll
                  for (int r = 0; r < 16; ++r) { const int tr = (r & 3) + 8 * (r >> 2); op[tr * 132] = acc0[r]; op[tr * 132 + 32] = acc1[r]; } }
                __syncthreads();
            }
            { const size_t grow = r0 + prow;
              float o[32];
#pragma unroll
              for (int i = 0; i < 4; ++i) { const u32x4 w = olc[i];
                  o[8 * i] = bflo(w.x); o[8 * i + 1] = bfhi(w.x); o[8 * i + 2] = bflo(w.y); o[8 * i + 3] = bfhi(w.y); o[8 * i + 4] = bflo(w.z); o[8 * i + 5] = bfhi(w.z); o[8 * i + 6] = bflo(w.w); o[8 * i + 7] = bfhi(w.w); }
              if (seg > 0) {
#pragma unroll
                  for (int i = 0; i < 8; ++i) { const f32x4 x = *(const LAS f32x4*)(OT + prow * 132 + 32 * ppart + 4 * i); o[4 * i] += x.x; o[4 * i + 1] += x.y; o[4 * i + 2] += x.z; o[4 * i + 3] += x.w; } }
              float ss = 0.f;
#pragma unroll
              for (int i = 0; i < 32; ++i) ss += o[i] * o[i];
              ss += __shfl_xor(ss, 1); ss += __shfl_xor(ss, 2);
              const float rs = rsqrtf(ss * (1.f / 128.f) + EPS);
#pragma unroll
              for (int i = 0; i < 4; ++i) { const u32x4 gw = gtc[i];
                  const f32x4 g0 = *(const f32x4*)(og + h * 128 + 32 * ppart + 8 * i), g1 = *(const f32x4*)(og + h * 128 + 32 * ppart + 8 * i + 4);
                  float e[8];
                  e[0] = o[8 * i] * rs * g0.x * bflo(gw.x); e[1] = o[8 * i + 1] * rs * g0.y * bfhi(gw.x); e[2] = o[8 * i + 2] * rs * g0.z * bflo(gw.y); e[3] = o[8 * i + 3] * rs * g0.w * bfhi(gw.y);
                  e[4] = o[8 * i + 4] * rs * g1.x * bflo(gw.z); e[5] = o[8 * i + 5] * rs * g1.y * bfhi(gw.z); e[6] = o[8 * i + 6] * rs * g1.z * bflo(gw.w); e[7] = o[8 * i + 7] * rs * g1.w * bfhi(gw.w);
                  st8(H0 + grow * 2048 + 1024 + pc0 + 8 * i, e); }
            }
        }
#undef HB_LOAD
    }
}

__device__ __forceinline__ void gmlp_simple(const Params& p, LAS unsigned char* lds, int vb, int G, int row_lo) {
    LAS float* smean = (LAS float*)lds; LAS float* srstd = smean + 128;
    const f32x2* VST = (const f32x2*)(p.ws + WS_VST); const bf16_t* GV = (const bf16_t*)p.out; bf16_t* UG = (bf16_t*)(p.ws + WS_UG);
    const float *lg = p.in[15], *lb_ = p.in[16], *wsp = p.in[17], *bs = p.in[18];
    const int tid = opaque((int)threadIdx.x), ch = tid * 4, h = tid >> 6;
    const f32x4 g4 = *(const f32x4*)(lg + ch), b4 = *(const f32x4*)(lb_ + ch);
    for (int r = row_lo + vb; r < T; r += G) {
        int t, cstart;
        if (r < TP) { t = r & 127; cstart = r - t; } else { t = (r - TP) & 7; cstart = r - t; }
        __syncthreads();
        if (tid <= t) { const size_t row = (size_t)(cstart + tid); float s = 0.f, q = 0.f;
            for (int j = 0; j < 32; ++j) { const f32x2 st = VST[row * 32 + j]; s += st.x; q += st.y; }
            const float mean = s * (1.f / 2048.f); const float var = q * (1.f / 2048.f) - mean * mean; smean[tid] = mean; srstd[tid] = rsqrtf(var + EPS); }
        __syncthreads();
        float a0 = 0.f, a1 = 0.f, a2 = 0.f, a3 = 0.f, v0 = 0.f, v1 = 0.f, v2 = 0.f, v3 = 0.f;
        for (int s = 0; s <= t; ++s) {
            const float w = wsp[(size_t)(h * 128 + t) * 128 + s], m = smean[s], rs = srstd[s];
            const u32x2 gvw = *(const u32x2*)(GV + (size_t)(cstart + s) * DC + ch);
            v0 = (bflo(gvw.x) - m) * rs * g4.x + b4.x; v1 = (bfhi(gvw.x) - m) * rs * g4.y + b4.y; v2 = (bflo(gvw.y) - m) * rs * g4.z + b4.z; v3 = (bfhi(gvw.y) - m) * rs * g4.w + b4.w;
            a0 += w * v0; a1 += w * v1; a2 += w * v2; a3 += w * v3;
        }
        const float bias = bs[h * 128 + t];
        const u32x2 ugw = *(const u32x2*)(UG + (size_t)r * DC + ch);
        u32x2 o; o.x = pk2(bflo(ugw.x) * (a0 + bias), bfhi(ugw.x) * (a1 + bias)); o.y = pk2(bflo(ugw.y) * (a2 + bias), bfhi(ugw.y) * (a3 + bias));
        *(u32x2*)(UG + (size_t)r * DC + ch) = o;
        if (r < TP) { const int tt = (r & 2047) - 1920; if (tt >= 0) *(f32x4*)(p.out + O_GP + ((size_t)(r >> 11) * 128 + tt) * DC + ch) = (f32x4){v0, v1, v2, v3}; }
        else *(f32x4*)(p.out + O_GS + (size_t)(r - TP) * DC + ch) = (f32x4){v0, v1, v2, v3};
    }
}


constexpr int GM_W = 0, GM_VT = 34816, GM_MR = 34816 + 69632, GM_PITCH = 272;
__device__ __forceinline__ void gmlp_fast(const Params& p, LAS unsigned char* lds, int vb, int G) {
    LAS float* smean = (LAS float*)(lds + GM_MR); LAS float* srstd = smean + 128;
    const f32x2* VST = (const f32x2*)(p.ws + WS_VST); const bf16_t* GV = (const bf16_t*)p.out; bf16_t* UG = (bf16_t*)(p.ws + WS_UG);
    const float *lg = p.in[15], *lb_ = p.in[16], *wsp = p.in[17], *bs = p.in[18];
    const int tid = opaque((int)threadIdx.x), lane = tid & 63, wid = __builtin_amdgcn_readfirstlane(tid >> 6);
    for (int sitem = vb; sitem < 256; sitem += G) {
        const int chunk = sitem >> 1, hh = (sitem & 1) * 4; const size_t cstart = (size_t)chunk * 128;
        const bool lastchunk = (chunk & 15) == 15; const int bseq = chunk >> 4;
        __syncthreads();
        if (tid < 128) { const f32x4* sp = (const f32x4*)(VST + (cstart + tid) * 32); float s = 0.f, q = 0.f;
#pragma unroll
            for (int j = 0; j < 16; ++j) { const f32x4 a = sp[j]; s += a.x + a.z; q += a.y + a.w; }
            const float mean = s * (1.f / 2048.f); const float var = q * (1.f / 2048.f) - mean * mean; smean[tid] = mean; srstd[tid] = rsqrtf(var + EPS); }
        for (int h = hh; h < hh + 4; ++h) {
            __syncthreads();
            for (int q = tid; q < 4096; q += NTHR) { const int t = q >> 5, s0 = (q & 31) * 4; const f32x4 w = *(const f32x4*)(wsp + (size_t)(h * 128 + t) * 128 + s0);
                u32x2 o; o.x = pk2(s0 <= t ? w.x : 0.f, s0 + 1 <= t ? w.y : 0.f); o.y = pk2(s0 + 2 <= t ? w.z : 0.f, s0 + 3 <= t ? w.w : 0.f);
                *(LAS u32x2*)(lds + GM_W + t * GM_PITCH + s0 * 2) = o; }
            { u32x4 ra[4], rb[4];
#pragma unroll
              for (int it = 0; it < 4; ++it) { const int q = tid + it * NTHR, l = q & 63, wq = q >> 6; const int sp = 16 * (wq & 3) + (l & 15), oc = 4 * (wq >> 2) + (l >> 4);
                  const bf16_t* src = GV + (cstart + 2 * sp) * DC + h * 256 + 8 * oc; ra[it] = *(const u32x4*)src; rb[it] = *(const u32x4*)(src + DC); }
#pragma unroll
              for (int it = 0; it < 4; ++it) { const int q = tid + it * NTHR, l = q & 63, wq = q >> 6; const int sp = 16 * (wq & 3) + (l & 15), oc = 4 * (wq >> 2) + (l >> 4);
                  const int col = h * 256 + 8 * oc; const f32x4 ga = *(const f32x4*)(lg + col), gb = *(const f32x4*)(lg + col + 4), ba = *(const f32x4*)(lb_ + col), bb = *(const f32x4*)(lb_ + col + 4);
                  const float m0 = smean[2 * sp], r0s = srstd[2 * sp], m1 = smean[2 * sp + 1], r1s = srstd[2 * sp + 1];
                  float x[8], y[8];
                  x[0] = (bflo(ra[it].x) - m0) * r0s * ga.x + ba.x; x[1] = (bfhi(ra[it].x) - m0) * r0s * ga.y + ba.y; x[2] = (bflo(ra[it].y) - m0) * r0s * ga.z + ba.z; x[3] = (bfhi(ra[it].y) - m0) * r0s * ga.w + ba.w;
                  x[4] = (bflo(ra[it].z) - m0) * r0s * gb.x + bb.x; x[5] = (bfhi(ra[it].z) - m0) * r0s * gb.y + bb.y; x[6] = (bflo(ra[it].w) - m0) * r0s * gb.z + bb.z; x[7] = (bfhi(ra[it].w) - m0) * r0s * gb.w + bb.w;
                  y[0] = (bflo(rb[it].x) - m1) * r1s * ga.x + ba.x; y[1] = (bfhi(rb[it].x) - m1) * r1s * ga.y + ba.y; y[2] = (bflo(rb[it].y) - m1) * r1s * ga.z + ba.z; y[3] = (bfhi(rb[it].y) - m1) * r1s * ga.w + ba.w;
                  y[4] = (bflo(rb[it].z) - m1) * r1s * gb.x + bb.x; y[5] = (bfhi(rb[it].z) - m1) * r1s * gb.y + bb.y; y[6] = (bflo(rb[it].w) - m1) * r1s * gb.z + bb.z; y[7] = (bfhi(rb[it].w) - m1) * r1s * gb.w + bb.w;
                  LAS unsigned char* vp = lds + GM_VT + (8 * oc) * GM_PITCH + sp * 4;
#pragma unroll
                  for (int e = 0; e < 8; ++e) *(LAS unsigned*)(vp + e * GM_PITCH) = pk2(x[e], y[e]);
                  if (lastchunk) { float* o = p.out + O_GP + ((size_t)bseq * 128 + 2 * sp) * DC + col;
                      *(f32x4*)o = (f32x4){x[0], x[1], x[2], x[3]}; *(f32x4*)(o + 4) = (f32x4){x[4], x[5], x[6], x[7]};
                      *(f32x4*)(o + DC) = (f32x4){y[0], y[1], y[2], y[3]}; *(f32x4*)(o + DC + 4) = (f32x4){y[4], y[5], y[6], y[7]}; }
              } }
            __syncthreads();
            f32x16 acc[4];
#pragma unroll
            for (int mt = 0; mt < 4; ++mt)
#pragma unroll
                for (int r = 0; r < 16; ++r) acc[mt][r] = 0.f;
#pragma unroll
            for (int ks = 0; ks < 8; ++ks) { const bf16x8 b = ldfrag(lds + GM_VT, GM_PITCH, 32 * wid, 16 * ks, lane);
#pragma unroll
                for (int mt = 0; mt < 4; ++mt) if (ks < 2 * (mt + 1)) { const bf16x8 a = ldfrag(lds + GM_W, GM_PITCH, 32 * mt, 16 * ks, lane); acc[mt] = MFMA32(a, b, acc[mt]); } }
            u32x4 ugv[8];
#pragma unroll
            for (int it = 0; it < 8; ++it) { const int q = tid + it * NTHR; ugv[it] = *(const u32x4*)(UG + (cstart + (q >> 5)) * DC + h * 256 + 8 * (q & 31)); }
            __syncthreads();
            { const int lnm = opaque(lane); LAS unsigned char* mp = lds + GM_VT + (4 * (lnm >> 5)) * 528 + (32 * wid + (lnm & 31)) * 2; const float* bp = bs + h * 128 + 4 * (lnm >> 5);
#pragma unroll
              for (int mt = 0; mt < 4; ++mt)
#pragma unroll
                  for (int r = 0; r < 16; ++r) { const int tr = 32 * mt + (r & 3) + 8 * (r >> 2); *(LAS bf16_t*)(mp + tr * 528) = (bf16_t)f2bf(acc[mt][r] + bp[tr]); } }
            __syncthreads();
#pragma unroll
            for (int it = 0; it < 8; ++it) { const int q = tid + it * NTHR; const int t = q >> 5, oc = q & 31;
                const u32x4 m = *(const LAS u32x4*)(lds + GM_VT + t * 528 + oc * 16); const u32x4 u = ugv[it]; u32x4 o;
                o.x = pk2(bflo(u.x) * bflo(m.x), bfhi(u.x) * bfhi(m.x)); o.y = pk2(bflo(u.y) * bflo(m.y), bfhi(u.y) * bfhi(m.y));
                o.z = pk2(bflo(u.z) * bflo(m.z), bfhi(u.z) * bfhi(m.z)); o.w = pk2(bflo(u.w) * bflo(m.w), bfhi(u.w) * bfhi(m.w));
                *(u32x4*)(UG + (cstart + t) * DC + h * 256 + 8 * oc) = o; }
        }
    }
}


__device__ __forceinline__ void gmlp_sample(const Params& p, LAS unsigned char* lds, int vb, int G) {
    LAS float* smean = (LAS float*)(lds + GM_MR); LAS float* srstd = smean + 128;
    const f32x2* VST = (const f32x2*)(p.ws + WS_VST); const bf16_t* GV = (const bf16_t*)p.out; bf16_t* UG = (bf16_t*)(p.ws + WS_UG);
    const float *lg = p.in[15], *lb_ = p.in[16], *wsp = p.in[17], *bs = p.in[18];
    const int tid = opaque((int)threadIdx.x), ch = tid * 4; const int h = __builtin_amdgcn_readfirstlane(tid >> 6);
    const f32x4 g4 = *(const f32x4*)(lg + ch), b4 = *(const f32x4*)(lb_ + ch);
    for (int sb = vb; sb < 128; sb += G) {
        const size_t r0 = (size_t)TP + sb * 8;
        __syncthreads();
        if (tid < 64) { const int t = tid >> 3, q = tid & 7; const f32x4* sp = (const f32x4*)(VST + (r0 + t) * 32 + q * 4); const f32x4 a = sp[0], b = sp[1];
            float s_ = (a.x + a.z) + (b.x + b.z), q_ = (a.y + a.w) + (b.y + b.w);
            s_ += __shfl_xor(s_, 1); q_ += __shfl_xor(q_, 1); s_ += __shfl_xor(s_, 2); q_ += __shfl_xor(q_, 2); s_ += __shfl_xor(s_, 4); q_ += __shfl_xor(q_, 4);
            const float mean = s_ * (1.f / 2048.f); const float var = q_ * (1.f / 2048.f) - mean * mean;
            if (q == 0) { smean[t] = mean; srstd[t] = rsqrtf(var + EPS); } }
        u32x2 gvw[8], ugw[8];
#pragma unroll
        for (int t = 0; t < 8; ++t) { gvw[t] = *(const u32x2*)(GV + (r0 + t) * DC + ch); ugw[t] = *(const u32x2*)(UG + (r0 + t) * DC + ch); }
        __syncthreads();
        float vn[8][4];
#pragma unroll
        for (int sx = 0; sx < 8; ++sx) { const float m = smean[sx], rs = srstd[sx];
            vn[sx][0] = (bflo(gvw[sx].x) - m) * rs * g4.x + b4.x; vn[sx][1] = (bfhi(gvw[sx].x) - m) * rs * g4.y + b4.y; vn[sx][2] = (bflo(gvw[sx].y) - m) * rs * g4.z + b4.z; vn[sx][3] = (bfhi(gvw[sx].y) - m) * rs * g4.w + b4.w; }
#pragma unroll
        for (int t = 0; t < 8; ++t) { const float bias = bs[h * 128 + t]; float a0 = bias, a1 = bias, a2 = bias, a3 = bias;
#pragma unroll
            for (int sx = 0; sx <= t; ++sx) { const float w = wsp[(size_t)(h * 128 + t) * 128 + sx]; a0 += w * vn[sx][0]; a1 += w * vn[sx][1]; a2 += w * vn[sx][2]; a3 += w * vn[sx][3]; }
            u32x2 o; o.x = pk2(bflo(ugw[t].x) * a0, bfhi(ugw[t].x) * a1); o.y = pk2(bflo(ugw[t].y) * a2, bfhi(ugw[t].y) * a3);
            *(u32x2*)(UG + (r0 + t) * DC + ch) = o;
            *(f32x4*)(p.out + O_GS + ((size_t)sb * 8 + t) * DC + ch) = (f32x4){vn[t][0], vn[t][1], vn[t][2], vn[t][3]}; }
    }
}

__device__ __forceinline__ void final_norm(const Params& p, int vb, int G) {
    const int tid = opaque((int)threadIdx.x), lane = tid & 63, wave = tid >> 6;
    const int gw = vb * NWAVES + wave, NGW = G * NWAVES;
    const float* SSP = (const float*)(p.ws + WS_SSP2); const float* g = p.in[20];
    f32x4 gg[4];
#pragma unroll
    for (int j = 0; j < 4; ++j) gg[j] = ((const f32x4*)g)[lane + 64 * j];
    for (int r = gw; r < T; r += 2 * NGW) {
        const int r2 = (r + NGW < T) ? r + NGW : r;
        f32x4* y = (f32x4*)(p.out + (size_t)r * D) + lane; f32x4* y2 = (f32x4*)(p.out + (size_t)r2 * D) + lane;
        f32x4 v[4], w[4];
#pragma unroll
        for (int j = 0; j < 4; ++j) { v[j] = y[64 * j]; w[j] = y2[64 * j]; }
        float rs, rs2;
        { const f32x4* s = (const f32x4*)(SSP + (size_t)r * 16); const f32x4 a = s[0], b = s[1], c = s[2], d = s[3];
          rs = rsqrtf((((a.x + a.y) + (a.z + a.w)) + ((b.x + b.y) + (b.z + b.w)) + ((c.x + c.y) + (c.z + c.w)) + ((d.x + d.y) + (d.z + d.w))) * (1.f / 1024.f) + EPS); }
        { const f32x4* s = (const f32x4*)(SSP + (size_t)r2 * 16); const f32x4 a = s[0], b = s[1], c = s[2], d = s[3];
          rs2 = rsqrtf((((a.x + a.y) + (a.z + a.w)) + ((b.x + b.y) + (b.z + b.w)) + ((c.x + c.y) + (c.z + c.w)) + ((d.x + d.y) + (d.z + d.w))) * (1.f / 1024.f) + EPS); }
#pragma unroll
        for (int j = 0; j < 4; ++j) { f32x4 o = v[j]; o.x *= rs * gg[j].x; o.y *= rs * gg[j].y; o.z *= rs * gg[j].z; o.w *= rs * gg[j].w; y[64 * j] = o; }
        if (r2 != r) {
#pragma unroll
            for (int j = 0; j < 4; ++j) { f32x4 o = w[j]; o.x *= rs2 * gg[j].x; o.y *= rs2 * gg[j].y; o.z *= rs2 * gg[j].z; o.w *= rs2 * gg[j].w; y2[64 * j] = o; } }
    }
}

__global__ void __launch_bounds__(NTHR, 2) fwd_kernel(Params p) {
    extern __shared__ __attribute__((aligned(16))) unsigned char lds_raw[];
    LAS unsigned char* lds = (LAS unsigned char*)lds_raw;
    { volatile LAS unsigned* st0 = (volatile LAS unsigned*)(lds + LDS_BYTES - 64); if (threadIdx.x < 16) st0[threadIdx.x] = 0u; }
    __syncthreads();
    const XcdBarrier bar = xcd_barrier_post((unsigned*)p.ws, (volatile LAS unsigned*)(lds + LDS_BYTES - 64));
    const int G = gridDim.x, vb = blockIdx.x;
    unsigned long long stamps[16];
#define STAMP(k) do { if (PROBE_A >= 0) stamps[k] = __builtin_amdgcn_s_memrealtime(); } while (0)
    STAMP(0);
    bf16_t* WT1 = (bf16_t*)(p.ws + WS_WT1); bf16_t* WT2 = (bf16_t*)(p.ws + WS_WT2); bf16_t* WT3 = (bf16_t*)(p.ws + WS_WT3); bf16_t* WT4 = (bf16_t*)(p.ws + WS_WT4);
    bf16_t* ZR = (bf16_t*)(p.ws + WS_R1);

    phase0(p, lds, vb, G);
    xcd_barrier(bar); STAMP(1);
    { Epi1 E{ZR, (const float*)(p.ws + WS_LB)}; GEMM(lds, (const bf16_t*)p.out, WT1, T, N1, D, E, vb, G); STAMP(14); }
    xcd_barrier(bar); STAMP(2);
    hgrn_phaseA(p, lds, vb, G); STAMP(10);
    hgrn_sample(p, lds, vb, G); STAMP(11);
    conv_fast(p, lds, vb, G); STAMP(12);
    xcd_barrier(bar); STAMP(3);
    hgrn_phaseB(p, lds, vb, G);
    xcd_barrier(bar); STAMP(4);
    { Epi2 E{p.in[0], p.in[1], (float*)(p.ws + WS_X1), (bf16_t*)(p.ws + WS_X1B), (float*)(p.ws + WS_SSP1)}; GEMM(lds, (const bf16_t*)p.out, WT2, TP, D, 2048, E, vb, G); STAMP(15); gemm_small<Epi2, 8>(lds, (const bf16_t*)p.out + (size_t)TP * 2048, WT2, D, 2048, E, TP, vb, G); }
    xcd_barrier(bar); STAMP(5);
    { Epi3 E{(const float*)(p.ws + WS_SSP1), (bf16_t*)(p.ws + WS_UG), (bf16_t*)p.out, (f32x2*)(p.ws + WS_VST)}; GEMM(lds, (const bf16_t*)(p.ws + WS_X1B), WT3, T, N3, D, E, vb, G); }
    xcd_barrier(bar); STAMP(6);
    gmlp_fast(p, lds, vb, G); STAMP(13);
    gmlp_sample(p, lds, vb, G);
    xcd_barrier(bar); STAMP(7);
    { Epi4 E{(const float*)(p.ws + WS_X1), p.out, (float*)(p.ws + WS_SSP2)}; GEMM(lds, (const bf16_t*)(p.ws + WS_UG), WT4, TP, D, 2048, E, vb, G); gemm_small<Epi4, 8>(lds, (const bf16_t*)(p.ws + WS_UG) + (size_t)TP * 2048, WT4, D, 2048, E, TP, vb, G); }
    xcd_barrier(bar); STAMP(8);
    final_norm(p, vb, G);
    STAMP(9);
    if (PROBE_A >= 0 && blockIdx.x == 0 && threadIdx.x == 0) {
#ifdef PROBE_EXPR
        const unsigned long long da = PROBE_EXPR;
#else
        const unsigned long long da = stamps[PROBE_B] - stamps[PROBE_A];
#endif
        const unsigned long long wait = 8ull * da, t0 = __builtin_amdgcn_s_memrealtime();
        while (__builtin_amdgcn_s_memrealtime() - t0 < wait) __builtin_amdgcn_s_sleep(32);
    }
}

extern "C" void kernel_launch(void* const* d_in, const int* in_sizes, int n_in, void* d_out, int out_size, void* d_ws, size_t ws_size, hipStream_t stream) {
    static int grid = 0;
    if (grid == 0) {
        if (n_in != 21 || (size_t)out_size != O_END || ws_size < WS_END) { fprintf(stderr, "kernel_launch: unexpected shapes: n_in %d out %d ws %zu\n", n_in, out_size, ws_size); grid = -1; return; }
        int dev = 0, cus = 0, per_cu = 0;
        if (hipGetDevice(&dev) != hipSuccess || hipDeviceGetAttribute(&cus, hipDeviceAttributeMultiprocessorCount, dev) != hipSuccess) { grid = -1; return; }
        if (hipFuncSetAttribute((const void*)fwd_kernel, hipFuncAttributeMaxDynamicSharedMemorySize, LDS_BYTES) != hipSuccess) { fprintf(stderr, "kernel_launch: hipFuncSetAttribute failed\n"); grid = -1; return; }
        if (hipOccupancyMaxActiveBlocksPerMultiprocessor(&per_cu, (const void*)fwd_kernel, NTHR, LDS_BYTES) != hipSuccess || per_cu < 1) { fprintf(stderr, "kernel_launch: occupancy query says %d\n", per_cu); grid = -1; return; }
        grid = cus;
    }
    if (grid < 0) return;
    if (hipMemsetAsync(d_ws, 0, 16384, stream) != hipSuccess) { fprintf(stderr, "kernel_launch: memset failed\n"); return; }
    Params p{};
    for (int i = 0; i < 21; ++i) p.in[i] = (const float*)d_in[i];
    p.out = (float*)d_out; p.ws = (unsigned char*)d_ws;
    void* args[] = {&p};
    hipError_t e = hipLaunchCooperativeKernel((const void*)fwd_kernel, dim3(grid), dim3(NTHR), args, LDS_BYTES, stream);
    if (e != hipSuccess) fprintf(stderr, "kernel_launch: cooperative launch failed: %s (grid %d)\n", hipGetErrorString(e), grid);
}
```
